# Optimizing an MI355X kernel written in HIP

```python
import math
import jax, jax.numpy as jnp
from jax import lax
import numpy as np

D_MODEL = 1024
BATCH = 8
SEQ = 2048
DEPTH = 2

GRID_W = 64
CTX_LEN = 256

D_MIX = D_MODEL
D_FOURIER = D_MIX // 4
FOURIER_GROUPS = 4
D_FG = D_FOURIER // FOURIER_GROUPS
HEAD_DIM = 64
NA_HEADS = (D_MIX // 2) // HEAD_DIM
D_NA = NA_HEADS * HEAD_DIM
D_CONV = D_MIX - D_FOURIER - D_NA
CONV_WIDTH = 3
D_IN_PROJ = D_FOURIER + 3 * D_NA + 3 * D_CONV

NA_KH = 8
NA_KW = 16
NA_QB = 16
NA_KB = 32

N_GROUPS = 4
EXPERTS_PER_GROUP = 8
N_EXPERTS = N_GROUPS * EXPERTS_PER_GROUP
TOP_K = 2
D_EXPERT = 512

EPS = 1e-6
NEG_INF = -1e30

kernel_name = "hybrid_fourier_natten_shortconv_hmoe_dit"


def rms_norm(x, gain):
    xf = x.astype(jnp.float32)
    y = xf * lax.rsqrt(jnp.mean(xf * xf, axis=-1, keepdims=True) + EPS)
    return (y * gain.astype(jnp.float32)).astype(x.dtype)


def split_in(u):
    o = [D_FOURIER, D_FOURIER + D_NA, D_FOURIER + 2 * D_NA, D_FOURIER + 3 * D_NA,
         D_FOURIER + 3 * D_NA + D_CONV, D_FOURIER + 3 * D_NA + 2 * D_CONV]
    f, q, k, v, gb, gc, h = jnp.split(u, o, axis=-1)
    heads = lambda t: t.reshape(*t.shape[:-1], NA_HEADS, HEAD_DIM)
    return f, heads(q), heads(k), heads(v), gb, gc, h


def fourier_mix(f):
    b, n, _ = f.shape
    fg = f.reshape(b, n, FOURIER_GROUPS, D_FG).astype(jnp.float32)
    out = jnp.fft.fft2(fg, axes=(1, 3), norm="ortho").real
    return out.reshape(b, n, D_FOURIER).astype(f.dtype)


def short_conv(h, w):
    return lax.conv_general_dilated(
        h, w[:, None, :].astype(h.dtype), window_strides=(1,), padding=((1, 1),),
        dimension_numbers=("NWC", "WIO", "NWC"), feature_group_count=h.shape[-1])


def na_latent(q, k, v, kc, vc, rpb):
    b, n, h, dh = q.shape
    rows = n // GRID_W
    kh = min(NA_KH, rows)
    ncb = GRID_W // NA_QB
    r = jnp.arange(rows)
    row_start = jnp.clip(r - kh // 2, 0, rows - kh)
    row_idx = row_start[:, None] + jnp.arange(kh)[None, :]
    cols = jnp.arange(GRID_W)
    col_start = jnp.clip(cols - NA_KW // 2, 0, GRID_W - NA_KW)
    band_start = jnp.clip(col_start[::NA_QB], 0, GRID_W - NA_KB)
    band_idx = band_start[:, None] + jnp.arange(NA_KB)[None, :]
    qcol = cols.reshape(ncb, NA_QB)
    qcs = col_start.reshape(ncb, NA_QB)
    kcol = band_idx[:, None, :]
    valid = (kcol >= qcs[..., None]) & (kcol < qcs[..., None] + NA_KW)
    roff = row_idx - r[:, None] + (NA_KH - 1)
    coff = jnp.clip(kcol - qcol[..., None] + (NA_KW - 1), 0, 2 * NA_KW - 2)
    bias = rpb[:, roff[:, None, None, :, None], coff[None, :, :, None, :]]

    qg = q.reshape(b, rows, ncb, NA_QB, h, dh)
    kg = k.reshape(b, rows, GRID_W, h, dh)
    vg = v.reshape(b, rows, GRID_W, h, dh)
    ri = row_idx[:, :, None, None]
    ci = band_idx[None, None]
    kb = kg[:, ri, ci]
    vb = vg[:, ri, ci]

    s_loc = jnp.einsum("brcqhd,brkcjhd->bhrcqkj", qg, kb).astype(jnp.float32)
    s_loc = jnp.where(valid[:, :, None, :], s_loc + bias.astype(jnp.float32), NEG_INF)
    s_ctx = jnp.einsum("brcqhd,blhd->bhrcql", qg, kc).astype(jnp.float32)
    kj = kh * NA_KB
    s = jnp.concatenate([s_loc.reshape(*s_loc.shape[:5], kj), s_ctx], axis=-1)
    p = jax.nn.softmax(s, axis=-1).astype(v.dtype)
    p_loc = p[..., :kj].reshape(s_loc.shape)
    p_ctx = p[..., kj:]
    o = (jnp.einsum("bhrcqkj,brkcjhd->brcqhd", p_loc, vb)
         + jnp.einsum("bhrcql,blhd->brcqhd", p_ctx, vc))
    return o.reshape(b, n, h * dh)


def na_context(qc, kc, vc):
    s = jnp.einsum("blhd,bmhd->bhlm", qc, kc).astype(jnp.float32)
    p = jax.nn.softmax(s, axis=-1).astype(vc.dtype)
    o = jnp.einsum("bhlm,bmhd->blhd", p, vc)
    return o.reshape(*o.shape[:2], D_NA)


def mix_out(f, attn, conv, w_fourier, w_out):
    return jnp.concatenate([fourier_mix(f) @ w_fourier, attn, conv], axis=-1) @ w_out


def hier_moe(t, w_rg, b_rg, w_re, b_re, w_gate, w_up, w_down):
    n_tok = t.shape[0]
    g_logits = (t @ w_rg + b_rg).astype(jnp.float32)
    g_prob = jax.nn.softmax(g_logits, axis=-1)
    g_idx = jnp.argmax(g_logits, axis=-1)
    g_w = jnp.take_along_axis(g_prob, g_idx[:, None], axis=-1)
    e_logits = (t @ w_re + b_re).astype(jnp.float32).reshape(n_tok, N_GROUPS, EXPERTS_PER_GROUP)
    e_sel = jnp.take_along_axis(e_logits, g_idx[:, None, None], axis=1)[:, 0]
    top_v, top_i = lax.top_k(e_sel, TOP_K)
    pair_w = g_w * jax.nn.softmax(top_v, axis=-1)
    expert_id = g_idx[:, None] * EXPERTS_PER_GROUP + top_i
    combine = jnp.sum(jax.nn.one_hot(expert_id, N_EXPERTS, dtype=jnp.float32)
                      * pair_w[..., None], axis=1).astype(t.dtype)
    y = jnp.zeros_like(t)
    for e in range(N_EXPERTS):
        he = jax.nn.silu(t @ w_gate[e]) * (t @ w_up[e])
        y = y + combine[:, e:e + 1] * (he @ w_down[e])
    return y


def trunk_layer(x, xc, mod_x, mod_c, norm1, norm2, w_in, w_fourier, w_conv, rpb, w_out,
                w_rg, b_rg, w_re, b_re, w_gate, w_up, w_down, last):
    b, n, d = x.shape
    l = xc.shape[1]
    sh1, sc1, g1, sh2, sc2, g2 = jnp.split(mod_x[:, None, :], 6, axis=-1)
    csh1, csc1, cg1, csh2, csc2, cg2 = jnp.split(mod_c, 6, axis=-1)
    scale = 1.0 / math.sqrt(HEAD_DIM)

    ux = (rms_norm(x, norm1) * (1 + sc1) + sh1) @ w_in
    uc = (rms_norm(xc, norm1) * (1 + csc1) + csh1) @ w_in
    fx, qx, kx, vx, bx, cx, hx = split_in(ux)
    fc, qc, kc, vc, bc, cc, hc = split_in(uc)
    attn_x = na_latent(qx * scale, kx, vx, kc, vc, rpb)
    conv_x = bx * short_conv(cx * hx, w_conv)
    x = x + g1 * mix_out(fx, attn_x, conv_x, w_fourier, w_out)
    if not last:
        attn_c = na_context(qc * scale, kc, vc)
        conv_c = bc * short_conv(cc * hc, w_conv)
        xc = xc + cg1 * mix_out(fc, attn_c, conv_c, w_fourier, w_out)

    hx2 = rms_norm(x, norm2) * (1 + sc2) + sh2
    if last:
        y = hier_moe(hx2.reshape(-1, d), w_rg, b_rg, w_re, b_re, w_gate, w_up, w_down)
        x = x + g2 * y.reshape(b, n, d)
    else:
        hc2 = rms_norm(xc, norm2) * (1 + csc2) + csh2
        tok = jnp.concatenate([hx2.reshape(-1, d), hc2.reshape(-1, d)], axis=0)
        y = hier_moe(tok, w_rg, b_rg, w_re, b_re, w_gate, w_up, w_down)
        x = x + g2 * y[:b * n].reshape(b, n, d)
        xc = xc + cg2 * y[b * n:].reshape(b, l, d)
    return x, xc


def setup_inputs(seed: int = 0) -> dict:
    key = jax.random.key(seed)
    ks = jax.random.split(key, 24)
    d = D_MODEL
    nrm = lambda k, shape, s: jax.random.normal(k, shape, jnp.float32) * s
    return {
        "x": nrm(ks[0], (BATCH, SEQ, d), 1.0),
        "c": nrm(ks[1], (BATCH, d), 1.0),
        "ctx": nrm(ks[2], (BATCH, CTX_LEN, d), 1.0),
        "c_ctx": nrm(ks[3], (d,), 1.0),
        "w_ada": nrm(ks[4], (DEPTH, d, 6 * d), 0.5 * d ** -0.5),
        "b_ada": nrm(ks[5], (DEPTH, 6 * d), 0.02),
        "norm1": 1.0 + nrm(ks[6], (DEPTH, d), 0.05),
        "norm2": 1.0 + nrm(ks[7], (DEPTH, d), 0.05),
        "w_in": nrm(ks[8], (DEPTH, d, D_IN_PROJ), d ** -0.5),
        "w_fourier": nrm(ks[9], (DEPTH, D_FOURIER, D_FOURIER), D_FOURIER ** -0.5),
        "w_conv": nrm(ks[10], (DEPTH, CONV_WIDTH, D_CONV), CONV_WIDTH ** -0.5),
        "rpb": nrm(ks[11], (DEPTH, NA_HEADS, 2 * NA_KH - 1, 2 * NA_KW - 1), 0.1),
        "w_out": nrm(ks[12], (DEPTH, D_MIX, d), D_MIX ** -0.5),
        "w_rg": nrm(ks[13], (DEPTH, d, N_GROUPS), d ** -0.5),
        "b_rg": nrm(ks[14], (DEPTH, N_GROUPS), 0.01),
        "w_re": nrm(ks[15], (DEPTH, d, N_EXPERTS), d ** -0.5),
        "b_re": nrm(ks[16], (DEPTH, N_EXPERTS), 0.01),
        "w_gate": nrm(ks[17], (DEPTH, N_EXPERTS, d, D_EXPERT), d ** -0.5),
        "w_up": nrm(ks[18], (DEPTH, N_EXPERTS, d, D_EXPERT), d ** -0.5),
        "w_down": nrm(ks[19], (DEPTH, N_EXPERTS, D_EXPERT, d), D_EXPERT ** -0.5),
        "norm_final": 1.0 + nrm(ks[20], (d,), 0.05),
    }


def reference(x, c, ctx, c_ctx, w_ada, b_ada, norm1, norm2, w_in, w_fourier, w_conv, rpb,
              w_out, w_rg, b_rg, w_re, b_re, w_gate, w_up, w_down, norm_final):
    xc = ctx
    sc = jax.nn.silu(c)
    scc = jax.nn.silu(c_ctx)
    for li in range(DEPTH):
        mod_x = sc @ w_ada[li] + b_ada[li]
        mod_c = scc @ w_ada[li] + b_ada[li]
        x, xc = trunk_layer(x, xc, mod_x, mod_c, norm1[li], norm2[li], w_in[li], w_fourier[li],
                            w_conv[li], rpb[li], w_out[li], w_rg[li], b_rg[li], w_re[li],
                            b_re[li], w_gate[li], w_up[li], w_down[li], li == DEPTH - 1)
    return rms_norm(x, norm_final)
```

```cpp
#include <hip/hip_runtime.h>
#include <cstdio>
#include <cstdint>

#ifndef MK_SKIP
#define MK_SKIP 0
#endif
#ifndef MK_SUB
#define MK_SUB 0
#endif
#ifndef MK_SPLIT
#define MK_SPLIT 0
#endif

#define GAS __attribute__((address_space(1)))
#define LAS __attribute__((address_space(3)))
typedef unsigned short bf16_t;
typedef short bf16x8 __attribute__((ext_vector_type(8)));
typedef short bf16x4 __attribute__((ext_vector_type(4)));
typedef float f32x2 __attribute__((ext_vector_type(2)));
typedef float f32x4 __attribute__((ext_vector_type(4)));
typedef float f32x16 __attribute__((ext_vector_type(16)));
typedef unsigned u32x2 __attribute__((ext_vector_type(2)));
typedef unsigned u32x4 __attribute__((ext_vector_type(4)));
typedef __bf16 bf16x2_n __attribute__((ext_vector_type(2)));

constexpr int D = 1024, NB = 8, SEQ = 2048, LC = 256, NX = NB * SEQ, NC = NB * LC, MT = NX + NC;
constexpr int NU = 1792;
constexpr int KO = 1280;
constexpr int NE = 32, DE = 512, NHEAD = 8;
constexpr int MAXT = 176;
constexpr float QSCALE = 0.125f * 1.4426950408889634f;
constexpr float LOG2E = 1.4426950408889634f;

constexpr size_t MiB = 1u << 20;
constexpr size_t WS_CTL = 0, CTL_ZERO_BYTES = 1 * MiB;
constexpr size_t WS_MOD = 1 * MiB;
constexpr size_t WS_MODP = 2 * MiB;
constexpr size_t WS_MW = 16 * MiB;
constexpr size_t WS_WRT = 17 * MiB;
constexpr size_t WS_ROUTE = 18 * MiB;
constexpr size_t WS_ROWLIST = 19 * MiB;
constexpr size_t WS_ADFTC = 22 * MiB;
constexpr size_t WS_ADFTX = 23 * MiB;
constexpr size_t WS_WIN = 39 * MiB;
constexpr size_t WS_WOUT = 49 * MiB;
constexpr size_t WS_WGU = 54 * MiB;
constexpr size_t WS_WD = 182 * MiB;
constexpr size_t WS_H1 = 246 * MiB;
constexpr size_t WS_U = 282 * MiB;
constexpr size_t WS_Y2 = WS_U;
constexpr size_t WS_VTX = 354 * MiB;
constexpr size_t WS_VTC = 370 * MiB;
constexpr size_t WS_FTX = 372 * MiB;
constexpr size_t WS_FTC = 380 * MiB;
constexpr size_t WS_CONC = 381 * MiB;
constexpr size_t WS_H = WS_FTX;
constexpr size_t WS_X1 = 426 * MiB;
constexpr size_t WS_END = 498 * MiB;
static_assert(WS_H + (size_t)MAXT * 256 * 512 * 2 <= WS_X1, "H overlay");
static_assert(WS_Y2 + (size_t)MT * 2 * 1024 * 2 <= WS_VTX, "y2 overlay");

constexpr int CW_BAR = 4096;
constexpr int CW_ATTQ = 8192;
constexpr int CW_CNT = 16384;

constexpr int RING_BYTES = 131072, MISC_OFF = RING_BYTES, LDS_BYTES = 147456;
constexpr int MO_TCNT = 64, MO_TBASE = 192, MO_LCNT = 384, MO_LBASE = 512, MO_IDX = 1024, MO_RROW = 4096;

__device__ __forceinline__ unsigned cvtpk(float lo, float hi) { f32x2 v = {lo, hi}; bf16x2_n b = __builtin_convertvector(v, bf16x2_n); return __builtin_bit_cast(unsigned, b); }
__device__ __forceinline__ float bf2f(unsigned short b) { return __uint_as_float(((unsigned)b) << 16); }
__device__ __forceinline__ float bflo(unsigned w) { return __uint_as_float(w << 16); }
__device__ __forceinline__ float bfhi(unsigned w) { return __uint_as_float(w & 0xffff0000u); }
__device__ __forceinline__ float wave_sum(float v) {
#pragma unroll
    for (int o = 1; o < 64; o <<= 1) v += __shfl_xor(v, o);
    return v;
}
#define LDS_WAIT() asm volatile("s_waitcnt lgkmcnt(0)" ::: "memory")
#define VM_WAIT() asm volatile("s_waitcnt vmcnt(0)" ::: "memory")

#define XB_TMO      128
#define XB_XCNT(j)  (256  + 64 * (j))
#define XB_XSUB(j)  (1280 + 64 * (j))
#define XB_XGEN(j)  (2304 + 64 * (j))
#define XB_TOP      3328
#define XB_TOPGEN   3392
#define XCD_BAR_WORDS 3456
#define XB_SPIN_CAP (1u << 18)
__device__ __forceinline__ unsigned xb_ld(unsigned* p)              { return __hip_atomic_load(p, __ATOMIC_RELAXED, __HIP_MEMORY_SCOPE_AGENT); }
__device__ __forceinline__ unsigned xb_add(unsigned* p, unsigned v) { return __hip_atomic_fetch_add(p, v, __ATOMIC_RELAXED, __HIP_MEMORY_SCOPE_AGENT); }
__device__ __forceinline__ unsigned xb_xcc_id() { return (unsigned)__builtin_amdgcn_s_getreg((3 << 11) | 20) & 0xFu; }
#define XB_SPIN(cond, bar) do { unsigned _sp = 0; while (cond) { __builtin_amdgcn_s_sleep(1); \
    if ((++_sp & 255u) == 0u) { if (xb_ld(&(bar)[XB_TMO])) break; if (_sp > XB_SPIN_CAP) { atomicAdd(&(bar)[XB_TMO], 1u); break; } } } } while (0)
struct XcdBarrier { unsigned* bar; unsigned x; volatile LAS unsigned* st; };
__device__ __forceinline__ XcdBarrier xcd_barrier_post(unsigned* bar, volatile LAS unsigned* st) {
    XcdBarrier b; b.bar = bar; b.x = xb_xcc_id(); b.st = st;
    if (threadIdx.x == 0) (void)xb_add(&bar[XB_XCNT(b.x)], 1u);
    return b;
}
__device__ __forceinline__ void xcd_barrier_complete(unsigned* bar, unsigned x, unsigned& nloc, unsigned& nx) {
    const unsigned G = gridDim.x * gridDim.y * gridDim.z;
    unsigned sum, cnt, mine, sp = 0u;
    for (;;) {
        sum = 0u; cnt = 0u; mine = 0u;
#pragma unroll
        for (unsigned j = 0; j < 16; ++j) { const unsigned c = xb_ld(&bar[XB_XCNT(j)]); sum += c; cnt += (c > 0u) ? 1u : 0u; mine = (j == x) ? c : mine; }
        if (sum == G) break;
        __builtin_amdgcn_s_sleep(1);
        if ((++sp & 255u) == 0u) { if (xb_ld(&bar[XB_TMO])) break; if (sp > XB_SPIN_CAP) { atomicAdd(&bar[XB_TMO], 1u); break; } }
    }
    nloc = mine > 0u ? mine : 1u; nx = cnt > 0u ? cnt : 1u;
}
__device__ __forceinline__ void xcd_barrier(const XcdBarrier& b) {
    asm volatile("s_waitcnt vmcnt(0)" ::: "memory");
    __syncthreads();
    if (threadIdx.x == 0) {
        unsigned* bar = b.bar;
        __builtin_amdgcn_s_waitcnt(0);
        unsigned nloc = b.st[0], nx = b.st[1];
        if (nloc == 0u) { xcd_barrier_complete(bar, b.x, nloc, nx); b.st[0] = nloc; b.st[1] = nx; }
        const unsigned old = xb_add(&bar[XB_XSUB(b.x)], 1u);
        const unsigned gen = old / nloc;
        if (old + 1u == (gen + 1u) * nloc) {
            __builtin_amdgcn_fence(__ATOMIC_RELEASE, "agent");
            asm volatile("s_waitcnt vmcnt(0)" ::: "memory");
            const unsigned og = xb_add(&bar[XB_TOP], 1u);
            const unsigned tg = og / nx;
            if (og + 1u == (tg + 1u) * nx) xb_add(&bar[XB_TOPGEN], 1u);
            else XB_SPIN(xb_ld(&bar[XB_TOPGEN]) == tg, bar);
            __builtin_amdgcn_fence(__ATOMIC_ACQUIRE, "agent");
            xb_add(&bar[XB_XGEN(b.x)], 1u);
            asm volatile("s_waitcnt vmcnt(0)" ::: "memory");
        } else {
            XB_SPIN(xb_ld(&bar[XB_XGEN(b.x)]) == gen, bar);
            __builtin_amdgcn_fence(__ATOMIC_ACQUIRE, "agent");
            asm volatile("s_waitcnt vmcnt(0)" ::: "memory");
        }
    }
    __syncthreads();
}

namespace pg8 {
constexpr int BM = 256, BK = 64, HALF = 128, HTB = HALF * BK * 2, STAGE_BYTES = 8 * HTB, NXCD = 8, WGM = 8;
__host__ __device__ __forceinline__ int lds_byte(int r, int c) { const int st = (r >> 4) * 2 + (c >> 5), rr = r & 15, cc = c & 31, ob = rr * 64 + cc * 2; return st * 1024 + (ob ^ (((ob >> 9) & 1) << 5)); }
__host__ __device__ __forceinline__ void stage_rc(int b, int& R, int& C) { const int st = b / 1024, sb = b % 1024, swz = sb ^ (((sb >> 9) & 1) << 5); R = (st >> 1) * 16 + swz / 64; C = (st & 1) * 32 + (swz % 64) / 2; }
__host__ __device__ __forceinline__ int perm32(int rho) { const int n = rho >> 4, i = rho & 15; return 8 * (i >> 2) + 4 * n + (i & 3); }

struct Unit { int pm, pn, aux; const char* A; const char* B; };

template <class Epi, class Sched, bool GATHER, bool ALIGN_EPI, int K>
__device__ __forceinline__ void gemm_phase(LAS unsigned char* lds, const Sched& S, const Epi& E) {
    int tid_ = threadIdx.x; asm volatile("" : "+v"(tid_));
    const int tid = tid_, wid = __builtin_amdgcn_readfirstlane(tid >> 6), lane = tid & 63, wr = wid >> 2, wc = wid & 3, fr = lane & 15, fq = lane >> 4;
    constexpr int nt = K / BK;
    int R0, C0; stage_rc(tid * 16, R0, C0);
    unsigned voffA[2], voffB[2];
#pragma unroll
    for (int i = 0; i < 2; ++i) { const int R = R0 + 64 * i; const int Rb = Epi::PERM ? ((R & ~31) + perm32(R & 31)) : R;
        voffA[i] = (unsigned)(R * K + C0) * 2u; voffB[i] = (unsigned)(Rb * K + C0) * 2u; }
    unsigned cvA0[2] = {0u, 0u}, cvA1[2] = {0u, 0u}, nvA0[2] = {0u, 0u}, nvA1[2] = {0u, 0u};
    const size_t kstep = (size_t)(BK * 2);
    const size_t hstep = (size_t)HALF * K * 2;
    const unsigned ldsw = (unsigned)wid * 1024u;
    const int aoff = lds_byte(wr * 64 + fr, fq * 8), boff = lds_byte(wc * 32 + fr, fq * 8);
#define PG8_SA(b, h) (((b) * 2 + (h)) * HTB)
#define PG8_SB(b, h) ((4 + (b) * 2 + (h)) * HTB)
#define PG8_STAGE(bufoff, gbase, voff) do { _Pragma("unroll") for (int _i = 0; _i < 2; ++_i) \
        __builtin_amdgcn_global_load_lds((const unsigned*)((const char*)(gbase) + (voff)[_i]), (LAS unsigned*)(lds + (bufoff) + ldsw + _i * 8192), 16, 0, 0); } while (0)
#define PG8_STAGE_A(b, h, gbase, g0, g1) do { if constexpr (GATHER) { if ((h) == 0) PG8_STAGE(PG8_SA(b, 0), gbase, g0); else PG8_STAGE(PG8_SA(b, 1), gbase, g1); } \
        else { PG8_STAGE(PG8_SA(b, h), (gbase) + ((h) ? hstep : 0), voffA); } } while (0)
#define PG8_ROWS(u, v0, v1) do { _Pragma("unroll") for (int _i = 0; _i < 2; ++_i) { v0[_i] = (unsigned)(S.arow(u, R0 + 64 * _i) * K + C0) * 2u; v1[_i] = (unsigned)(S.arow(u, 128 + R0 + 64 * _i) * K + C0) * 2u; } } while (0)
#define PG8_LDA(dst, b, h) do { _Pragma("unroll") for (int m = 0; m < 4; ++m) _Pragma("unroll") for (int k = 0; k < 2; ++k) dst[m][k] = *(const LAS bf16x8*)(lds + PG8_SA(b, h) + aoff + m * 2048 + k * 1024); } while (0)
#define PG8_LDB(dst, b, h) do { _Pragma("unroll") for (int n = 0; n < 2; ++n) _Pragma("unroll") for (int k = 0; k < 2; ++k) dst[n][k] = *(const LAS bf16x8*)(lds + PG8_SB(b, h) + boff + n * 2048 + k * 1024); } while (0)
#define PG8_MMA(ai, bj, At, Bt) do { __builtin_amdgcn_s_setprio(1); _Pragma("unroll") for (int m = 0; m < 4; ++m) _Pragma("unroll") for (int n = 0; n < 2; ++n) _Pragma("unroll") for (int k = 0; k < 2; ++k) \
        acc[ai][bj][m][n] = __builtin_amdgcn_mfma_f32_16x16x32_bf16(Bt[n][k], At[m][k], acc[ai][bj][m][n], 0, 0, 0); __builtin_amdgcn_s_setprio(0); } while (0)
#define PG8_WAIT_V(n) asm volatile("s_waitcnt vmcnt(" #n ")" ::: "memory")
#define PG8_WAIT_L(n) asm volatile("s_waitcnt lgkmcnt(" #n ")" ::: "memory")
#define PG8_BAR __builtin_amdgcn_s_barrier()
#define PG8_SCHED __builtin_amdgcn_sched_barrier(0)
    Unit cur, nxt; int ui = 0;
    if (!S.next(0, cur)) return;
    f32x4 acc[2][2][4][2];
#pragma unroll
    for (int a = 0; a < 2; ++a)
#pragma unroll
        for (int b = 0; b < 2; ++b)
#pragma unroll
            for (int m = 0; m < 4; ++m)
#pragma unroll
                for (int n = 0; n < 2; ++n) acc[a][b][m][n] = (f32x4){0.f, 0.f, 0.f, 0.f};
    bf16x8 At[4][2], B0[2][2], B1[2][2];
    const char* cA = cur.A; const char* cB = cur.B;
    if constexpr (GATHER) { PG8_ROWS(cur, cvA0, cvA1); }
    PG8_STAGE(PG8_SB(0, 0), cB, voffB); PG8_STAGE(PG8_SB(0, 1), cB + hstep, voffB); PG8_STAGE_A(0, 0, cA, cvA0, cvA1); PG8_STAGE_A(0, 1, cA, cvA0, cvA1);
    if (wr == 1) PG8_BAR;
    PG8_WAIT_V(2); PG8_BAR;
    PG8_STAGE(PG8_SB(1, 0), cB + kstep, voffB); PG8_STAGE_A(1, 0, cA + kstep, cvA0, cvA1); PG8_STAGE(PG8_SB(1, 1), cB + hstep + kstep, voffB);
    PG8_WAIT_V(6); PG8_BAR;
    for (;;) {
        const bool has_next = S.next(ui + 1, nxt);
        const char* nA = has_next ? nxt.A : cA; const char* nB = has_next ? nxt.B : cB;
        if constexpr (GATHER) { if (has_next) { PG8_ROWS(nxt, nvA0, nvA1); } else {
#pragma unroll
            for (int i = 0; i < 2; ++i) { nvA0[i] = cvA0[i]; nvA1[i] = cvA1[i]; } } }
        for (int t = 0; t < nt; t += 2) {
            const bool last = (t == nt - 2);
            const char* a1 = cA + (size_t)(t + 1) * kstep;
            const char* a2 = last ? nA : cA + (size_t)(t + 2) * kstep; const char* b2 = last ? nB : cB + (size_t)(t + 2) * kstep;
            const char* a3 = a2 + kstep; const char* b3 = b2 + kstep;
            unsigned sA0[2], sA1[2];
#pragma unroll
            for (int i = 0; i < 2; ++i) { sA0[i] = last ? nvA0[i] : cvA0[i]; sA1[i] = last ? nvA1[i] : cvA1[i]; }
            PG8_LDB(B0, 0, 0); PG8_LDB(B1, 0, 1); PG8_SCHED; PG8_LDA(At, 0, 0); PG8_STAGE_A(1, 1, a1, cvA0, cvA1);
            PG8_WAIT_V(8); PG8_WAIT_L(0); PG8_BAR; PG8_MMA(0, 0, At, B0); PG8_MMA(0, 1, At, B1); PG8_BAR; PG8_SCHED;
            PG8_LDA(At, 0, 1); PG8_STAGE(PG8_SB(0, 0), b2, voffB); PG8_STAGE(PG8_SB(0, 1), b2 + hstep, voffB); PG8_STAGE_A(0, 0, a2, sA0, sA1);
            PG8_WAIT_V(8); PG8_WAIT_L(0); PG8_BAR; PG8_MMA(1, 0, At, B0); PG8_MMA(1, 1, At, B1); PG8_BAR; PG8_SCHED;
            PG8_LDB(B0, 1, 0); PG8_LDB(B1, 1, 1); PG8_SCHED; PG8_LDA(At, 1, 0); PG8_STAGE_A(0, 1, a2, sA0, sA1);
            PG8_WAIT_V(8); PG8_WAIT_L(0); PG8_BAR; PG8_MMA(0, 0, At, B0); PG8_MMA(0, 1, At, B1); PG8_BAR; PG8_SCHED;
            PG8_LDA(At, 1, 1); PG8_STAGE(PG8_SB(1, 0), b3, voffB); PG8_STAGE(PG8_SB(1, 1), b3 + hstep, voffB); PG8_STAGE_A(1, 0, a3, sA0, sA1);
            PG8_WAIT_V(8); PG8_WAIT_L(0); PG8_BAR; PG8_MMA(1, 0, At, B0); PG8_MMA(1, 1, At, B1); PG8_BAR; PG8_SCHED;
        }
        if constexpr (ALIGN_EPI) { if (wr == 0) PG8_BAR; }
        E(acc, cur, wr, wc, fr, fq);
        if (!has_next) break;
#pragma unroll
        for (int a = 0; a < 2; ++a)
#pragma unroll
            for (int b = 0; b < 2; ++b)
#pragma unroll
                for (int m = 0; m < 4; ++m)
#pragma unroll
                    for (int n = 0; n < 2; ++n) acc[a][b][m][n] = (f32x4){0.f, 0.f, 0.f, 0.f};
        cur = nxt; cA = nA; cB = nB; ++ui;
        if constexpr (GATHER) {
#pragma unroll
            for (int i = 0; i < 2; ++i) { cvA0[i] = nvA0[i]; cvA1[i] = nvA1[i]; } }
        if constexpr (ALIGN_EPI) { if (wr == 1) PG8_BAR; }
    }
    PG8_WAIT_V(0);
    if constexpr (!ALIGN_EPI) { if (wr == 0) PG8_BAR; }
    PG8_BAR;
#undef PG8_SA
#undef PG8_SB
#undef PG8_STAGE
#undef PG8_STAGE_A
#undef PG8_ROWS
#undef PG8_LDA
#undef PG8_LDB
#undef PG8_MMA
#undef PG8_WAIT_V
#undef PG8_WAIT_L
#undef PG8_BAR
#undef PG8_SCHED
}

struct SchedRect {
    const char* A; const char* B; size_t tA, tB; int nM, nN, nwg, G, c;
    __device__ __forceinline__ void init(const void* A_, const void* B_, int M, int N, int K, int G_, int c_) { A = (const char*)A_; B = (const char*)B_; tA = tB = (size_t)BM * K * 2; nM = M / BM; nN = N / BM; nwg = nM * nN; G = G_; c = c_; }
    __device__ __forceinline__ bool next(int i, Unit& u) const {
        const long L = (long)i * G + c; if (L >= nwg) return false;
        int wgid = (int)L; { const int q = nwg / NXCD, r = nwg % NXCD, xcd = wgid % NXCD, off = wgid / NXCD; wgid = (xcd < r ? xcd * (q + 1) : r * (q + 1) + (xcd - r) * q) + off; }
        const int nig = WGM * nN, gid = wgid / nig, fm = gid * WGM, gsz = (nM - fm) < WGM ? (nM - fm) : WGM;
        u.pm = fm + ((wgid % nig) % gsz); u.pn = (wgid % nig) / gsz; u.aux = 0; u.A = A + (size_t)u.pm * tA; u.B = B + (size_t)u.pn * tB; return true;
    }
    __device__ __forceinline__ int arow(const Unit&, int) const { return 0; }
};
struct SchedOne {
    bool has; Unit u0;
    __device__ __forceinline__ bool next(int i, Unit& u) const { if (i > 0 || !has) return false; u = u0; return true; }
    __device__ __forceinline__ int arow(const Unit&, int) const { return 0; }
};
struct SchedMoe {
    const LAS int* tbase; const LAS int* idx; const char* A; const char* B; size_t tA, eB, tB; int G, c, ntiles; bool gather;
    __device__ __forceinline__ bool next(int i, Unit& u) const {
        const int L = i * G + c, T = L >> 2; if (T >= ntiles) return false;
        int e = 0;
#pragma unroll 1
        for (int j = 1; j < 32; ++j) e += (tbase[j] <= T) ? 1 : 0;
        e = __builtin_amdgcn_readfirstlane(e);
        u.pm = T; u.pn = L & 3; u.aux = e | (i << 8); u.A = gather ? A : A + (size_t)T * tA; u.B = B + (size_t)e * eB + (size_t)(L & 3) * tB; return true;
    }
    __device__ __forceinline__ int arow(const Unit& u, int r) const { return idx[(u.aux >> 8) * 256 + r]; }
};

struct EpiBf16 {
    static constexpr bool PERM = true;
    bf16_t* O; int ldc;
    __device__ __forceinline__ void operator()(const f32x4 (&acc)[2][2][4][2], const Unit& u, int wr, int wc, int fr, int fq) const {
        const int row0 = u.pm * BM + wr * 64 + fr, col0 = u.pn * BM + wc * 32 + 8 * fq;
#pragma unroll
        for (int ai = 0; ai < 2; ++ai)
#pragma unroll
            for (int m = 0; m < 4; ++m) { bf16_t* rowp = O + (size_t)(row0 + ai * HALF + m * 16) * ldc + col0;
#pragma unroll
                for (int bj = 0; bj < 2; ++bj) { const f32x4 v0 = acc[ai][bj][m][0], v1 = acc[ai][bj][m][1];
                    u32x4 w; w.x = cvtpk(v0[0], v0[1]); w.y = cvtpk(v0[2], v0[3]); w.z = cvtpk(v1[0], v1[1]); w.w = cvtpk(v1[2], v1[3]);
                    *(u32x4*)(rowp + bj * HALF) = w; } }
    }
};
struct EpiT {
    static constexpr bool PERM = true;
    bf16_t *ftx, *ftc, *vtx, *vtc;
    __device__ __forceinline__ void operator()(const f32x4 (&acc)[2][2][4][2], const Unit& u, int wr, int wc, int fr, int fq) const {
        bf16_t* base; int pitch;
        const int b = (u.pn < 64) ? (u.pn >> 3) : (u.pn - 64);
        if (u.pm == 0) { if (u.pn < 64) { base = ftx + (size_t)b * 256 * 2048 + (u.pn & 7) * 256; pitch = 2048; } else { base = ftc + (size_t)b * 256 * 256; pitch = 256; } }
        else { const int v0 = (u.pm - 1) * 256; if (u.pn < 64) { base = vtx + ((size_t)b * 512 + v0) * 2048 + (u.pn & 7) * 256; pitch = 2048; } else { base = vtc + ((size_t)b * 512 + v0) * 256; pitch = 256; } }
        const int row0 = wr * 64 + fr, col0 = wc * 32 + 8 * fq;
#pragma unroll
        for (int ai = 0; ai < 2; ++ai)
#pragma unroll
            for (int m = 0; m < 4; ++m) { bf16_t* rowp = base + (size_t)(row0 + ai * HALF + m * 16) * pitch + col0;
#pragma unroll
                for (int bj = 0; bj < 2; ++bj) { const f32x4 v0 = acc[ai][bj][m][0], v1 = acc[ai][bj][m][1];
                    u32x4 w; w.x = cvtpk(v0[0], v0[1]); w.y = cvtpk(v0[2], v0[3]); w.z = cvtpk(v1[0], v1[1]); w.w = cvtpk(v1[2], v1[3]);
                    *(u32x4*)(rowp + bj * HALF) = w; } }
    }
};
struct EpiDft {
    static constexpr bool PERM = true;
    bf16_t* conc; int ktiles;
    __device__ __forceinline__ void operator()(const f32x4 (&acc)[2][2][4][2], const Unit& u, int wr, int wc, int fr, int fq) const {
        const int cs = u.pm / ktiles, kt = u.pm % ktiles;
        bf16_t* base = conc + ((size_t)u.pn * (ktiles * 256) + kt * 256) * KO + cs * 256;
        const int row0 = wr * 64 + fr, col0 = wc * 32 + 8 * fq;
#pragma unroll
        for (int ai = 0; ai < 2; ++ai)
#pragma unroll
            for (int m = 0; m < 4; ++m) { bf16_t* rowp = base + (size_t)(row0 + ai * HALF + m * 16) * KO + col0;
#pragma unroll
                for (int bj = 0; bj < 2; ++bj) { const f32x4 v0 = acc[ai][bj][m][0], v1 = acc[ai][bj][m][1];
                    u32x4 w; w.x = cvtpk(v0[0], v0[1]); w.y = cvtpk(v0[2], v0[3]); w.z = cvtpk(v1[0], v1[1]); w.w = cvtpk(v1[2], v1[3]);
                    *(u32x4*)(rowp + bj * HALF) = w; } }
    }
};
struct EpiOut {
    static constexpr bool PERM = false;
    float* x1; const float* xin; const float* cin; const float* mod;
    __device__ __forceinline__ void operator()(const f32x4 (&acc)[2][2][4][2], const Unit& u, int wr, int wc, int fr, int fq) const {
        const int rr = (u.pm < 64) ? (u.pm >> 3) : 8;
        const int row0 = u.pm * BM + wr * 64 + fr, col0 = u.pn * BM + wc * 32 + 4 * fq;
        const float* res = xin ? ((u.pm < 64) ? xin + (size_t)row0 * D : cin + (size_t)(row0 - NX) * D) : x1 + (size_t)row0 * D;
        const float* g1 = mod + rr * 6144 + 2 * D + col0;
        f32x4 gv[2][2];
#pragma unroll
        for (int bj = 0; bj < 2; ++bj)
#pragma unroll
            for (int n = 0; n < 2; ++n) gv[bj][n] = *(const f32x4*)(g1 + bj * HALF + n * 16);
#pragma unroll
        for (int ai = 0; ai < 2; ++ai)
#pragma unroll
            for (int m = 0; m < 4; ++m) { const size_t ro = (size_t)(ai * HALF + m * 16) * D + col0; float* op = x1 + (size_t)row0 * D + ro;
#pragma unroll
                for (int bj = 0; bj < 2; ++bj)
#pragma unroll
                    for (int n = 0; n < 2; ++n) { const f32x4 r = *(const f32x4*)(res + ro + bj * HALF + n * 16);
                        *(f32x4*)(op + bj * HALF + n * 16) = r + gv[bj][n] * acc[ai][bj][m][n]; } }
    }
};
struct EpiUp {
    static constexpr bool PERM = false;
    bf16_t* H;
    __device__ __forceinline__ void operator()(const f32x4 (&acc)[2][2][4][2], const Unit& u, int wr, int wc, int fr, int fq) const {
        const int row0 = u.pm * BM + wr * 64 + fr;
#pragma unroll
        for (int ai = 0; ai < 2; ++ai)
#pragma unroll
            for (int m = 0; m < 4; ++m) { bf16_t* rowp = H + (size_t)(row0 + ai * HALF + m * 16) * DE;
#pragma unroll
                for (int bj = 0; bj < 2; ++bj) { const int hid = 16 * (8 * u.pn + 4 * bj + wc) + 4 * fq;
                    const f32x4 g = acc[ai][bj][m][0], up = acc[ai][bj][m][1]; float h[4];
#pragma unroll
                    for (int j = 0; j < 4; ++j) h[j] = g[j] / (1.f + __expf(-g[j])) * up[j];
                    u32x2 w; w.x = cvtpk(h[0], h[1]); w.y = cvtpk(h[2], h[3]);
                    *(u32x2*)(rowp + hid) = w; } }
    }
};
struct EpiDown {
    static constexpr bool PERM = true;
    bf16_t* y2; const int* rowlist; const float* tokw; const float* mod; const LAS int* tcnt; const LAS int* tbase;
    __device__ __forceinline__ void operator()(const f32x4 (&acc)[2][2][4][2], const Unit& u, int wr, int wc, int fr, int fq) const {
        const int e = u.aux & 255, cnt = tcnt[e], j0 = (u.pm - tbase[e]) * 256 + wr * 64 + fr;
        const int col0 = u.pn * BM + wc * 32 + 8 * fq;
#pragma unroll
        for (int ai = 0; ai < 2; ++ai)
#pragma unroll
            for (int m = 0; m < 4; ++m) { const int j = j0 + ai * HALF + m * 16;
                if (j < cnt) { const int ts = rowlist[(size_t)e * MT + j]; const int tok = ts >> 1; const float pw = tokw[ts];
                    const int rr = (tok < NX) ? (tok >> 11) : 8; const float* g2 = mod + rr * 6144 + 5 * D + col0; bf16_t* rowp = y2 + (size_t)ts * D + col0;
#pragma unroll
                    for (int bj = 0; bj < 2; ++bj) { const f32x4 ga = *(const f32x4*)(g2 + bj * HALF), gb = *(const f32x4*)(g2 + bj * HALF + 4);
                        const f32x4 v0 = acc[ai][bj][m][0] * ga * pw, v1 = acc[ai][bj][m][1] * gb * pw;
                        u32x4 w; w.x = cvtpk(v0[0], v0[1]); w.y = cvtpk(v0[2], v0[3]); w.z = cvtpk(v1[0], v1[1]); w.w = cvtpk(v1[2], v1[3]);
                        *(u32x4*)(rowp + bj * HALF) = w; } } }
    }
};
}

struct Params {
    const float *x, *c, *ctx, *c_ctx, *w_ada, *b_ada, *norm1, *norm2, *w_in, *w_fourier, *w_conv, *rpb, *w_out, *w_rg, *b_rg, *w_re, *b_re, *w_gate, *w_up, *w_down, *norm_final;
    float* out; unsigned char* ws; int ph_lo, ph_hi;
};
typedef const __attribute__((address_space(4))) Params CP;
__device__ __forceinline__ CP* opaque_args(CP* p) { asm volatile("" : "+s"(p)); return p; }
struct Ctx { LAS unsigned char* lds; int tid, lane, wave, G, vcu, gw, ngw; };
__device__ __forceinline__ Ctx reopaque(const Ctx& c) { Ctx r = c; int t = threadIdx.x; asm volatile("" : "+v"(t)); r.tid = t; r.lane = t & 63; return r; }

__device__ __forceinline__ void tr_item(const float* src, int ldn, int k0, int n0, bf16_t* dst, int ldk, int kd0, int rtype, LAS float* scr, int lane) {
#pragma unroll 8
    for (int i = 0; i < 32; ++i) { const int kk = 2 * i + (lane >> 5); scr[kk * 33 + (lane & 31)] = src[(size_t)(k0 + kk) * ldn + n0 + (lane & 31)]; }
    LDS_WAIT(); asm volatile("" ::: "memory");
    const int c = lane & 7;
#pragma unroll
    for (int j = 0; j < 4; ++j) { const int n = (lane >> 3) + 8 * j; const LAS float* s = scr + (8 * c) * 33 + n;
        const int sn = n0 + n; int dr; float sc = 1.f;
        if (rtype == 0) { dr = (sn < 256) ? sn : (sn < 1280 ? sn + 512 : (sn < 1792 ? sn - 1024 : sn)); if (sn >= 256 && sn < 768) sc = QSCALE; }
        else if (rtype == 2) dr = 32 * (sn >> 4) + (sn & 15);
        else if (rtype == 3) dr = 32 * (sn >> 4) + 16 + (sn & 15);
        else dr = sn;
        u32x4 o; o.x = cvtpk(s[0 * 33] * sc, s[1 * 33] * sc); o.y = cvtpk(s[2 * 33] * sc, s[3 * 33] * sc); o.z = cvtpk(s[4 * 33] * sc, s[5 * 33] * sc); o.w = cvtpk(s[6 * 33] * sc, s[7 * 33] * sc);
        *(u32x4*)(dst + (size_t)dr * ldk + kd0 + 8 * c) = o; }
    LDS_WAIT(); asm volatile("" ::: "memory");
}
__device__ __forceinline__ void phase_p0a(CP* p0, const Ctx& cx0) {
    const Ctx cx = reopaque(cx0); CP* p = opaque_args(p0);
    LAS float* T = (LAS float*)(cx.lds + 69632);
    LAS float* sl = (LAS float*)(cx.lds + 69632 + 8192);
    LAS float* scr = (LAS float*)(cx.lds + cx.wave * 8448);
    unsigned char* ws = p->ws;
    for (int j = cx.tid; j < 2048; j += 512) T[j] = cospif((float)j * (1.0f / 1024.0f));
    __syncthreads();
    const int gt = cx.vcu * 512 + cx.tid, ngt = cx.G * 512;
    { bf16_t* AX = (bf16_t*)(ws + WS_ADFTX); const float SX = 0.0027621358640099513f;
      for (int it = gt; it < 4096 * 256; it += ngt) { const int R = it >> 8, n0 = (it & 255) * 8, cs = R >> 11, k = R & 2047; float v[8];
#pragma unroll
          for (int j = 0; j < 8; ++j) { const int idx = (k * (n0 + j)) & 2047; v[j] = T[cs ? ((idx - 512) & 2047) : idx] * SX; }
          u32x4 o; o.x = cvtpk(v[0], v[1]); o.y = cvtpk(v[2], v[3]); o.z = cvtpk(v[4], v[5]); o.w = cvtpk(v[6], v[7]);
          *(u32x4*)(AX + (size_t)R * 2048 + n0) = o; }
      bf16_t* AC = (bf16_t*)(ws + WS_ADFTC); const float SC = 1.0f / 128.0f;
      for (int it = gt; it < 512 * 32; it += ngt) { const int R = it >> 5, n0 = (it & 31) * 8, cs = R >> 8, k = R & 255; float v[8];
#pragma unroll
          for (int j = 0; j < 8; ++j) { const int idx = (8 * k * (n0 + j)) & 2047; v[j] = T[cs ? ((idx - 512) & 2047) : idx] * SC; }
          u32x4 o; o.x = cvtpk(v[0], v[1]); o.y = cvtpk(v[2], v[3]); o.z = cvtpk(v[4], v[5]); o.w = cvtpk(v[6], v[7]);
          *(u32x4*)(AC + (size_t)R * 256 + n0) = o; } }
    { float* MW = (float*)(ws + WS_MW);
      for (int it = gt; it < 2 * 512 * 256; it += ngt) { const int j = it & 255, kp = (it >> 8) & 511, li = it >> 17, cs = kp >> 8, g = (kp >> 6) & 3, cc = kp & 63;
          const float* wf = p->w_fourier + (size_t)li * 65536 + (size_t)(64 * g) * 256 + j; float a = 0.f;
          for (int l = 0; l < 64; ++l) { const int idx = (32 * l * cc) & 2047; const float mix = cs ? -T[(idx - 512) & 2047] : T[idx]; a += mix * wf[l * 256]; }
          MW[it] = a; } }
    { float* WR = (float*)(ws + WS_WRT);
      for (int it = gt; it < 2 * 36 * 1024; it += ngt) { const int k = it & 1023, c = (it >> 10) % 36, li = it / 36864;
          WR[it] = (c < 4) ? p->w_rg[(size_t)li * 4096 + k * 4 + c] : p->w_re[(size_t)li * 32768 + k * 32 + (c - 4)]; } }
    { float* MP = (float*)(ws + WS_MODP);
      for (int u = cx.vcu; u < 768; u += cx.G) { const int kc = u & 31, jc = (u >> 5) % 12, li = u / 384;
          __syncthreads();
          if (cx.tid < 288) { const int r = cx.tid >> 5, kk = cx.tid & 31, k = kc * 32 + kk; const float v = (r < 8) ? p->c[r * 1024 + k] : p->c_ctx[k]; sl[cx.tid] = v / (1.f + __expf(-v)); }
          __syncthreads();
          const int j = jc * 512 + cx.tid; float a[9];
#pragma unroll
          for (int r = 0; r < 9; ++r) a[r] = 0.f;
          const float* wp = p->w_ada + ((size_t)li * 1024 + kc * 32) * 6144 + j;
#pragma unroll 8
          for (int kk = 0; kk < 32; ++kk) { const float w = wp[(size_t)kk * 6144];
#pragma unroll
              for (int r = 0; r < 9; ++r) a[r] += sl[r * 32 + kk] * w; }
#pragma unroll
          for (int r = 0; r < 9; ++r) MP[((size_t)(li * 32 + kc) * 9 + r) * 6144 + j] = a[r]; }
      __syncthreads(); }
    { bf16_t* WIN = (bf16_t*)(ws + WS_WIN); bf16_t* WOUT = (bf16_t*)(ws + WS_WOUT); bf16_t* WGU = (bf16_t*)(ws + WS_WGU); bf16_t* WDN = (bf16_t*)(ws + WS_WD);
      constexpr int I0 = 2 * 1280, I1 = 2 * 384, I2 = 64 * 256;
      for (int it = cx.gw; it < I0 + I1 + 3 * I2; it += cx.ngw) { int r = it;
          if (r < I0) { const int li = r / 1280, q = r % 1280, kb = q / 80, nb = q % 80;
              tr_item(p->w_in + (size_t)li * 1024 * 2560, 2560, kb * 64, nb * 32, WIN + (size_t)li * 2560 * 1024, 1024, kb * 64, 0, scr, cx.lane); continue; } r -= I0;
          if (r < I1) { const int li = r / 384, q = r % 384, kb = q / 32, nb = q % 32;
              tr_item(p->w_out + (size_t)li * 1024 * 1024, 1024, 256 + kb * 64, nb * 32, WOUT + (size_t)li * 1024 * 1280, 1280, 512 + kb * 64, 1, scr, cx.lane); continue; } r -= I1;
          if (r < I2) { const int le = r >> 8, q = r & 255, kb = q >> 4, nb = q & 15;
              tr_item(p->w_gate + (size_t)le * 1024 * 512, 512, kb * 64, nb * 32, WGU + (size_t)le * 1024 * 1024, 1024, kb * 64, 2, scr, cx.lane); continue; } r -= I2;
          if (r < I2) { const int le = r >> 8, q = r & 255, kb = q >> 4, nb = q & 15;
              tr_item(p->w_up + (size_t)le * 1024 * 512, 512, kb * 64, nb * 32, WGU + (size_t)le * 1024 * 1024, 1024, kb * 64, 3, scr, cx.lane); continue; } r -= I2;
          { const int le = r >> 8, q = r & 255, kb = q >> 5, nb = q & 31;
              tr_item(p->w_down + (size_t)le * 512 * 1024, 1024, kb * 64, nb * 32, WDN + (size_t)le * 1024 * 512, 512, kb * 64, 4, scr, cx.lane); } } }
}
__device__ __forceinline__ void phase_p0b(CP* p0, const Ctx& cx0) {
    const Ctx cx = reopaque(cx0); CP* p = opaque_args(p0);
    unsigned char* ws = p->ws; const int gt = cx.vcu * 512 + cx.tid, ngt = cx.G * 512;
    { const float* MP = (const float*)(ws + WS_MODP); float* MOD = (float*)(ws + WS_MOD);
      for (int it = gt; it < 2 * 9 * 6144; it += ngt) { const int j = it % 6144, r = (it / 6144) % 9, li = it / (9 * 6144); float a = p->b_ada[li * 6144 + j];
          for (int kc = 0; kc < 32; ++kc) a += MP[((size_t)(li * 32 + kc) * 9 + r) * 6144 + j];
          MOD[it] = a; } }
    { const float* MW = (const float*)(ws + WS_MW); bf16_t* WOUT = (bf16_t*)(ws + WS_WOUT);
      for (int it = gt; it < 2 * 64 * 1024; it += ngt) { const int n = it & 1023, k8 = (it >> 10) & 63, li = it >> 16; float a[8];
#pragma unroll
          for (int i = 0; i < 8; ++i) a[i] = 0.f;
          const float* wo = p->w_out + (size_t)li * 1024 * 1024 + n; const float* mw = MW + ((size_t)li * 512 + k8 * 8) * 256;
          for (int j = 0; j < 256; ++j) { const float w = wo[(size_t)j * 1024];
#pragma unroll
              for (int i = 0; i < 8; ++i) a[i] += mw[i * 256 + j] * w; }
          u32x4 o; o.x = cvtpk(a[0], a[1]); o.y = cvtpk(a[2], a[3]); o.z = cvtpk(a[4], a[5]); o.w = cvtpk(a[6], a[7]);
          *(u32x4*)(WOUT + ((size_t)li * 1024 + n) * 1280 + k8 * 8) = o; } }
}
__device__ __forceinline__ void phase_norm1(CP* p0, const Ctx& cx0, int li) {
    const Ctx cx = reopaque(cx0); CP* p = opaque_args(p0);
    unsigned char* ws = p->ws; float* X1 = (float*)(ws + WS_X1); const bf16_t* Y2 = (const bf16_t*)(ws + WS_Y2); bf16_t* H1 = (bf16_t*)(ws + WS_H1);
    const float* MOD = (const float*)(ws + WS_MOD) + (size_t)li * 9 * 6144; const float* n1 = p->norm1 + li * 1024;
    for (int m = cx.gw; m < MT; m += cx.ngw) {
        f32x4 v[4];
        if (li == 0) { const float* src = (m < NX) ? p->x + (size_t)m * D : p->ctx + (size_t)(m - NX) * D;
#pragma unroll
            for (int j = 0; j < 4; ++j) v[j] = *(const f32x4*)(src + 256 * j + 4 * cx.lane); }
        else { float* xr = X1 + (size_t)m * D; const bf16_t* ya = Y2 + (size_t)m * 2 * D;
#pragma unroll
            for (int j = 0; j < 4; ++j) { v[j] = *(const f32x4*)(xr + 256 * j + 4 * cx.lane);
                const u32x2 a = *(const u32x2*)(ya + 256 * j + 4 * cx.lane), b = *(const u32x2*)(ya + D + 256 * j + 4 * cx.lane);
                v[j][0] += bflo(a.x) + bflo(b.x); v[j][1] += bfhi(a.x) + bfhi(b.x); v[j][2] += bflo(a.y) + bflo(b.y); v[j][3] += bfhi(a.y) + bfhi(b.y);
                *(f32x4*)(xr + 256 * j + 4 * cx.lane) = v[j]; } }
        float ss = 0.f;
#pragma unroll
        for (int j = 0; j < 4; ++j) ss += v[j][0] * v[j][0] + v[j][1] * v[j][1] + v[j][2] * v[j][2] + v[j][3] * v[j][3];
        const float r = 1.0f / sqrtf(wave_sum(ss) * (1.0f / D) + 1e-6f);
        const int rr = (m < NX) ? (m >> 11) : 8; const float* sh = MOD + rr * 6144; const float* sc = sh + D;
#pragma unroll
        for (int j = 0; j < 4; ++j) { const int k = 256 * j + 4 * cx.lane; const f32x4 g = *(const f32x4*)(n1 + k), s1 = *(const f32x4*)(sc + k), h1 = *(const f32x4*)(sh + k);
            const f32x4 o = v[j] * r * g * (s1 + 1.0f) + h1; u32x2 w; w.x = cvtpk(o[0], o[1]); w.y = cvtpk(o[2], o[3]);
            *(u32x2*)(H1 + (size_t)m * D + k) = w; }
    }
}
__device__ __forceinline__ void phase_inproj(CP* p0, const Ctx& cx0, int li) {
    const Ctx cx = reopaque(cx0); CP* p = opaque_args(p0);
    unsigned char* ws = p->ws; const bf16_t* H1 = (const bf16_t*)(ws + WS_H1); const bf16_t* WIN = (const bf16_t*)(ws + WS_WIN) + (size_t)li * 2560 * 1024;
    if (!(MK_SUB & 1)) { pg8::SchedRect S; S.init(H1, WIN + (size_t)768 * 1024, MT, NU, D, cx.G, (int)blockIdx.x);
      pg8::EpiBf16 E{(bf16_t*)(ws + WS_U), NU};
      pg8::gemm_phase<pg8::EpiBf16, pg8::SchedRect, false, true, D>(cx.lds, S, E); }
    if (!(MK_SUB & 2)) { pg8::SchedRect S; S.init(WIN, H1, 768, MT, D, cx.G, (int)blockIdx.x);
      pg8::EpiT E{(bf16_t*)(ws + WS_FTX), (bf16_t*)(ws + WS_FTC), (bf16_t*)(ws + WS_VTX), (bf16_t*)(ws + WS_VTC)};
      pg8::gemm_phase<pg8::EpiT, pg8::SchedRect, false, true, D>(cx.lds, S, E); }
}
struct AttnPtrs { const bf16_t* U; const bf16_t* vtx; const bf16_t* vtc; bf16_t* conc; };
__device__ __forceinline__ void attn_load_chunk(const AttnPtrs& a, int c, int b, int h, int kr0, int bs, int lane, bf16x8 (&kf)[4], bf16x8 (&vf)[4]) {
    const int q = lane & 31, hh = lane >> 5;
    const bf16_t* kp; const bf16_t* vp; int vpitch;
    if (c < 8) { kp = a.U + (size_t)(NX + b * 256 + 32 * c + q) * NU + 512 + h * 64 + 8 * hh; vp = a.vtc + ((size_t)b * 512 + h * 64 + q) * 256 + 32 * c + 4 * hh; vpitch = 256; }
    else { const int t0 = 64 * (kr0 + c - 8) + bs; kp = a.U + (size_t)(b * 2048 + t0 + q) * NU + 512 + h * 64 + 8 * hh; vp = a.vtx + ((size_t)b * 512 + h * 64 + q) * 2048 + t0 + 4 * hh; vpitch = 2048; }
#pragma unroll
    for (int s = 0; s < 4; ++s) kf[s] = *(const bf16x8*)(kp + 16 * s);
#pragma unroll
    for (int s2 = 0; s2 < 2; ++s2)
#pragma unroll
        for (int dh = 0; dh < 2; ++dh) { const bf16_t* v0 = vp + (size_t)(32 * dh) * vpitch + 16 * s2; const bf16x4 lo = *(const bf16x4*)v0, hi = *(const bf16x4*)(v0 + 8);
            vf[s2 * 2 + dh] = (bf16x8){lo[0], lo[1], lo[2], lo[3], hi[0], hi[1], hi[2], hi[3]}; }
}
#define ATT_COMPUTE(c_, kf_, vf_) do { \
    f32x16 s_; \
    if ((c_) >= 8) { const int kr_ = kr0 + (c_) - 8; const bool rok_ = (kr_ >= rsq) && (kr_ < rsq + 8); int ro_ = kr_ - rq + 7; ro_ = ro_ < 0 ? 0 : (ro_ > 14 ? 14 : ro_); \
        const LAS float* bp_ = tblh + ro_ * 80 + cbase; const float rp_ = rok_ ? 0.f : -1e30f; \
        _Pragma("unroll") for (int i_ = 0; i_ < 16; ++i_) s_[i_] = bp_[(i_ & 3) + 8 * (i_ >> 2)] + colpen[i_] + rp_; } \
    else { _Pragma("unroll") for (int i_ = 0; i_ < 16; ++i_) s_[i_] = 0.f; } \
    _Pragma("unroll") for (int k_ = 0; k_ < 4; ++k_) s_ = __builtin_amdgcn_mfma_f32_32x32x16_bf16(kf_[k_], qf[k_], s_, 0, 0, 0); \
    float cm_ = s_[0]; \
    _Pragma("unroll") for (int i_ = 1; i_ < 16; ++i_) cm_ = fmaxf(cm_, s_[i_]); \
    cm_ = fmaxf(cm_, __shfl_xor(cm_, 32)); \
    const float mn_ = fmaxf(mrun, cm_); const float al_ = __builtin_amdgcn_exp2f(mrun - mn_); mrun = mn_; \
    float ps_ = 0.f; \
    _Pragma("unroll") for (int i_ = 0; i_ < 16; ++i_) { s_[i_] = __builtin_amdgcn_exp2f(s_[i_] - mn_); ps_ += s_[i_]; } \
    lsum = lsum * al_ + ps_; \
    _Pragma("unroll") for (int i_ = 0; i_ < 16; ++i_) { o0[i_] *= al_; o1[i_] *= al_; } \
    bf16x8 p0_, p1_; { u32x4 w_; w_.x = cvtpk(s_[0], s_[1]); w_.y = cvtpk(s_[2], s_[3]); w_.z = cvtpk(s_[4], s_[5]); w_.w = cvtpk(s_[6], s_[7]); p0_ = __builtin_bit_cast(bf16x8, w_); \
        w_.x = cvtpk(s_[8], s_[9]); w_.y = cvtpk(s_[10], s_[11]); w_.z = cvtpk(s_[12], s_[13]); w_.w = cvtpk(s_[14], s_[15]); p1_ = __builtin_bit_cast(bf16x8, w_); } \
    o0 = __builtin_amdgcn_mfma_f32_32x32x16_bf16(vf_[0], p0_, o0, 0, 0, 0); o1 = __builtin_amdgcn_mfma_f32_32x32x16_bf16(vf_[1], p0_, o1, 0, 0, 0); \
    o0 = __builtin_amdgcn_mfma_f32_32x32x16_bf16(vf_[2], p1_, o0, 0, 0, 0); o1 = __builtin_amdgcn_mfma_f32_32x32x16_bf16(vf_[3], p1_, o1, 0, 0, 0); \
} while (0)

__device__ __forceinline__ void attn_unit(const AttnPtrs& a, const LAS float* tbl, int qi, int u, int lane) {
    const int q = lane & 31, hh = lane >> 5;
    int b, h, nl, kr0 = 0, bs = 0, rq = 0, rsq = 0, cq = 0, csq = 0; size_t qrow;
    if (u < 512) { const int pair = qi * 8 + (u >> 6), rp = (u & 63) >> 2, cb = u & 3; b = pair >> 3; h = pair & 7;
        rq = 2 * rp + (q >> 4); cq = 16 * cb + (q & 15);
        rsq = rq - 4; rsq = rsq < 0 ? 0 : (rsq > 24 ? 24 : rsq); csq = cq - 8; csq = csq < 0 ? 0 : (csq > 48 ? 48 : csq);
        kr0 = 2 * rp - 4; kr0 = kr0 < 0 ? 0 : (kr0 > 24 ? 24 : kr0); int kr1 = 2 * rp + 1 - 4; kr1 = kr1 < 0 ? 0 : (kr1 > 24 ? 24 : kr1); nl = kr1 + 8 - kr0;
        bs = (cb == 0) ? 0 : (cb == 1 ? 8 : (cb == 2 ? 24 : 32));
        qrow = (size_t)b * 2048 + 64 * rq + cq; }
    else { const int v = u - 512, pair = qi * 8 + (v >> 3); b = pair >> 3; h = pair & 7; nl = 0; qrow = (size_t)NX + b * 256 + 32 * (v & 7) + q; }
    const int nc = 8 + nl;
    bf16x8 qf[4];
#pragma unroll
    for (int s = 0; s < 4; ++s) qf[s] = *(const bf16x8*)(a.U + qrow * NU + h * 64 + 16 * s + 8 * hh);
    float colpen[16];
#pragma unroll
    for (int i = 0; i < 16; ++i) { const int kc = bs + (i & 3) + 8 * (i >> 2) + 4 * hh; colpen[i] = (kc >= csq && kc < csq + 16) ? 0.f : -1e30f; }
    const LAS float* tblh = tbl + h * (15 * 80); const int cbase = bs - cq + 15 + 16 + 4 * hh;
    f32x16 o0, o1;
#pragma unroll
    for (int i = 0; i < 16; ++i) { o0[i] = 0.f; o1[i] = 0.f; }
    float mrun = -1e30f, lsum = 0.f;
    bf16x8 ka[4], va[4], kb[4], vb[4];
    attn_load_chunk(a, 0, b, h, kr0, bs, lane, ka, va);
    for (int c = 0; c < nc; c += 2) {
        const bool h1 = (c + 1 < nc);
        if (h1) attn_load_chunk(a, c + 1, b, h, kr0, bs, lane, kb, vb);
        ATT_COMPUTE(c, ka, va);
        if (h1) { if (c + 2 < nc) attn_load_chunk(a, c + 2, b, h, kr0, bs, lane, ka, va);
            ATT_COMPUTE(c + 1, kb, vb); }
    }
    const float inv = 1.0f / (lsum + __shfl_xor(lsum, 32));
    bf16_t* op = a.conc + qrow * KO + 512 + h * 64 + 4 * hh;
#pragma unroll
    for (int g = 0; g < 4; ++g) { u32x2 w; w.x = cvtpk(o0[4 * g] * inv, o0[4 * g + 1] * inv); w.y = cvtpk(o0[4 * g + 2] * inv, o0[4 * g + 3] * inv); *(u32x2*)(op + 8 * g) = w;
        w.x = cvtpk(o1[4 * g] * inv, o1[4 * g + 1] * inv); w.y = cvtpk(o1[4 * g + 2] * inv, o1[4 * g + 3] * inv); *(u32x2*)(op + 32 + 8 * g) = w; }
}
__device__ __forceinline__ void phase_mix(CP* p0, const Ctx& cx0, int li) {
    const Ctx cx = reopaque(cx0); CP* p = opaque_args(p0);
    unsigned char* ws = p->ws; const bf16_t* U = (const bf16_t*)(ws + WS_U); bf16_t* CONC = (bf16_t*)(ws + WS_CONC);
    const int nrows = (li == 0) ? MT : NX;
    if (!(MK_SUB & 16)) { const float* wc = p->w_conv + li * 768;
      for (int it = cx.vcu * 512 + cx.tid; it < nrows * 32; it += cx.G * 512) { const int m = it >> 5, c0 = (it & 31) * 8;
          const int pos = (m < NX) ? (m & 2047) : ((m - NX) & 255), len = (m < NX) ? 2048 : 256;
          const bf16_t* up = U + (size_t)m * NU; float z[3][8];
#pragma unroll
          for (int d = 0; d < 3; ++d) { const bool ok = (pos + d - 1 >= 0) && (pos + d - 1 < len);
              if (ok) { const u32x4 a = *(const u32x4*)(up + (ptrdiff_t)(d - 1) * NU + 1280 + c0), b = *(const u32x4*)(up + (ptrdiff_t)(d - 1) * NU + 1536 + c0);
                  z[d][0] = bflo(a.x) * bflo(b.x); z[d][1] = bfhi(a.x) * bfhi(b.x); z[d][2] = bflo(a.y) * bflo(b.y); z[d][3] = bfhi(a.y) * bfhi(b.y);
                  z[d][4] = bflo(a.z) * bflo(b.z); z[d][5] = bfhi(a.z) * bfhi(b.z); z[d][6] = bflo(a.w) * bflo(b.w); z[d][7] = bfhi(a.w) * bfhi(b.w); }
              else {
#pragma unroll
                  for (int j = 0; j < 8; ++j) z[d][j] = 0.f; } }
          const u32x4 g = *(const u32x4*)(up + 1024 + c0); float gb[8] = {bflo(g.x), bfhi(g.x), bflo(g.y), bfhi(g.y), bflo(g.z), bfhi(g.z), bflo(g.w), bfhi(g.w)}; float o[8];
#pragma unroll
          for (int j = 0; j < 8; ++j) o[j] = gb[j] * (wc[c0 + j] * z[0][j] + wc[256 + c0 + j] * z[1][j] + wc[512 + c0 + j] * z[2][j]);
          u32x4 w; w.x = cvtpk(o[0], o[1]); w.y = cvtpk(o[2], o[3]); w.z = cvtpk(o[4], o[5]); w.w = cvtpk(o[6], o[7]);
          *(u32x4*)(CONC + (size_t)m * KO + 1024 + c0) = w; } }
    if (!(MK_SUB & 4)) { const int c = (int)blockIdx.x;
      { pg8::SchedOne S; S.has = (c < 128); S.u0.pm = c >> 3; S.u0.pn = c & 7; S.u0.aux = 0;
        S.u0.A = (const char*)(ws + WS_ADFTX) + (size_t)(c >> 3) * 256 * 2048 * 2; S.u0.B = (const char*)(ws + WS_FTX) + (size_t)(c & 7) * 256 * 2048 * 2;
        pg8::EpiDft E{CONC, 8};
        pg8::gemm_phase<pg8::EpiDft, pg8::SchedOne, false, false, 2048>(cx.lds, S, E); }
      if (li == 0) { const int c2 = c - 128; pg8::SchedOne S; S.has = (c2 >= 0 && c2 < 16); S.u0.pm = c2 >> 3; S.u0.pn = c2 & 7; S.u0.aux = 0;
        S.u0.A = (const char*)(ws + WS_ADFTC) + (size_t)(c2 >> 3) * 256 * 256 * 2; S.u0.B = (const char*)(ws + WS_FTC) + (size_t)(c2 & 7) * 256 * 256 * 2;
        pg8::EpiDft E{CONC + (size_t)NX * KO, 1};
        pg8::gemm_phase<pg8::EpiDft, pg8::SchedOne, false, false, 256>(cx.lds, S, E); } }
    if (!(MK_SUB & 8)) { LAS float* tbl = (LAS float*)cx.lds;
      __syncthreads();
      for (int i = cx.tid; i < 8 * 15 * 80; i += 512) { const int col = i % 80 - 16, ro = (i / 80) % 15, h = i / 1200;
          tbl[i] = (col >= 0 && col <= 30) ? p->rpb[(size_t)li * 3720 + h * 465 + ro * 31 + col] * LOG2E : 0.f; }
      __syncthreads();
      AttnPtrs a{U, (const bf16_t*)(ws + WS_VTX), (const bf16_t*)(ws + WS_VTC), CONC};
      unsigned* qw = (unsigned*)(ws + WS_CTL) + CW_ATTQ + li * 512;
      const int nper = (li == 0) ? 576 : 512; const int q0 = (int)(xb_xcc_id() & 7u);
      for (int qq = 0; qq < 8; ++qq) { const int qi = (q0 + qq) & 7;
          for (;;) { unsigned u0 = 0; if (cx.lane == 0) u0 = xb_add(qw + qi * 64, 2u); u0 = __builtin_amdgcn_readfirstlane(u0);
              if ((int)u0 >= nper) break;
              attn_unit(a, tbl, qi, (int)u0, cx.lane);
              if ((int)u0 + 1 < nper) attn_unit(a, tbl, qi, (int)u0 + 1, cx.lane); } } }
}
__device__ __forceinline__ void phase_outproj(CP* p0, const Ctx& cx0, int li) {
    const Ctx cx = reopaque(cx0); CP* p = opaque_args(p0);
    unsigned char* ws = p->ws;
    pg8::SchedRect S; S.init(ws + WS_CONC, (const bf16_t*)(ws + WS_WOUT) + (size_t)li * 1024 * 1280, (li == 0) ? MT : NX, D, KO, cx.G, (int)blockIdx.x);
    pg8::EpiOut E{(float*)(ws + WS_X1), (li == 0) ? p->x : nullptr, (li == 0) ? p->ctx : nullptr, (const float*)(ws + WS_MOD) + (size_t)li * 9 * 6144};
    pg8::gemm_phase<pg8::EpiOut, pg8::SchedRect, false, true, KO>(cx.lds, S, E);
}
__device__ __forceinline__ void phase_router(CP* p0, const Ctx& cx0, int li) {
    const Ctx cx = reopaque(cx0); CP* p = opaque_args(p0);
    unsigned char* ws = p->ws; const float* X1 = (const float*)(ws + WS_X1); bf16_t* TT = (bf16_t*)(ws + WS_H1);
    const float* MOD = (const float*)(ws + WS_MOD) + (size_t)li * 9 * 6144; const float* n2 = p->norm2 + li * 1024; const float* WR = (const float*)(ws + WS_WRT) + (size_t)li * 36 * 1024;
    const int M = (li == 0) ? MT : NX; const int RB = (M + cx.G - 1) / cx.G;
    const int row0 = cx.vcu * RB;
    LAS float* lg = (LAS float*)cx.lds;
    LAS int* lcnt = (LAS int*)(cx.lds + MISC_OFF + MO_LCNT); LAS int* lbase = (LAS int*)(cx.lds + MISC_OFF + MO_LBASE);
    LAS int* rrow = (LAS int*)(cx.lds + MISC_OFF + MO_RROW);
    __syncthreads();
    if (cx.tid < 32) lcnt[cx.tid] = 0;
    f32x4 t[9][4];
#pragma unroll
    for (int j = 0; j < 9; ++j) { const int rl = cx.wave + 8 * j; int m = row0 + rl; const bool ok = (rl < RB) && (m < M); if (!ok) m = row0 < M ? row0 : 0;
        const float* xr = X1 + (size_t)m * D; f32x4 v[4]; float ss = 0.f;
#pragma unroll
        for (int i = 0; i < 4; ++i) { v[i] = *(const f32x4*)(xr + 256 * i + 4 * cx.lane); ss += v[i][0] * v[i][0] + v[i][1] * v[i][1] + v[i][2] * v[i][2] + v[i][3] * v[i][3]; }
        const float r = 1.0f / sqrtf(wave_sum(ss) * (1.0f / D) + 1e-6f);
        const int rr = (m < NX) ? (m >> 11) : 8; const float* sh = MOD + rr * 6144 + 3 * D; const float* sc = sh + D;
#pragma unroll
        for (int i = 0; i < 4; ++i) { const int k = 256 * i + 4 * cx.lane; const f32x4 g = *(const f32x4*)(n2 + k), s1 = *(const f32x4*)(sc + k), h1 = *(const f32x4*)(sh + k);
            t[j][i] = v[i] * r * g * (s1 + 1.0f) + h1;
            if (ok) { u32x2 w; w.x = cvtpk(t[j][i][0], t[j][i][1]); w.y = cvtpk(t[j][i][2], t[j][i][3]); *(u32x2*)(TT + (size_t)m * D + k) = w; } } }
    const bool b5 = (cx.lane & 32) != 0, b4 = (cx.lane & 16) != 0, b3 = (cx.lane & 8) != 0;
#pragma unroll 1
    for (int c = 0; c < 36; ++c) { f32x4 w[4];
#pragma unroll
        for (int i = 0; i < 4; ++i) w[i] = *(const f32x4*)(WR + (size_t)c * 1024 + 256 * i + 4 * cx.lane);
        float pp[9];
#pragma unroll
        for (int j = 0; j < 9; ++j) { float a = 0.f;
#pragma unroll
            for (int i = 0; i < 4; ++i) a += t[j][i][0] * w[i][0] + t[j][i][1] * w[i][1] + t[j][i][2] * w[i][2] + t[j][i][3] * w[i][3];
            pp[j] = a; }
        float q4[4];
#pragma unroll
        for (int k = 0; k < 4; ++k) { const float keep = b5 ? pp[4 + k] : pp[k], send = b5 ? pp[k] : pp[4 + k]; q4[k] = keep + __shfl_xor(send, 32); }
        float r2[2];
#pragma unroll
        for (int k = 0; k < 2; ++k) { const float keep = b4 ? q4[2 + k] : q4[k], send = b4 ? q4[k] : q4[2 + k]; r2[k] = keep + __shfl_xor(send, 16); }
        float s1; { const float keep = b3 ? r2[1] : r2[0], send = b3 ? r2[0] : r2[1]; s1 = keep + __shfl_xor(send, 8); }
        s1 += __shfl_xor(s1, 4); s1 += __shfl_xor(s1, 2); s1 += __shfl_xor(s1, 1);
        const float s9 = wave_sum(pp[8]);
        if ((cx.lane & 7) == 0) { const int rl = cx.wave + 8 * (cx.lane >> 3); if (rl < 72) lg[rl * 36 + c] = s1; }
        if (cx.lane == 0) { const int rl = cx.wave + 64; if (rl < 72) lg[rl * 36 + c] = s9; }
    }
    __syncthreads();
    int e0 = 0, e1 = 0, lr0 = 0, lr1 = 0; float w0 = 0.f, w1 = 0.f; const bool act = (cx.tid < RB) && (row0 + cx.tid < M) && (cx.tid < 72);
    if (act) { const LAS float* l = lg + cx.tid * 36; float gl[4];
#pragma unroll
        for (int i = 0; i < 4; ++i) gl[i] = l[i] + p->b_rg[li * 4 + i];
        int gi = 0; float gm = gl[0];
#pragma unroll
        for (int i = 1; i < 4; ++i) if (gl[i] > gm) { gm = gl[i]; gi = i; }
        float gs = 0.f;
#pragma unroll
        for (int i = 0; i < 4; ++i) gs += __expf(gl[i] - gm);
        const float gw = 1.0f / gs;
        float ev[8];
#pragma unroll
        for (int i = 0; i < 8; ++i) ev[i] = l[4 + gi * 8 + i] + p->b_re[li * 32 + gi * 8 + i];
        int i0 = 0; float v0 = ev[0];
#pragma unroll
        for (int i = 1; i < 8; ++i) if (ev[i] > v0) { v0 = ev[i]; i0 = i; }
        int i1 = -1; float v1 = 0.f;
#pragma unroll
        for (int i = 0; i < 8; ++i) if (i != i0 && (i1 < 0 || ev[i] > v1)) { v1 = ev[i]; i1 = i; }
        const float ex = __expf(v1 - v0); w0 = gw / (1.f + ex); w1 = gw * ex / (1.f + ex);
        e0 = gi * 8 + i0; e1 = gi * 8 + i1;
        lr0 = __hip_atomic_fetch_add(&lcnt[e0], 1, __ATOMIC_RELAXED, __HIP_MEMORY_SCOPE_WORKGROUP); lr1 = __hip_atomic_fetch_add(&lcnt[e1], 1, __ATOMIC_RELAXED, __HIP_MEMORY_SCOPE_WORKGROUP); }
    __syncthreads();
    if (cx.tid < 32) { const int n = lcnt[cx.tid]; int base = 0; if (n > 0) base = (int)xb_add((unsigned*)(ws + WS_CTL) + CW_CNT + li * 2048 + cx.tid * 64, (unsigned)n); lbase[cx.tid] = base; }
    __syncthreads();
    if (act) { const int tok = row0 + cx.tid; int* RL = (int*)(ws + WS_ROWLIST); float* TW = (float*)(ws + WS_ROUTE);
        RL[(size_t)e0 * MT + lbase[e0] + lr0] = tok * 2; RL[(size_t)e1 * MT + lbase[e1] + lr1] = tok * 2 + 1;
        TW[tok * 2] = w0; TW[tok * 2 + 1] = w1; }
    (void)rrow;
}
__device__ __forceinline__ void moe_tables(CP* p, const Ctx& cx, int li, int& ntiles) {
    LAS int* tcnt = (LAS int*)(cx.lds + MISC_OFF + MO_TCNT); LAS int* tbase = (LAS int*)(cx.lds + MISC_OFF + MO_TBASE);
    __syncthreads();
    if (cx.tid < 32) tcnt[cx.tid] = (int)__hip_atomic_load((unsigned*)(p->ws + WS_CTL) + CW_CNT + li * 2048 + cx.tid * 64, __ATOMIC_RELAXED, __HIP_MEMORY_SCOPE_AGENT);
    __syncthreads();
    if (cx.tid == 0) { int a = 0; for (int e = 0; e < 32; ++e) { tbase[e] = a; a += (tcnt[e] + 255) >> 8; } tbase[32] = a; }
    __syncthreads();
    ntiles = __builtin_amdgcn_readfirstlane(tbase[32]);
}
__device__ __forceinline__ void phase_moe_up(CP* p0, const Ctx& cx0, int li) {
    const Ctx cx = reopaque(cx0); CP* p = opaque_args(p0);
    unsigned char* ws = p->ws; int ntiles; moe_tables(p, cx, li, ntiles);
    LAS int* tcnt = (LAS int*)(cx.lds + MISC_OFF + MO_TCNT); LAS int* tbase = (LAS int*)(cx.lds + MISC_OFF + MO_TBASE); LAS int* idx = (LAS int*)(cx.lds + MISC_OFF + MO_IDX);
    const int* RL = (const int*)(ws + WS_ROWLIST);
    for (int i = 0; i < 3; ++i) { const int L = i * cx.G + cx.vcu, T = L >> 2;
        if (T < ntiles && cx.tid < 256) { int e = 0; for (int j = 1; j < 32; ++j) e += (tbase[j] <= T) ? 1 : 0;
            const int j = (T - tbase[e]) * 256 + cx.tid; const int ts = RL[(size_t)e * MT + (j < tcnt[e] ? j : 0)]; idx[i * 256 + cx.tid] = ts >> 1; } }
    __syncthreads();
    pg8::SchedMoe S; S.tbase = tbase; S.idx = idx; S.A = (const char*)(ws + WS_H1); S.B = (const char*)(ws + WS_WGU) + (size_t)li * 32 * 1024 * 1024 * 2;
    S.tA = 0; S.eB = (size_t)1024 * 1024 * 2; S.tB = (size_t)256 * 1024 * 2; S.G = cx.G; S.c = cx.vcu; S.ntiles = ntiles; S.gather = true;
    pg8::EpiUp E{(bf16_t*)(ws + WS_H)};
    pg8::gemm_phase<pg8::EpiUp, pg8::SchedMoe, true, true, D>(cx.lds, S, E);
}
__device__ __forceinline__ void phase_moe_down(CP* p0, const Ctx& cx0, int li) {
    const Ctx cx = reopaque(cx0); CP* p = opaque_args(p0);
    unsigned char* ws = p->ws; int ntiles; moe_tables(p, cx, li, ntiles);
    LAS int* tcnt = (LAS int*)(cx.lds + MISC_OFF + MO_TCNT); LAS int* tbase = (LAS int*)(cx.lds + MISC_OFF + MO_TBASE); LAS int* idx = (LAS int*)(cx.lds + MISC_OFF + MO_IDX);
    pg8::SchedMoe S; S.tbase = tbase; S.idx = idx; S.A = (const char*)(ws + WS_H); S.B = (const char*)(ws + WS_WD) + (size_t)li * 32 * 1024 * 512 * 2;
    S.tA = (size_t)256 * 512 * 2; S.eB = (size_t)1024 * 512 * 2; S.tB = (size_t)256 * 512 * 2; S.G = cx.G; S.c = cx.vcu; S.ntiles = ntiles; S.gather = false;
    pg8::EpiDown E{(bf16_t*)(ws + WS_Y2), (const int*)(ws + WS_ROWLIST), (const float*)(ws + WS_ROUTE), (const float*)(ws + WS_MOD) + (size_t)li * 9 * 6144, tcnt, tbase};
    pg8::gemm_phase<pg8::EpiDown, pg8::SchedMoe, false, true, DE>(cx.lds, S, E);
}
__device__ __forceinline__ void phase_final(CP* p0, const Ctx& cx0) {
    const Ctx cx = reopaque(cx0); CP* p = opaque_args(p0);
    unsigned char* ws = p->ws; const float* X1 = (const float*)(ws + WS_X1); const bf16_t* Y2 = (const bf16_t*)(ws + WS_Y2);
    for (int m = cx.gw; m < NX; m += cx.ngw) { const float* xr = X1 + (size_t)m * D; const bf16_t* ya = Y2 + (size_t)m * 2 * D; f32x4 v[4]; float ss = 0.f;
#pragma unroll
        for (int j = 0; j < 4; ++j) { v[j] = *(const f32x4*)(xr + 256 * j + 4 * cx.lane);
            const u32x2 a = *(const u32x2*)(ya + 256 * j + 4 * cx.lane), b = *(const u32x2*)(ya + D + 256 * j + 4 * cx.lane);
            v[j][0] += bflo(a.x) + bflo(b.x); v[j][1] += bfhi(a.x) + bfhi(b.x); v[j][2] += bflo(a.y) + bflo(b.y); v[j][3] += bfhi(a.y) + bfhi(b.y);
            ss += v[j][0] * v[j][0] + v[j][1] * v[j][1] + v[j][2] * v[j][2] + v[j][3] * v[j][3]; }
        const float r = 1.0f / sqrtf(wave_sum(ss) * (1.0f / D) + 1e-6f);
#pragma unroll
        for (int j = 0; j < 4; ++j) { const int k = 256 * j + 4 * cx.lane; const f32x4 g = *(const f32x4*)(p->norm_final + k); *(f32x4*)(p->out + (size_t)m * D + k) = v[j] * r * g; } }
}

constexpr int N_PHASES = 17;
__global__ void __launch_bounds__(512, 2) mk_fwd(Params p_unused) {
    CP* p = (CP*)__builtin_amdgcn_kernarg_segment_ptr(); (void)p_unused;
    extern __shared__ __attribute__((aligned(16))) unsigned char lds_raw[];
    Ctx cx; cx.lds = (LAS unsigned char*)lds_raw; cx.tid = threadIdx.x; cx.lane = cx.tid & 63; cx.wave = __builtin_amdgcn_readfirstlane(cx.tid >> 6);
    cx.G = gridDim.x; { const int bx = blockIdx.x; cx.vcu = (cx.G % 8 == 0) ? (bx % 8) * (cx.G / 8) + bx / 8 : bx; }
    cx.gw = cx.vcu * 8 + cx.wave; cx.ngw = cx.G * 8;
    volatile LAS unsigned* misc = (volatile LAS unsigned*)(cx.lds + MISC_OFF);
    if (cx.tid < 16) misc[cx.tid] = 0u;
    __syncthreads();
#if MK_SPLIT
#define GRID_BAR() do { } while (0)
#else
    XcdBarrier bar = xcd_barrier_post((unsigned*)(p->ws + WS_CTL) + CW_BAR, misc);
#define GRID_BAR() xcd_barrier(bar)
#endif
    const int lo = p->ph_lo, hi = p->ph_hi;
#define IN(k) (lo <= (k) && (k) < hi)
#define EN(j) (!((MK_SKIP >> (j)) & 1))
#define SEAM(k) do { if (IN(k) && IN((k) + 1)) GRID_BAR(); } while (0)
    if (EN(0) && IN(0)) phase_p0a(p, cx);
    SEAM(0);
    if (EN(1) && IN(1)) phase_p0b(p, cx);
    SEAM(1);
    for (int li = 0; li < 2; ++li) { const int pb = 2 + 7 * li;
        if (EN(2) && IN(pb + 0)) phase_norm1(p, cx, li);
        SEAM(pb + 0);
        if (EN(3) && IN(pb + 1)) phase_inproj(p, cx, li);
        SEAM(pb + 1);
        if (EN(4) && IN(pb + 2)) phase_mix(p, cx, li);
        SEAM(pb + 2);
        if (EN(5) && IN(pb + 3)) phase_outproj(p, cx, li);
        SEAM(pb + 3);
        if (EN(6) && IN(pb + 4)) phase_router(p, cx, li);
        SEAM(pb + 4);
        if (EN(7) && IN(pb + 5)) phase_moe_up(p, cx, li);
        SEAM(pb + 5);
        if (EN(8) && IN(pb + 6)) phase_moe_down(p, cx, li);
        SEAM(pb + 6);
    }
    if (EN(9) && IN(16)) phase_final(p, cx);
}

extern "C" void kernel_launch(void* const* d_in, const int* in_sizes, int n_in, void* d_out, int out_size, void* d_ws, size_t ws_size, hipStream_t stream) {
    static int grid = 0;
    if (grid == 0) {
        if (n_in != 21 || out_size != NX * D || ws_size < WS_END) { fprintf(stderr, "kernel_launch: unexpected shapes (n_in %d, out %d, ws %zu)\n", n_in, out_size, ws_size); grid = -1; return; }
        int dev = 0, cus = 0;
        if (hipGetDevice(&dev) != hipSuccess || hipDeviceGetAttribute(&cus, hipDeviceAttributeMultiprocessorCount, dev) != hipSuccess) { grid = -1; return; }
        if (hipFuncSetAttribute((const void*)mk_fwd, hipFuncAttributeMaxDynamicSharedMemorySize, LDS_BYTES) != hipSuccess) { fprintf(stderr, "kernel_launch: hipFuncSetAttribute failed\n"); grid = -1; return; }
        (void)hipGetLastError();
        grid = cus;
        if (grid != 256) fprintf(stderr, "kernel_launch: %d CUs (built for 256)\n", grid);
    }
    if (grid < 0) return;
    (void)in_sizes;
    (void)hipMemsetAsync((char*)d_ws + WS_CTL, 0, CTL_ZERO_BYTES, stream);
    Params a{};
    a.x = (const float*)d_in[0]; a.c = (const float*)d_in[1]; a.ctx = (const float*)d_in[2]; a.c_ctx = (const float*)d_in[3]; a.w_ada = (const float*)d_in[4]; a.b_ada = (const float*)d_in[5];
    a.norm1 = (const float*)d_in[6]; a.norm2 = (const float*)d_in[7]; a.w_in = (const float*)d_in[8]; a.w_fourier = (const float*)d_in[9]; a.w_conv = (const float*)d_in[10]; a.rpb = (const float*)d_in[11];
    a.w_out = (const float*)d_in[12]; a.w_rg = (const float*)d_in[13]; a.b_rg = (const float*)d_in[14]; a.w_re = (const float*)d_in[15]; a.b_re = (const float*)d_in[16];
    a.w_gate = (const float*)d_in[17]; a.w_up = (const float*)d_in[18]; a.w_down = (const float*)d_in[19]; a.norm_final = (const float*)d_in[20];
    a.out = (float*)d_out; a.ws = (unsigned char*)d_ws;
#if MK_SPLIT
    for (int ph = 0; ph < N_PHASES; ++ph) { a.ph_lo = ph; a.ph_hi = ph + 1; hipLaunchKernelGGL(mk_fwd, dim3(grid), dim3(512), LDS_BYTES, stream, a); }
#else
    a.ph_lo = 0; a.ph_hi = N_PHASES; hipLaunchKernelGGL(mk_fwd, dim3(grid), dim3(512), LDS_BYTES, stream, a);
#endif
}
```

```cpp
#include <hip/hip_runtime.h>
#include <cstdio>
#include <cstdint>

#ifndef MK_REP
#define MK_REP 0
#endif
#ifndef MK_MIXREP
#define MK_MIXREP 0
#endif
#ifndef MK_XTRA
#define MK_XTRA -1
#endif
#ifndef MK_SKIP
#define MK_SKIP 0
#endif
#ifndef MK_SUB
#define MK_SUB 0
#endif
#ifndef MK_SPLIT
#define MK_SPLIT 0
#endif

#define GAS __attribute__((address_space(1)))
#define LAS __attribute__((address_space(3)))
typedef unsigned short bf16_t;
typedef short bf16x8 __attribute__((ext_vector_type(8)));
typedef short bf16x4 __attribute__((ext_vector_type(4)));
typedef float f32x2 __attribute__((ext_vector_type(2)));
typedef float f32x4 __attribute__((ext_vector_type(4)));
typedef float f32x16 __attribute__((ext_vector_type(16)));
typedef unsigned u32x2 __attribute__((ext_vector_type(2)));
typedef unsigned u32x4 __attribute__((ext_vector_type(4)));
typedef __bf16 bf16x2_n __attribute__((ext_vector_type(2)));

constexpr int D = 1024, NB = 8, SEQ = 2048, LC = 256, NX = NB * SEQ, NC = NB * LC, MT = NX + NC;
constexpr int NU = 1792;
constexpr int KO = 1280;
constexpr int NE = 32, DE = 512, NHEAD = 8;
constexpr int MAXT = 176;
constexpr float QSCALE = 0.125f * 1.4426950408889634f;
constexpr float LOG2E = 1.4426950408889634f;

constexpr size_t MiB = 1u << 20;
constexpr size_t WS_CTL = 0, CTL_ZERO_BYTES = 1 * MiB;
constexpr size_t WS_MOD = 1 * MiB;
constexpr size_t WS_MODP = 2 * MiB;
constexpr size_t WS_MW = 16 * MiB;
constexpr size_t WS_WRT = 17 * MiB;
constexpr size_t WS_ROUTE = 18 * MiB;
constexpr size_t WS_ROWLIST = 19 * MiB;
constexpr size_t WS_ADFTC = 22 * MiB;
constexpr size_t WS_ADFTX = 23 * MiB;
constexpr size_t WS_WIN = 39 * MiB;
constexpr size_t WS_WOUT = 49 * MiB;
constexpr size_t WS_WGU = 54 * MiB;
constexpr size_t WS_WD = 182 * MiB;
constexpr size_t WS_H1 = 246 * MiB;
constexpr size_t WS_U = 282 * MiB;
constexpr size_t WS_Y2 = WS_U;
constexpr size_t WS_VTX = 354 * MiB;
constexpr size_t WS_VTC = 370 * MiB;
constexpr size_t WS_FTX = 372 * MiB;
constexpr size_t WS_FTC = 380 * MiB;
constexpr size_t WS_CONC = 381 * MiB;
constexpr size_t WS_H = WS_FTX;
constexpr size_t WS_X1 = 426 * MiB;
constexpr size_t WS_END = 498 * MiB;
static_assert(WS_H + (size_t)MAXT * 256 * 512 * 2 <= WS_X1, "H overlay");
static_assert(WS_Y2 + (size_t)MT * 2 * 1024 * 2 <= WS_VTX, "y2 overlay");

constexpr int CW_BAR = 4096;
constexpr int CW_ATTQ = 8192;
constexpr int CW_CNT = 16384;

constexpr int RING_BYTES = 131072, MISC_OFF = RING_BYTES, LDS_BYTES = 163840;
constexpr int MO_TCNT = 64, MO_TBASE = 192, MO_LCNT = 384, MO_LBASE = 512, MO_IDX = 1024, MO_RROW = 4096;

__device__ __forceinline__ unsigned cvtpk(float lo, float hi) { f32x2 v = {lo, hi}; bf16x2_n b = __builtin_convertvector(v, bf16x2_n); return __builtin_bit_cast(unsigned, b); }
__device__ __forceinline__ float bf2f(unsigned short b) { return __uint_as_float(((unsigned)b) << 16); }
__device__ __forceinline__ float bflo(unsigned w) { return __uint_as_float(w << 16); }
__device__ __forceinline__ float bfhi(unsigned w) { return __uint_as_float(w & 0xffff0000u); }
__device__ __forceinline__ float wave_sum(float v) {
#pragma unroll
    for (int o = 1; o < 64; o <<= 1) v += __shfl_xor(v, o);
    return v;
}
#define LDS_WAIT() asm volatile("s_waitcnt lgkmcnt(0)" ::: "memory")
#define VM_WAIT() asm volatile("s_waitcnt vmcnt(0)" ::: "memory")

#define XB_TMO      128
#define XB_XCNT(j)  (256  + 64 * (j))
#define XB_XSUB(j)  (1280 + 64 * (j))
#define XB_XGEN(j)  (2304 + 64 * (j))
#define XB_TOP      3328
#define XB_TOPGEN   3392
#define XCD_BAR_WORDS 3456
#define XB_SPIN_CAP (1u << 18)
__device__ __forceinline__ unsigned xb_ld(unsigned* p)              { return __hip_atomic_load(p, __ATOMIC_RELAXED, __HIP_MEMORY_SCOPE_AGENT); }
__device__ __forceinline__ unsigned xb_add(unsigned* p, unsigned v) { return __hip_atomic_fetch_add(p, v, __ATOMIC_RELAXED, __HIP_MEMORY_SCOPE_AGENT); }
__device__ __forceinline__ unsigned xb_xcc_id() { return (unsigned)__builtin_amdgcn_s_getreg((3 << 11) | 20) & 0xFu; }
#define XB_SPIN(cond, bar) do { unsigned _sp = 0; while (cond) { __builtin_amdgcn_s_sleep(1); \
    if ((++_sp & 255u) == 0u) { if (xb_ld(&(bar)[XB_TMO])) break; if (_sp > XB_SPIN_CAP) { atomicAdd(&(bar)[XB_TMO], 1u); break; } } } } while (0)
struct XcdBarrier { unsigned* bar; unsigned x; volatile LAS unsigned* st; };
__device__ __forceinline__ XcdBarrier xcd_barrier_post(unsigned* bar, volatile LAS unsigned* st) {
    XcdBarrier b; b.bar = bar; b.x = xb_xcc_id(); b.st = st;
    if (threadIdx.x == 0) (void)xb_add(&bar[XB_XCNT(b.x)], 1u);
    return b;
}
__device__ __forceinline__ void xcd_barrier_complete(unsigned* bar, unsigned x, unsigned& nloc, unsigned& nx) {
    const unsigned G = gridDim.x * gridDim.y * gridDim.z;
    unsigned sum, cnt, mine, sp = 0u;
    for (;;) {
        sum = 0u; cnt = 0u; mine = 0u;
#pragma unroll
        for (unsigned j = 0; j < 16; ++j) { const unsigned c = xb_ld(&bar[XB_XCNT(j)]); sum += c; cnt += (c > 0u) ? 1u : 0u; mine = (j == x) ? c : mine; }
        if (sum == G) break;
        __builtin_amdgcn_s_sleep(1);
        if ((++sp & 255u) == 0u) { if (xb_ld(&bar[XB_TMO])) break; if (sp > XB_SPIN_CAP) { atomicAdd(&bar[XB_TMO], 1u); break; } }
    }
    nloc = mine > 0u ? mine : 1u; nx = cnt > 0u ? cnt : 1u;
}
__device__ __forceinline__ void xcd_barrier(const XcdBarrier& b) {
    asm volatile("s_waitcnt vmcnt(0)" ::: "memory");
    __syncthreads();
    if (threadIdx.x == 0) {
        unsigned* bar = b.bar;
        __builtin_amdgcn_s_waitcnt(0);
        unsigned nloc = b.st[0], nx = b.st[1];
        if (nloc == 0u) { xcd_barrier_complete(bar, b.x, nloc, nx); b.st[0] = nloc; b.st[1] = nx; }
        const unsigned old = xb_add(&bar[XB_XSUB(b.x)], 1u);
        const unsigned gen = old / nloc;
        if (old + 1u == (gen + 1u) * nloc) {
            __builtin_amdgcn_fence(__ATOMIC_RELEASE, "agent");
            asm volatile("s_waitcnt vmcnt(0)" ::: "memory");
            const unsigned og = xb_add(&bar[XB_TOP], 1u);
            const unsigned tg = og / nx;
            if (og + 1u == (tg + 1u) * nx) xb_add(&bar[XB_TOPGEN], 1u);
            else XB_SPIN(xb_ld(&bar[XB_TOPGEN]) == tg, bar);
            __builtin_amdgcn_fence(__ATOMIC_ACQUIRE, "agent");
            xb_add(&bar[XB_XGEN(b.x)], 1u);
            asm volatile("s_waitcnt vmcnt(0)" ::: "memory");
        } else {
            XB_SPIN(xb_ld(&bar[XB_XGEN(b.x)]) == gen, bar);
            __builtin_amdgcn_fence(__ATOMIC_ACQUIRE, "agent");
            asm volatile("s_waitcnt vmcnt(0)" ::: "memory");
        }
    }
    __syncthreads();
}

namespace pg8 {
constexpr int BM = 256, BK = 64, HALF = 128, HTB = HALF * BK * 2, STAGE_BYTES = 8 * HTB, NXCD = 8, WGM = 8;
__host__ __device__ __forceinline__ int lds_byte(int r, int c) { const int st = (r >> 4) * 2 + (c >> 5), rr = r & 15, cc = c & 31, ob = rr * 64 + cc * 2; return st * 1024 + (ob ^ (((ob >> 9) & 1) << 5)); }
__host__ __device__ __forceinline__ void stage_rc(int b, int& R, int& C) { const int st = b / 1024, sb = b % 1024, swz = sb ^ (((sb >> 9) & 1) << 5); R = (st >> 1) * 16 + swz / 64; C = (st & 1) * 32 + (swz % 64) / 2; }
__host__ __device__ __forceinline__ int perm32(int rho) { const int n = rho >> 4, i = rho & 15; return 8 * (i >> 2) + 4 * n + (i & 3); }

struct Unit { int pm, pn, aux; const char* A; const char* B; };

template <class Epi, class Sched, bool GATHER, bool ALIGN_EPI, int K>
__device__ __forceinline__ void gemm_phase(LAS unsigned char* lds, const Sched& S, const Epi& E) {
    int tid_ = threadIdx.x; asm volatile("" : "+v"(tid_));
    const int tid = tid_, wid = __builtin_amdgcn_readfirstlane(tid >> 6), lane = tid & 63, wr = wid >> 2, wc = wid & 3, fr = lane & 15, fq = lane >> 4;
    constexpr int nt = K / BK;
    int R0, C0; stage_rc(tid * 16, R0, C0);
    unsigned voffA[2], voffB[2];
#pragma unroll
    for (int i = 0; i < 2; ++i) { const int R = R0 + 64 * i; const int Rb = Epi::PERM ? ((R & ~31) + perm32(R & 31)) : R;
        voffA[i] = (unsigned)(R * K + C0) * 2u; voffB[i] = (unsigned)(Rb * K + C0) * 2u; }
    unsigned cvA0[2] = {0u, 0u}, cvA1[2] = {0u, 0u}, nvA0[2] = {0u, 0u}, nvA1[2] = {0u, 0u};
    const size_t kstep = (size_t)(BK * 2);
    const size_t hstep = (size_t)HALF * K * 2;
    const unsigned ldsw = (unsigned)wid * 1024u;
    const int aoff = lds_byte(wr * 64 + fr, fq * 8), boff = lds_byte(wc * 32 + fr, fq * 8);
#define PG8_SA(b, h) (((b) * 2 + (h)) * HTB)
#define PG8_SB(b, h) ((4 + (b) * 2 + (h)) * HTB)
#define PG8_STAGE(bufoff, gbase, voff) do { _Pragma("unroll") for (int _i = 0; _i < 2; ++_i) \
        __builtin_amdgcn_global_load_lds((const unsigned*)((const char*)(gbase) + (voff)[_i]), (LAS unsigned*)(lds + (bufoff) + ldsw + _i * 8192), 16, 0, 0); } while (0)
#define PG8_STAGE_A(b, h, gbase, g0, g1) do { if constexpr (GATHER) { if ((h) == 0) PG8_STAGE(PG8_SA(b, 0), gbase, g0); else PG8_STAGE(PG8_SA(b, 1), gbase, g1); } \
        else { PG8_STAGE(PG8_SA(b, h), (gbase) + ((h) ? hstep : 0), voffA); } } while (0)
#define PG8_ROWS(u, v0, v1) do { _Pragma("unroll") for (int _i = 0; _i < 2; ++_i) { v0[_i] = (unsigned)(S.arow(u, R0 + 64 * _i) * K + C0) * 2u; v1[_i] = (unsigned)(S.arow(u, 128 + R0 + 64 * _i) * K + C0) * 2u; } } while (0)
#define PG8_LDA(dst, b, h) do { _Pragma("unroll") for (int m = 0; m < 4; ++m) _Pragma("unroll") for (int k = 0; k < 2; ++k) dst[m][k] = *(const LAS bf16x8*)(lds + PG8_SA(b, h) + aoff + m * 2048 + k * 1024); } while (0)
#define PG8_LDB(dst, b, h) do { _Pragma("unroll") for (int n = 0; n < 2; ++n) _Pragma("unroll") for (int k = 0; k < 2; ++k) dst[n][k] = *(const LAS bf16x8*)(lds + PG8_SB(b, h) + boff + n * 2048 + k * 1024); } while (0)
#define PG8_MMA(ai, bj, At, Bt) do { __builtin_amdgcn_s_setprio(1); _Pragma("unroll") for (int m = 0; m < 4; ++m) _Pragma("unroll") for (int n = 0; n < 2; ++n) _Pragma("unroll") for (int k = 0; k < 2; ++k) \
        acc[ai][bj][m][n] = __builtin_amdgcn_mfma_f32_16x16x32_bf16(Bt[n][k], At[m][k], acc[ai][bj][m][n], 0, 0, 0); __builtin_amdgcn_s_setprio(0); } while (0)
#define PG8_WAIT_V(n) asm volatile("s_waitcnt vmcnt(" #n ")" ::: "memory")
#define PG8_WAIT_L(n) asm volatile("s_waitcnt lgkmcnt(" #n ")" ::: "memory")
#define PG8_BAR __builtin_amdgcn_s_barrier()
#define PG8_SCHED __builtin_amdgcn_sched_barrier(0)
    Unit cur, nxt; int ui = 0;
    if (!S.next(0, cur)) return;
    f32x4 acc[2][2][4][2];
#pragma unroll
    for (int a = 0; a < 2; ++a)
#pragma unroll
        for (int b = 0; b < 2; ++b)
#pragma unroll
            for (int m = 0; m < 4; ++m)
#pragma unroll
                for (int n = 0; n < 2; ++n) acc[a][b][m][n] = (f32x4){0.f, 0.f, 0.f, 0.f};
    bf16x8 At[4][2], B0[2][2], B1[2][2];
    const char* cA = cur.A; const char* cB = cur.B;
    if constexpr (GATHER) { PG8_ROWS(cur, cvA0, cvA1); }
    PG8_STAGE(PG8_SB(0, 0), cB, voffB); PG8_STAGE(PG8_SB(0, 1), cB + hstep, voffB); PG8_STAGE_A(0, 0, cA, cvA0, cvA1); PG8_STAGE_A(0, 1, cA, cvA0, cvA1);
    if (wr == 1) PG8_BAR;
    PG8_WAIT_V(2); PG8_BAR;
    PG8_STAGE(PG8_SB(1, 0), cB + kstep, voffB); PG8_STAGE_A(1, 0, cA + kstep, cvA0, cvA1); PG8_STAGE(PG8_SB(1, 1), cB + hstep + kstep, voffB);
    PG8_WAIT_V(6); PG8_BAR;
    for (;;) {
        const bool has_next = S.next(ui + 1, nxt);
        const char* nA = has_next ? nxt.A : cA; const char* nB = has_next ? nxt.B : cB;
        if constexpr (GATHER) { if (has_next) { PG8_ROWS(nxt, nvA0, nvA1); } else {
#pragma unroll
            for (int i = 0; i < 2; ++i) { nvA0[i] = cvA0[i]; nvA1[i] = cvA1[i]; } } }
        for (int t = 0; t < nt; t += 2) {
            const bool last = (t == nt - 2);
            const char* a1 = cA + (size_t)(t + 1) * kstep;
            const char* a2 = last ? nA : cA + (size_t)(t + 2) * kstep; const char* b2 = last ? nB : cB + (size_t)(t + 2) * kstep;
            const char* a3 = a2 + kstep; const char* b3 = b2 + kstep;
            unsigned sA0[2], sA1[2];
#pragma unroll
            for (int i = 0; i < 2; ++i) { sA0[i] = last ? nvA0[i] : cvA0[i]; sA1[i] = last ? nvA1[i] : cvA1[i]; }
            PG8_LDB(B0, 0, 0); PG8_LDB(B1, 0, 1); PG8_SCHED; PG8_LDA(At, 0, 0); PG8_STAGE_A(1, 1, a1, cvA0, cvA1);
            PG8_WAIT_V(8); PG8_WAIT_L(0); PG8_BAR; PG8_MMA(0, 0, At, B0); PG8_MMA(0, 1, At, B1); PG8_BAR; PG8_SCHED;
            PG8_LDA(At, 0, 1); PG8_STAGE(PG8_SB(0, 0), b2, voffB); PG8_STAGE(PG8_SB(0, 1), b2 + hstep, voffB); PG8_STAGE_A(0, 0, a2, sA0, sA1);
            PG8_WAIT_V(8); PG8_WAIT_L(0); PG8_BAR; PG8_MMA(1, 0, At, B0); PG8_MMA(1, 1, At, B1); PG8_BAR; PG8_SCHED;
            PG8_LDB(B0, 1, 0); PG8_LDB(B1, 1, 1); PG8_SCHED; PG8_LDA(At, 1, 0); PG8_STAGE_A(0, 1, a2, sA0, sA1);
            PG8_WAIT_V(8); PG8_WAIT_L(0); PG8_BAR; PG8_MMA(0, 0, At, B0); PG8_MMA(0, 1, At, B1); PG8_BAR; PG8_SCHED;
            PG8_LDA(At, 1, 1); PG8_STAGE(PG8_SB(1, 0), b3, voffB); PG8_STAGE(PG8_SB(1, 1), b3 + hstep, voffB); PG8_STAGE_A(1, 0, a3, sA0, sA1);
            PG8_WAIT_V(8); PG8_WAIT_L(0); PG8_BAR; PG8_MMA(1, 0, At, B0); PG8_MMA(1, 1, At, B1); PG8_BAR; PG8_SCHED;
        }
        if constexpr (ALIGN_EPI) { if (wr == 0) PG8_BAR; }
        E(acc, cur, wr, wc, fr, fq);
        if (!has_next) break;
#pragma unroll
        for (int a = 0; a < 2; ++a)
#pragma unroll
            for (int b = 0; b < 2; ++b)
#pragma unroll
                for (int m = 0; m < 4; ++m)
#pragma unroll
                    for (int n = 0; n < 2; ++n) acc[a][b][m][n] = (f32x4){0.f, 0.f, 0.f, 0.f};
        cur = nxt; cA = nA; cB = nB; ++ui;
        if constexpr (GATHER) {
#pragma unroll
            for (int i = 0; i < 2; ++i) { cvA0[i] = nvA0[i]; cvA1[i] = nvA1[i]; } }
        if constexpr (ALIGN_EPI) { if (wr == 1) PG8_BAR; }
    }
    PG8_WAIT_V(0);
    if constexpr (!ALIGN_EPI) { if (wr == 0) PG8_BAR; }
    PG8_BAR;
#undef PG8_SA
#undef PG8_SB
#undef PG8_STAGE
#undef PG8_STAGE_A
#undef PG8_ROWS
#undef PG8_LDA
#undef PG8_LDB
#undef PG8_MMA
#undef PG8_WAIT_V
#undef PG8_WAIT_L
#undef PG8_BAR
#undef PG8_SCHED
}

struct SchedRect {
    const char* A; const char* B; size_t tA, tB; int nM, nN, nwg, G, c;
    __device__ __forceinline__ void init(const void* A_, const void* B_, int M, int N, int K, int G_, int c_) { A = (const char*)A_; B = (const char*)B_; tA = tB = (size_t)BM * K * 2; nM = M / BM; nN = N / BM; nwg = nM * nN; G = G_; c = c_; }
    __device__ __forceinline__ bool next(int i, Unit& u) const {
        const long L = (long)i * G + c; if (L >= nwg) return false;
        int wgid = (int)L; { const int q = nwg / NXCD, r = nwg % NXCD, xcd = wgid % NXCD, off = wgid / NXCD; wgid = (xcd < r ? xcd * (q + 1) : r * (q + 1) + (xcd - r) * q) + off; }
        const int nig = WGM * nN, gid = wgid / nig, fm = gid * WGM, gsz = (nM - fm) < WGM ? (nM - fm) : WGM;
        u.pm = fm + ((wgid % nig) % gsz); u.pn = (wgid % nig) / gsz; u.aux = 0; u.A = A + (size_t)u.pm * tA; u.B = B + (size_t)u.pn * tB; return true;
    }
    __device__ __forceinline__ int arow(const Unit&, int) const { return 0; }
};
struct SchedOne {
    bool has; Unit u0;
    __device__ __forceinline__ bool next(int i, Unit& u) const { if (i > 0 || !has) return false; u = u0; return true; }
    __device__ __forceinline__ int arow(const Unit&, int) const { return 0; }
};
struct SchedMoe {
    const LAS int* tbase; const LAS int* idx; const char* A; const char* B; size_t tA, eB, tB; int G, c, ntiles; bool gather;
    __device__ __forceinline__ bool next(int i, Unit& u) const {
        const int L = i * G + c, T = L >> 2; if (T >= ntiles) return false;
        int e = 0;
#pragma unroll 1
        for (int j = 1; j < 32; ++j) e += (tbase[j] <= T) ? 1 : 0;
        e = __builtin_amdgcn_readfirstlane(e);
        u.pm = T; u.pn = L & 3; u.aux = e | (i << 8); u.A = gather ? A : A + (size_t)T * tA; u.B = B + (size_t)e * eB + (size_t)(L & 3) * tB; return true;
    }
    __device__ __forceinline__ int arow(const Unit& u, int r) const { return idx[(u.aux >> 8) * 256 + r]; }
};

struct EpiBf16 {
    static constexpr bool PERM = true;
    bf16_t* O; int ldc;
    __device__ __forceinline__ void operator()(const f32x4 (&acc)[2][2][4][2], const Unit& u, int wr, int wc, int fr, int fq) const {
        const int row0 = u.pm * BM + wr * 64 + fr, col0 = u.pn * BM + wc * 32 + 8 * fq;
#pragma unroll
        for (int ai = 0; ai < 2; ++ai)
#pragma unroll
            for (int m = 0; m < 4; ++m) { bf16_t* rowp = O + (size_t)(row0 + ai * HALF + m * 16) * ldc + col0;
#pragma unroll
                for (int bj = 0; bj < 2; ++bj) { const f32x4 v0 = acc[ai][bj][m][0], v1 = acc[ai][bj][m][1];
                    u32x4 w; w.x = cvtpk(v0[0], v0[1]); w.y = cvtpk(v0[2], v0[3]); w.z = cvtpk(v1[0], v1[1]); w.w = cvtpk(v1[2], v1[3]);
                    *(u32x4*)(rowp + bj * HALF) = w; } }
    }
};
struct EpiT {
    static constexpr bool PERM = true;
    bf16_t *ftx, *ftc, *vtx, *vtc;
    __device__ __forceinline__ void operator()(const f32x4 (&acc)[2][2][4][2], const Unit& u, int wr, int wc, int fr, int fq) const {
        bf16_t* base; int pitch;
        const int b = (u.pn < 64) ? (u.pn >> 3) : (u.pn - 64);
        if (u.pm == 0) { if (u.pn < 64) { base = ftx + (size_t)b * 256 * 2048 + (u.pn & 7) * 256; pitch = 2048; } else { base = ftc + (size_t)b * 256 * 256; pitch = 256; } }
        else { const int v0 = (u.pm - 1) * 256; if (u.pn < 64) { base = vtx + ((size_t)b * 512 + v0) * 2048 + (u.pn & 7) * 256; pitch = 2048; } else { base = vtc + ((size_t)b * 512 + v0) * 256; pitch = 256; } }
        const int row0 = wr * 64 + fr, col0 = wc * 32 + 8 * fq;
#pragma unroll
        for (int ai = 0; ai < 2; ++ai)
#pragma unroll
            for (int m = 0; m < 4; ++m) { bf16_t* rowp = base + (size_t)(row0 + ai * HALF + m * 16) * pitch + col0;
#pragma unroll
                for (int bj = 0; bj < 2; ++bj) { const f32x4 v0 = acc[ai][bj][m][0], v1 = acc[ai][bj][m][1];
                    u32x4 w; w.x = cvtpk(v0[0], v0[1]); w.y = cvtpk(v0[2], v0[3]); w.z = cvtpk(v1[0], v1[1]); w.w = cvtpk(v1[2], v1[3]);
                    *(u32x4*)(rowp + bj * HALF) = w; } }
    }
};
struct EpiDft {
    static constexpr bool PERM = true;
    bf16_t* conc; int ktiles;
    __device__ __forceinline__ void operator()(const f32x4 (&acc)[2][2][4][2], const Unit& u, int wr, int wc, int fr, int fq) const {
        const int cs = u.pm / ktiles, kt = u.pm % ktiles;
        bf16_t* base = conc + ((size_t)u.pn * (ktiles * 256) + kt * 256) * KO + cs * 256;
        const int row0 = wr * 64 + fr, col0 = wc * 32 + 8 * fq;
#pragma unroll
        for (int ai = 0; ai < 2; ++ai)
#pragma unroll
            for (int m = 0; m < 4; ++m) { bf16_t* rowp = base + (size_t)(row0 + ai * HALF + m * 16) * KO + col0;
#pragma unroll
                for (int bj = 0; bj < 2; ++bj) { const f32x4 v0 = acc[ai][bj][m][0], v1 = acc[ai][bj][m][1];
                    u32x4 w; w.x = cvtpk(v0[0], v0[1]); w.y = cvtpk(v0[2], v0[3]); w.z = cvtpk(v1[0], v1[1]); w.w = cvtpk(v1[2], v1[3]);
                    *(u32x4*)(rowp + bj * HALF) = w; } }
    }
};
struct EpiOut {
    static constexpr bool PERM = false;
    float* x1; const float* xin; const float* cin; const float* mod;
    __device__ __forceinline__ void operator()(const f32x4 (&acc)[2][2][4][2], const Unit& u, int wr, int wc, int fr, int fq) const {
        const int rr = (u.pm < 64) ? (u.pm >> 3) : 8;
        const int row0 = u.pm * BM + wr * 64 + fr, col0 = u.pn * BM + wc * 32 + 4 * fq;
        const float* res = xin ? ((u.pm < 64) ? xin + (size_t)row0 * D : cin + (size_t)(row0 - NX) * D) : x1 + (size_t)row0 * D;
        const float* g1 = mod + rr * 6144 + 2 * D + col0;
        f32x4 gv[2][2];
#pragma unroll
        for (int bj = 0; bj < 2; ++bj)
#pragma unroll
            for (int n = 0; n < 2; ++n) gv[bj][n] = *(const f32x4*)(g1 + bj * HALF + n * 16);
#pragma unroll
        for (int ai = 0; ai < 2; ++ai)
#pragma unroll
            for (int m = 0; m < 4; ++m) { const size_t ro = (size_t)(ai * HALF + m * 16) * D + col0; float* op = x1 + (size_t)row0 * D + ro;
#pragma unroll
                for (int bj = 0; bj < 2; ++bj)
#pragma unroll
                    for (int n = 0; n < 2; ++n) { const f32x4 r = *(const f32x4*)(res + ro + bj * HALF + n * 16);
                        *(f32x4*)(op + bj * HALF + n * 16) = r + gv[bj][n] * acc[ai][bj][m][n]; } }
    }
};
struct EpiUp {
    static constexpr bool PERM = false;
    bf16_t* H;
    __device__ __forceinline__ void operator()(const f32x4 (&acc)[2][2][4][2], const Unit& u, int wr, int wc, int fr, int fq) const {
        const int row0 = u.pm * BM + wr * 64 + fr;
#pragma unroll
        for (int ai = 0; ai < 2; ++ai)
#pragma unroll
            for (int m = 0; m < 4; ++m) { bf16_t* rowp = H + (size_t)(row0 + ai * HALF + m * 16) * DE;
#pragma unroll
                for (int bj = 0; bj < 2; ++bj) { const int hid = 16 * (8 * u.pn + 4 * bj + wc) + 4 * fq;
                    const f32x4 g = acc[ai][bj][m][0], up = acc[ai][bj][m][1]; float h[4];
#pragma unroll
                    for (int j = 0; j < 4; ++j) h[j] = g[j] * __builtin_amdgcn_rcpf(1.f + __builtin_amdgcn_exp2f(-LOG2E * g[j])) * up[j];
                    u32x2 w; w.x = cvtpk(h[0], h[1]); w.y = cvtpk(h[2], h[3]);
                    *(u32x2*)(rowp + hid) = w; } }
    }
};
struct EpiDown {
    static constexpr bool PERM = true;
    bf16_t* y2; const int* rowlist; const float* tokw; const LAS int* tcnt; const LAS int* tbase;
    __device__ __forceinline__ void operator()(const f32x4 (&acc)[2][2][4][2], const Unit& u, int wr, int wc, int fr, int fq) const {
        const int e = u.aux & 255, cnt = tcnt[e], j0 = (u.pm - tbase[e]) * 256 + wr * 64 + fr;
        const int col0 = u.pn * BM + wc * 32 + 8 * fq;
        int ts[2][4]; float pw[2][4];
#pragma unroll
        for (int ai = 0; ai < 2; ++ai)
#pragma unroll
            for (int m = 0; m < 4; ++m) { const int j = j0 + ai * HALF + m * 16; ts[ai][m] = (j < cnt) ? rowlist[(size_t)e * MT + j] : -1; }
#pragma unroll
        for (int ai = 0; ai < 2; ++ai)
#pragma unroll
            for (int m = 0; m < 4; ++m) pw[ai][m] = (ts[ai][m] >= 0) ? tokw[ts[ai][m]] : 0.f;
#pragma unroll
        for (int ai = 0; ai < 2; ++ai)
#pragma unroll
            for (int m = 0; m < 4; ++m) {
                if (ts[ai][m] >= 0) { bf16_t* rowp = y2 + (size_t)ts[ai][m] * D + col0; const float w_ = pw[ai][m];
#pragma unroll
                    for (int bj = 0; bj < 2; ++bj) { const f32x4 v0 = acc[ai][bj][m][0] * w_, v1 = acc[ai][bj][m][1] * w_;
                        u32x4 w; w.x = cvtpk(v0[0], v0[1]); w.y = cvtpk(v0[2], v0[3]); w.z = cvtpk(v1[0], v1[1]); w.w = cvtpk(v1[2], v1[3]);
                        *(u32x4*)(rowp + bj * HALF) = w; } } }
    }
};
}

struct Params {
    const float *x, *c, *ctx, *c_ctx, *w_ada, *b_ada, *norm1, *norm2, *w_in, *w_fourier, *w_conv, *rpb, *w_out, *w_rg, *b_rg, *w_re, *b_re, *w_gate, *w_up, *w_down, *norm_final;
    float* out; unsigned char* ws; int ph_lo, ph_hi, rep0, pad;
};
typedef const __attribute__((address_space(4))) Params CP;
__device__ __forceinline__ CP* opaque_args(CP* p) { asm volatile("" : "+s"(p)); return p; }
struct Ctx { LAS unsigned char* lds; int tid, lane, wave, G, vcu, gw, ngw; };
__device__ __forceinline__ Ctx reopaque(const Ctx& c) { Ctx r = c; int t = threadIdx.x; asm volatile("" : "+v"(t)); r.tid = t; r.lane = t & 63; return r; }

__device__ __forceinline__ void tr_item(const float* src, int ldn, int k0, int n0, bf16_t* dst, int ldk, int kd0, int rtype, LAS float* scr, int lane) {
#pragma unroll 8
    for (int i = 0; i < 32; ++i) { const int kk = 2 * i + (lane >> 5); scr[kk * 33 + (lane & 31)] = src[(size_t)(k0 + kk) * ldn + n0 + (lane & 31)]; }
    LDS_WAIT(); asm volatile("" ::: "memory");
    const int c = lane & 7;
#pragma unroll
    for (int j = 0; j < 4; ++j) { const int n = (lane >> 3) + 8 * j; const LAS float* s = scr + (8 * c) * 33 + n;
        const int sn = n0 + n; int dr; float sc = 1.f;
        if (rtype == 0) { dr = (sn < 256) ? sn : (sn < 1280 ? sn + 512 : (sn < 1792 ? sn - 1024 : sn)); if (sn >= 256 && sn < 768) sc = QSCALE; }
        else if (rtype == 2) dr = 32 * (sn >> 4) + (sn & 15);
        else if (rtype == 3) dr = 32 * (sn >> 4) + 16 + (sn & 15);
        else dr = sn;
        u32x4 o; o.x = cvtpk(s[0 * 33] * sc, s[1 * 33] * sc); o.y = cvtpk(s[2 * 33] * sc, s[3 * 33] * sc); o.z = cvtpk(s[4 * 33] * sc, s[5 * 33] * sc); o.w = cvtpk(s[6 * 33] * sc, s[7 * 33] * sc);
        *(u32x4*)(dst + (size_t)dr * ldk + kd0 + 8 * c) = o; }
    LDS_WAIT(); asm volatile("" ::: "memory");
}
__device__ __forceinline__ void phase_p0a(CP* p0, const Ctx& cx0) {
    const Ctx cx = reopaque(cx0); CP* p = opaque_args(p0);
    LAS float* T = (LAS float*)(cx.lds + 69632);
    LAS float* sl = (LAS float*)(cx.lds + 69632 + 8192);
    LAS float* scr = (LAS float*)(cx.lds + cx.wave * 8448);
    unsigned char* ws = p->ws;
    for (int j = cx.tid; j < 2048; j += 512) T[j] = cospif((float)j * (1.0f / 1024.0f));
    __syncthreads();
    const int gt = cx.vcu * 512 + cx.tid, ngt = cx.G * 512;
    { bf16_t* AX = (bf16_t*)(ws + WS_ADFTX); const float SX = 0.0027621358640099513f;
      for (int it = gt; it < 4096 * 256; it += ngt) { const int R = it >> 8, n0 = (it & 255) * 8, cs = R >> 11, k = R & 2047; float v[8];
#pragma unroll
          for (int j = 0; j < 8; ++j) { const int idx = (k * (n0 + j)) & 2047; v[j] = T[cs ? ((idx - 512) & 2047) : idx] * SX; }
          u32x4 o; o.x = cvtpk(v[0], v[1]); o.y = cvtpk(v[2], v[3]); o.z = cvtpk(v[4], v[5]); o.w = cvtpk(v[6], v[7]);
          *(u32x4*)(AX + (size_t)R * 2048 + n0) = o; }
      bf16_t* AC = (bf16_t*)(ws + WS_ADFTC); const float SC = 1.0f / 128.0f;
      for (int it = gt; it < 512 * 32; it += ngt) { const int R = it >> 5, n0 = (it & 31) * 8, cs = R >> 8, k = R & 255; float v[8];
#pragma unroll
          for (int j = 0; j < 8; ++j) { const int idx = (8 * k * (n0 + j)) & 2047; v[j] = T[cs ? ((idx - 512) & 2047) : idx] * SC; }
          u32x4 o; o.x = cvtpk(v[0], v[1]); o.y = cvtpk(v[2], v[3]); o.z = cvtpk(v[4], v[5]); o.w = cvtpk(v[6], v[7]);
          *(u32x4*)(AC + (size_t)R * 256 + n0) = o; } }
    { float* MW = (float*)(ws + WS_MW);
      for (int it = gt; it < 2 * 512 * 256; it += ngt) { const int j = it & 255, kp = (it >> 8) & 511, li = it >> 17, cs = kp >> 8, g = (kp >> 6) & 3, cc = kp & 63;
          const float* wf = p->w_fourier + (size_t)li * 65536 + (size_t)(64 * g) * 256 + j; float a = 0.f;
          for (int l = 0; l < 64; ++l) { const int idx = (32 * l * cc) & 2047; const float mix = cs ? -T[(idx - 512) & 2047] : T[idx]; a += mix * wf[l * 256]; }
          MW[it] = a; } }
    { bf16_t* WH = (bf16_t*)(ws + WS_WRT); bf16_t* WL = WH + 2 * 48 * 1024;
      for (int it = gt; it < 2 * 48 * 1024; it += ngt) { const int k = it & 1023, c = (it >> 10) % 48, li = it / 49152;
          const float w = (c < 4) ? p->w_rg[(size_t)li * 4096 + k * 4 + c] : ((c < 36) ? p->w_re[(size_t)li * 32768 + k * 32 + (c - 4)] : 0.f);
          const unsigned hb = cvtpk(w, 0.f) & 0xffffu; const float lo = w - bf2f((unsigned short)hb);
          WH[it] = (bf16_t)hb; WL[it] = (bf16_t)(cvtpk(lo, 0.f) & 0xffffu); } }
    { float* MP = (float*)(ws + WS_MODP);
      for (int u = cx.vcu; u < 768; u += cx.G) { const int kc = u & 31, jc = (u >> 5) % 12, li = u / 384;
          __syncthreads();
          if (cx.tid < 288) { const int r = cx.tid >> 5, kk = cx.tid & 31, k = kc * 32 + kk; const float v = (r < 8) ? p->c[r * 1024 + k] : p->c_ctx[k]; sl[cx.tid] = v / (1.f + __expf(-v)); }
          __syncthreads();
          const int j = jc * 512 + cx.tid; float a[9];
#pragma unroll
          for (int r = 0; r < 9; ++r) a[r] = 0.f;
          const float* wp = p->w_ada + ((size_t)li * 1024 + kc * 32) * 6144 + j;
#pragma unroll 8
          for (int kk = 0; kk < 32; ++kk) { const float w = wp[(size_t)kk * 6144];
#pragma unroll
              for (int r = 0; r < 9; ++r) a[r] += sl[r * 32 + kk] * w; }
#pragma unroll
          for (int r = 0; r < 9; ++r) MP[((size_t)(li * 32 + kc) * 9 + r) * 6144 + j] = a[r]; }
      __syncthreads(); }
    { bf16_t* WIN = (bf16_t*)(ws + WS_WIN); bf16_t* WOUT = (bf16_t*)(ws + WS_WOUT); bf16_t* WGU = (bf16_t*)(ws + WS_WGU); bf16_t* WDN = (bf16_t*)(ws + WS_WD);
      constexpr int I0 = 2 * 1280, I1 = 2 * 384, I2 = 64 * 256;
      for (int it = cx.gw; it < I0 + I1 + 3 * I2; it += cx.ngw) { int r = it;
          if (r < I0) { const int li = r / 1280, q = r % 1280, kb = q / 80, nb = q % 80;
              tr_item(p->w_in + (size_t)li * 1024 * 2560, 2560, kb * 64, nb * 32, WIN + (size_t)li * 2560 * 1024, 1024, kb * 64, 0, scr, cx.lane); continue; } r -= I0;
          if (r < I1) { const int li = r / 384, q = r % 384, kb = q / 32, nb = q % 32;
              tr_item(p->w_out + (size_t)li * 1024 * 1024, 1024, 256 + kb * 64, nb * 32, WOUT + (size_t)li * 1024 * 1280, 1280, 512 + kb * 64, 1, scr, cx.lane); continue; } r -= I1;
          if (r < I2) { const int le = r >> 8, q = r & 255, kb = q >> 4, nb = q & 15;
              tr_item(p->w_gate + (size_t)le * 1024 * 512, 512, kb * 64, nb * 32, WGU + (size_t)le * 1024 * 1024, 1024, kb * 64, 2, scr, cx.lane); continue; } r -= I2;
          if (r < I2) { const int le = r >> 8, q = r & 255, kb = q >> 4, nb = q & 15;
              tr_item(p->w_up + (size_t)le * 1024 * 512, 512, kb * 64, nb * 32, WGU + (size_t)le * 1024 * 1024, 1024, kb * 64, 3, scr, cx.lane); continue; } r -= I2;
          { const int le = r >> 8, q = r & 255, kb = q >> 5, nb = q & 31;
              tr_item(p->w_down + (size_t)le * 512 * 1024, 1024, kb * 64, nb * 32, WDN + (size_t)le * 1024 * 512, 512, kb * 64, 4, scr, cx.lane); } } }
}
__device__ __forceinline__ void phase_p0b(CP* p0, const Ctx& cx0) {
    const Ctx cx = reopaque(cx0); CP* p = opaque_args(p0);
    unsigned char* ws = p->ws; const int gt = cx.vcu * 512 + cx.tid, ngt = cx.G * 512;
    { const float* MP = (const float*)(ws + WS_MODP); float* MOD = (float*)(ws + WS_MOD);
      for (int it = gt; it < 2 * 9 * 6144; it += ngt) { const int j = it % 6144, r = (it / 6144) % 9, li = it / (9 * 6144); float a = p->b_ada[li * 6144 + j];
          for (int kc = 0; kc < 32; ++kc) a += MP[((size_t)(li * 32 + kc) * 9 + r) * 6144 + j];
          MOD[it] = a; } }
    { const float* MW = (const float*)(ws + WS_MW); bf16_t* WOUT = (bf16_t*)(ws + WS_WOUT);
      for (int it = gt; it < 2 * 64 * 1024; it += ngt) { const int n = it & 1023, k8 = (it >> 10) & 63, li = it >> 16; float a[8];
#pragma unroll
          for (int i = 0; i < 8; ++i) a[i] = 0.f;
          const float* wo = p->w_out + (size_t)li * 1024 * 1024 + n; const float* mw = MW + ((size_t)li * 512 + k8 * 8) * 256;
          for (int j = 0; j < 256; ++j) { const float w = wo[(size_t)j * 1024];
#pragma unroll
              for (int i = 0; i < 8; ++i) a[i] += mw[i * 256 + j] * w; }
          u32x4 o; o.x = cvtpk(a[0], a[1]); o.y = cvtpk(a[2], a[3]); o.z = cvtpk(a[4], a[5]); o.w = cvtpk(a[6], a[7]);
          *(u32x4*)(WOUT + ((size_t)li * 1024 + n) * 1280 + k8 * 8) = o; } }
}
__device__ __forceinline__ void phase_norm1(CP* p0, const Ctx& cx0, int li) {
    const Ctx cx = reopaque(cx0); CP* p = opaque_args(p0);
    unsigned char* ws = p->ws; float* X1 = (float*)(ws + WS_X1); const bf16_t* Y2 = (const bf16_t*)(ws + WS_Y2); bf16_t* H1 = (bf16_t*)(ws + WS_H1);
    const float* MOD = (const float*)(ws + WS_MOD) + (size_t)li * 9 * 6144; const float* n1 = p->norm1 + li * 1024;
    for (int m = cx.gw; m < MT; m += cx.ngw) {
        f32x4 v[4];
        if (li == 0) { const float* src = (m < NX) ? p->x + (size_t)m * D : p->ctx + (size_t)(m - NX) * D;
#pragma unroll
            for (int j = 0; j < 4; ++j) v[j] = *(const f32x4*)(src + 256 * j + 4 * cx.lane); }
        else { float* xr = X1 + (size_t)m * D; const bf16_t* ya = Y2 + (size_t)m * 2 * D; const float* g2 = MOD - 9 * 6144 + ((m < NX) ? (m >> 11) : 8) * 6144 + 5 * D;
#pragma unroll
            for (int j = 0; j < 4; ++j) { v[j] = *(const f32x4*)(xr + 256 * j + 4 * cx.lane); const f32x4 gg = *(const f32x4*)(g2 + 256 * j + 4 * cx.lane);
                const u32x2 a = *(const u32x2*)(ya + 256 * j + 4 * cx.lane), b = *(const u32x2*)(ya + D + 256 * j + 4 * cx.lane);
                v[j][0] += gg[0] * (bflo(a.x) + bflo(b.x)); v[j][1] += gg[1] * (bfhi(a.x) + bfhi(b.x)); v[j][2] += gg[2] * (bflo(a.y) + bflo(b.y)); v[j][3] += gg[3] * (bfhi(a.y) + bfhi(b.y));
                *(f32x4*)(xr + 256 * j + 4 * cx.lane) = v[j]; } }
        float ss = 0.f;
#pragma unroll
        for (int j = 0; j < 4; ++j) ss += v[j][0] * v[j][0] + v[j][1] * v[j][1] + v[j][2] * v[j][2] + v[j][3] * v[j][3];
        const float r = 1.0f / sqrtf(wave_sum(ss) * (1.0f / D) + 1e-6f);
        const int rr = (m < NX) ? (m >> 11) : 8; const float* sh = MOD + rr * 6144; const float* sc = sh + D;
#pragma unroll
        for (int j = 0; j < 4; ++j) { const int k = 256 * j + 4 * cx.lane; const f32x4 g = *(const f32x4*)(n1 + k), s1 = *(const f32x4*)(sc + k), h1 = *(const f32x4*)(sh + k);
            const f32x4 o = v[j] * r * g * (s1 + 1.0f) + h1; u32x2 w; w.x = cvtpk(o[0], o[1]); w.y = cvtpk(o[2], o[3]);
            *(u32x2*)(H1 + (size_t)m * D + k) = w; }
    }
}
__device__ __forceinline__ void phase_inproj(CP* p0, const Ctx& cx0, int li) {
    const Ctx cx = reopaque(cx0); CP* p = opaque_args(p0);
    unsigned char* ws = p->ws; const bf16_t* H1 = (const bf16_t*)(ws + WS_H1); const bf16_t* WIN = (const bf16_t*)(ws + WS_WIN) + (size_t)li * 2560 * 1024;
    if (!(MK_SUB & 1)) { pg8::SchedRect S; S.init(H1, WIN + (size_t)768 * 1024, MT, NU, D, cx.G, (int)blockIdx.x);
      pg8::EpiBf16 E{(bf16_t*)(ws + WS_U), NU};
      pg8::gemm_phase<pg8::EpiBf16, pg8::SchedRect, false, true, D>(cx.lds, S, E); }
    if (!(MK_SUB & 2)) { pg8::SchedRect S; S.init(WIN, H1, 768, MT, D, cx.G, (int)blockIdx.x);
      pg8::EpiT E{(bf16_t*)(ws + WS_FTX), (bf16_t*)(ws + WS_FTC), (bf16_t*)(ws + WS_VTX), (bf16_t*)(ws + WS_VTC)};
      pg8::gemm_phase<pg8::EpiT, pg8::SchedRect, false, true, D>(cx.lds, S, E); }
}
struct AttnPtrs { const bf16_t* U; const bf16_t* vtx; const bf16_t* vtc; bf16_t* conc; };
__device__ __forceinline__ void attn_dma_step(const AttnPtrs& a, int t, int b, int h, int krlo, int wave, int lane, LAS unsigned char* slot) {
    const bf16_t* kp; const bf16_t* vp; size_t vpitch;
    if (t < 4) { kp = a.U + (size_t)(NX + b * 256 + 64 * t) * NU + 512 + h * 64; vp = a.vtc + ((size_t)b * 512 + h * 64) * 256 + 64 * t; vpitch = 256; }
    else { const int t0 = 64 * (krlo + t - 4); kp = a.U + (size_t)(b * 2048 + t0) * NU + 512 + h * 64; vp = a.vtx + ((size_t)b * 512 + h * 64) * 2048 + t0; vpitch = 2048; }
    const int r = 8 * wave + (lane >> 3);
    __builtin_amdgcn_global_load_lds((const unsigned*)(kp + (size_t)r * NU + 8 * ((lane & 7) ^ (r & 7))), (LAS unsigned*)(slot + wave * 1024), 16, 0, 0);
    __builtin_amdgcn_global_load_lds((const unsigned*)(vp + (size_t)r * vpitch + 8 * ((lane & 7) ^ ((r >> 1) & 7))), (LAS unsigned*)(slot + 8192 + wave * 1024), 16, 0, 0);
}
__device__ __forceinline__ void attn_frags(const LAS unsigned char* sl, int kb0, int lane, bf16x8 (&kf)[4], bf16x8 (&vf)[4]) {
    const int q = lane & 31, hh = lane >> 5, key = kb0 + q;
#pragma unroll
    for (int s = 0; s < 4; ++s) kf[s] = *(const LAS bf16x8*)(sl + key * 128 + (((2 * s + hh) ^ (key & 7)) << 4));
#pragma unroll
    for (int s2 = 0; s2 < 2; ++s2)
#pragma unroll
        for (int dh = 0; dh < 2; ++dh) { const int d = 32 * dh + q, fd = (d >> 1) & 7, ch = (kb0 >> 3) + 2 * s2;
            const bf16x4 lo = *(const LAS bf16x4*)(sl + 8192 + d * 128 + ((ch ^ fd) << 4) + (hh << 3)), hi = *(const LAS bf16x4*)(sl + 8192 + d * 128 + (((ch + 1) ^ fd) << 4) + (hh << 3));
            vf[s2 * 2 + dh] = (bf16x8){lo[0], lo[1], lo[2], lo[3], hi[0], hi[1], hi[2], hi[3]}; }
}
#define ATT_COMPUTE(loc_, kr_, kf_, vf_) do { \
    f32x16 s_; \
    if (loc_) { const bool rok_ = ((kr_) >= rsq) && ((kr_) < rsq + 8); int ro_ = (kr_) - rq + 7; ro_ = ro_ < 0 ? 0 : (ro_ > 14 ? 14 : ro_); \
        const LAS float* bp_ = tblh + ro_ * 64 + cbase; const float rp_ = rok_ ? 0.f : -1e30f; \
        _Pragma("unroll") for (int i_ = 0; i_ < 16; ++i_) s_[i_] = bp_[(i_ & 3) + 8 * (i_ >> 2)] + colpen[i_] + rp_; } \
    else { _Pragma("unroll") for (int i_ = 0; i_ < 16; ++i_) s_[i_] = 0.f; } \
    _Pragma("unroll") for (int k_ = 0; k_ < 4; ++k_) s_ = __builtin_amdgcn_mfma_f32_32x32x16_bf16(kf_[k_], qf[k_], s_, 0, 0, 0); \
    float cm_ = s_[0]; \
    _Pragma("unroll") for (int i_ = 1; i_ < 16; ++i_) cm_ = fmaxf(cm_, s_[i_]); \
    cm_ = fmaxf(cm_, __shfl_xor(cm_, 32)); \
    const float mn_ = fmaxf(mrun, cm_); const float al_ = __builtin_amdgcn_exp2f(mrun - mn_); mrun = mn_; \
    float ps_ = 0.f; \
    _Pragma("unroll") for (int i_ = 0; i_ < 16; ++i_) { s_[i_] = __builtin_amdgcn_exp2f(s_[i_] - mn_); ps_ += s_[i_]; } \
    lsum = lsum * al_ + ps_; \
    _Pragma("unroll") for (int i_ = 0; i_ < 16; ++i_) { o0[i_] *= al_; o1[i_] *= al_; } \
    bf16x8 p0_, p1_; { u32x4 w_; w_.x = cvtpk(s_[0], s_[1]); w_.y = cvtpk(s_[2], s_[3]); w_.z = cvtpk(s_[4], s_[5]); w_.w = cvtpk(s_[6], s_[7]); p0_ = __builtin_bit_cast(bf16x8, w_); \
        w_.x = cvtpk(s_[8], s_[9]); w_.y = cvtpk(s_[10], s_[11]); w_.z = cvtpk(s_[12], s_[13]); w_.w = cvtpk(s_[14], s_[15]); p1_ = __builtin_bit_cast(bf16x8, w_); } \
    o0 = __builtin_amdgcn_mfma_f32_32x32x16_bf16(vf_[0], p0_, o0, 0, 0, 0); o1 = __builtin_amdgcn_mfma_f32_32x32x16_bf16(vf_[1], p0_, o1, 0, 0, 0); \
    o0 = __builtin_amdgcn_mfma_f32_32x32x16_bf16(vf_[2], p1_, o0, 0, 0, 0); o1 = __builtin_amdgcn_mfma_f32_32x32x16_bf16(vf_[3], p1_, o1, 0, 0, 0); \
} while (0)

__device__ __forceinline__ void attn_group(const AttnPtrs& a, const LAS float* tbl, LAS unsigned char* ring, int qi, int gid, int wave, int lane) {
    const int q = lane & 31, hh = lane >> 5;
    int b, h, nsteps, krlo = 0, kr0 = 0, nl = 0, bs = 0, rq = 0, rsq = 0, cq = 0, csq = 0; size_t qrow;
    if (gid < 64) { const int pair = qi * 8 + (gid >> 3), g4 = gid & 7, rp = 2 * g4 + (wave >> 2), cb = wave & 3; b = pair >> 3; h = pair & 7;
        rq = 2 * rp + (q >> 4); cq = 16 * cb + (q & 15);
        rsq = rq - 4; rsq = rsq < 0 ? 0 : (rsq > 24 ? 24 : rsq); csq = cq - 8; csq = csq < 0 ? 0 : (csq > 48 ? 48 : csq);
        kr0 = 2 * rp - 4; kr0 = kr0 < 0 ? 0 : (kr0 > 24 ? 24 : kr0); int kr1 = 2 * rp + 1 - 4; kr1 = kr1 < 0 ? 0 : (kr1 > 24 ? 24 : kr1); nl = kr1 + 8 - kr0;
        krlo = 4 * g4 - 4; krlo = krlo < 0 ? 0 : (krlo > 24 ? 24 : krlo); int krhi = 4 * g4 + 3 - 4; krhi = krhi < 0 ? 0 : (krhi > 24 ? 24 : krhi); nsteps = 4 + (krhi + 8 - krlo);
        bs = (cb == 0) ? 0 : (cb == 1 ? 8 : (cb == 2 ? 24 : 32));
        qrow = (size_t)b * 2048 + 64 * rq + cq; }
    else { const int pair = qi * 8 + (gid - 64); b = pair >> 3; h = pair & 7; nsteps = 4; qrow = (size_t)NX + b * 256 + 32 * wave + q; }
    bf16x8 qf[4];
#pragma unroll
    for (int s = 0; s < 4; ++s) qf[s] = *(const bf16x8*)(a.U + qrow * NU + h * 64 + 16 * s + 8 * hh);
    attn_dma_step(a, 0, b, h, krlo, wave, lane, ring);
    attn_dma_step(a, 1, b, h, krlo, wave, lane, ring + 16384);
    asm volatile("s_waitcnt vmcnt(4)" : "+v"(qf[0]), "+v"(qf[1]), "+v"(qf[2]), "+v"(qf[3]) :: "memory");
    float colpen[16];
#pragma unroll
    for (int i = 0; i < 16; ++i) { const int kc = bs + (i & 3) + 8 * (i >> 2) + 4 * hh; colpen[i] = (kc >= csq && kc < csq + 16) ? 0.f : -1e30f; }
    const LAS float* tblh = tbl + h * (15 * 64); const int cbase = bs - cq + 15 + 16 + 4 * hh;
    f32x16 o0, o1;
#pragma unroll
    for (int i = 0; i < 16; ++i) { o0[i] = 0.f; o1[i] = 0.f; }
    float mrun = -1e30f, lsum = 0.f;
    bf16x8 kf[4], vf[4];
    int slot_t = 0, slot_n = 2;
#pragma unroll 1
    for (int t = 0; t < nsteps; ++t) {
        if (t + 1 < nsteps) asm volatile("s_waitcnt vmcnt(2)" ::: "memory"); else asm volatile("s_waitcnt vmcnt(0)" ::: "memory");
        __builtin_amdgcn_s_barrier();
        if (t + 2 < nsteps) attn_dma_step(a, t + 2, b, h, krlo, wave, lane, ring + slot_n * 16384);
        const LAS unsigned char* sl = ring + slot_t * 16384;
        const bool loc = (t >= 4); const int kr = krlo + t - 4;
        const int nsub = loc ? ((kr >= kr0 && kr < kr0 + nl) ? 1 : 0) : 2;
#pragma unroll 1
        for (int sub = 0; sub < nsub; ++sub) {
            attn_frags(sl, loc ? bs : 32 * sub, lane, kf, vf); asm volatile("s_waitcnt lgkmcnt(0)" ::: "memory"); __builtin_amdgcn_sched_barrier(0);
            ATT_COMPUTE(loc, kr, kf, vf); }
        slot_t = (slot_t == 2) ? 0 : slot_t + 1; slot_n = (slot_n == 2) ? 0 : slot_n + 1;
    }
    const float inv = 1.0f / (lsum + __shfl_xor(lsum, 32));
    bf16_t* op = a.conc + qrow * KO + 512 + h * 64 + 4 * hh;
#pragma unroll
    for (int g = 0; g < 4; ++g) { u32x2 w; w.x = cvtpk(o0[4 * g] * inv, o0[4 * g + 1] * inv); w.y = cvtpk(o0[4 * g + 2] * inv, o0[4 * g + 3] * inv); *(u32x2*)(op + 8 * g) = w;
        w.x = cvtpk(o1[4 * g] * inv, o1[4 * g + 1] * inv); w.y = cvtpk(o1[4 * g + 2] * inv, o1[4 * g + 3] * inv); *(u32x2*)(op + 32 + 8 * g) = w; }
}
__device__ __forceinline__ void phase_mix(CP* p0, const Ctx& cx0, int li, int rep) {
    const Ctx cx = reopaque(cx0); CP* p = opaque_args(p0);
    unsigned char* ws = p->ws; const bf16_t* U = (const bf16_t*)(ws + WS_U); bf16_t* CONC = (bf16_t*)(ws + WS_CONC);
    const int nrows = (li == 0) ? MT : NX;
    for (int rp_ = 0; rp_ < ((MK_MIXREP & 4) ? 3 : 1); ++rp_) if (!(MK_SUB & 16)) { const float* wc = p->w_conv + li * 768;
      for (int it = cx.vcu * 512 + cx.tid; it < nrows * 32; it += cx.G * 512) { const int m = it >> 5, c0 = (it & 31) * 8;
          const int pos = (m < NX) ? (m & 2047) : ((m - NX) & 255), len = (m < NX) ? 2048 : 256;
          const bf16_t* up = U + (size_t)m * NU; float z[3][8];
#pragma unroll
          for (int d = 0; d < 3; ++d) { const bool ok = (pos + d - 1 >= 0) && (pos + d - 1 < len);
              if (ok) { const u32x4 a = *(const u32x4*)(up + (ptrdiff_t)(d - 1) * NU + 1280 + c0), b = *(const u32x4*)(up + (ptrdiff_t)(d - 1) * NU + 1536 + c0);
                  z[d][0] = bflo(a.x) * bflo(b.x); z[d][1] = bfhi(a.x) * bfhi(b.x); z[d][2] = bflo(a.y) * bflo(b.y); z[d][3] = bfhi(a.y) * bfhi(b.y);
                  z[d][4] = bflo(a.z) * bflo(b.z); z[d][5] = bfhi(a.z) * bfhi(b.z); z[d][6] = bflo(a.w) * bflo(b.w); z[d][7] = bfhi(a.w) * bfhi(b.w); }
              else {
#pragma unroll
                  for (int j = 0; j < 8; ++j) z[d][j] = 0.f; } }
          const u32x4 g = *(const u32x4*)(up + 1024 + c0); float gb[8] = {bflo(g.x), bfhi(g.x), bflo(g.y), bfhi(g.y), bflo(g.z), bfhi(g.z), bflo(g.w), bfhi(g.w)}; float o[8];
#pragma unroll
          for (int j = 0; j < 8; ++j) o[j] = gb[j] * (wc[c0 + j] * z[0][j] + wc[256 + c0 + j] * z[1][j] + wc[512 + c0 + j] * z[2][j]);
          u32x4 w; w.x = cvtpk(o[0], o[1]); w.y = cvtpk(o[2], o[3]); w.z = cvtpk(o[4], o[5]); w.w = cvtpk(o[6], o[7]);
          *(u32x4*)(CONC + (size_t)m * KO + 1024 + c0) = w; } }
    for (int rp_ = 0; rp_ < ((MK_MIXREP & 1) ? 3 : 1); ++rp_) if (!(MK_SUB & 4)) { const int c = (int)blockIdx.x;
      { pg8::SchedOne S; S.has = (c < 128); S.u0.pm = c >> 3; S.u0.pn = c & 7; S.u0.aux = 0;
        S.u0.A = (const char*)(ws + WS_ADFTX) + (size_t)(c >> 3) * 256 * 2048 * 2; S.u0.B = (const char*)(ws + WS_FTX) + (size_t)(c & 7) * 256 * 2048 * 2;
        pg8::EpiDft E{CONC, 8};
        pg8::gemm_phase<pg8::EpiDft, pg8::SchedOne, false, false, 2048>(cx.lds, S, E); }
      if (li == 0) { const int c2 = c - 128; pg8::SchedOne S; S.has = (c2 >= 0 && c2 < 16); S.u0.pm = c2 >> 3; S.u0.pn = c2 & 7; S.u0.aux = 0;
        S.u0.A = (const char*)(ws + WS_ADFTC) + (size_t)(c2 >> 3) * 256 * 256 * 2; S.u0.B = (const char*)(ws + WS_FTC) + (size_t)(c2 & 7) * 256 * 256 * 2;
        pg8::EpiDft E{CONC + (size_t)NX * KO, 1};
        pg8::gemm_phase<pg8::EpiDft, pg8::SchedOne, false, false, 256>(cx.lds, S, E); } }
    for (int rp_ = 0; rp_ < ((MK_MIXREP & 2) ? 3 : 1); ++rp_) if (!(MK_SUB & 8)) { LAS float* tbl = (LAS float*)(cx.lds + MISC_OFF + 64);
      __syncthreads();
      for (int i = cx.tid; i < 8 * 15 * 64; i += 512) { const int col = (i & 63) - 16, ro = (i >> 6) % 15, h = i / 960;
          tbl[i] = (col >= 0 && col <= 30) ? p->rpb[(size_t)li * 3720 + h * 465 + ro * 31 + col] * LOG2E : 0.f; }
      __syncthreads();
      AttnPtrs a{U, (const bf16_t*)(ws + WS_VTX), (const bf16_t*)(ws + WS_VTC), CONC};
      unsigned* qw = (unsigned*)(ws + WS_CTL) + CW_ATTQ + li * 512 + rep * 1024 + rp_ * 1024;
      volatile LAS int* gsel = (volatile LAS int*)(cx.lds + MISC_OFF + 32);
      const int nper = (li == 0) ? 72 : 64; const int q0 = (int)(xb_xcc_id() & 7u);
      for (int qq = 0; qq < 8; ++qq) { const int qi = (q0 + qq) & 7;
          for (;;) {
              __syncthreads();
              if (cx.tid == 0) { int g = nper; if ((int)xb_ld(qw + qi * 64) < nper) g = (int)xb_add(qw + qi * 64, 1u); gsel[0] = g; }
              __syncthreads();
              const int gid = __builtin_amdgcn_readfirstlane(gsel[0]);
              if (gid >= nper) break;
              attn_group(a, tbl, cx.lds, qi, gid, cx.wave, cx.lane); } } }
}
__device__ __forceinline__ void phase_outproj(CP* p0, const Ctx& cx0, int li) {
    const Ctx cx = reopaque(cx0); CP* p = opaque_args(p0);
    unsigned char* ws = p->ws;
    pg8::SchedRect S; S.init(ws + WS_CONC, (const bf16_t*)(ws + WS_WOUT) + (size_t)li * 1024 * 1280, (li == 0) ? MT : NX, D, KO, cx.G, (int)blockIdx.x);
    pg8::EpiOut E{(float*)(ws + WS_X1), (li == 0) ? p->x : nullptr, (li == 0) ? p->ctx : nullptr, (const float*)(ws + WS_MOD) + (size_t)li * 9 * 6144};
    pg8::gemm_phase<pg8::EpiOut, pg8::SchedRect, false, true, KO>(cx.lds, S, E);
}
__device__ __forceinline__ void phase_router(CP* p0, const Ctx& cx0, int li, int dummy) {
    const Ctx cx = reopaque(cx0); CP* p = opaque_args(p0);
    unsigned char* ws = p->ws; const float* X1 = (const float*)(ws + WS_X1); bf16_t* TT = (bf16_t*)(ws + WS_H1);
    const float* MOD = (const float*)(ws + WS_MOD) + (size_t)li * 9 * 6144; const float* n2 = p->norm2 + li * 1024;
    const bf16_t* WH = (const bf16_t*)(ws + WS_WRT) + (size_t)li * 48 * 1024; const bf16_t* WL = WH + 2 * 48 * 1024;
    const int M = (li == 0) ? MT : NX; const int RB = (M + cx.G - 1) / cx.G;
    const int RPW = (RB + 7) >> 3;
    const int row0 = cx.vcu * RB;
    LAS float* lg = (LAS float*)cx.lds;
    LAS int* lcnt = (LAS int*)(cx.lds + 12288); LAS int* lbase = (LAS int*)(cx.lds + 12544);
    LAS unsigned char* wb = cx.lds + 16384;
    LAS unsigned char* wa = cx.lds + 16384 + 2 * 48 * 528 + cx.wave * (2 * 9 * 528);
    __syncthreads();
    if (cx.tid < 32) lcnt[cx.tid] = 0;
    u32x4 wreg[6];
#define RT_WLOAD(ii) do { _Pragma("unroll") for (int r_ = 0; r_ < 6; ++r_) { const int p_ = cx.tid + 512 * r_, hl_ = p_ / 1536, q_ = p_ % 1536, c_ = q_ >> 5, k16_ = q_ & 31; \
        wreg[r_] = *(const u32x4*)((hl_ ? WL : WH) + (size_t)c_ * 1024 + 256 * (ii) + 8 * k16_); } } while (0)
#define RT_WSTORE() do { _Pragma("unroll") for (int r_ = 0; r_ < 6; ++r_) { const int p_ = cx.tid + 512 * r_, hl_ = p_ / 1536, q_ = p_ % 1536, c_ = q_ >> 5, k16_ = q_ & 31; \
        *(LAS u32x4*)(wb + hl_ * (48 * 528) + c_ * 528 + 16 * k16_) = wreg[r_]; } } while (0)
    RT_WLOAD(0);
    float rinv[9];
#pragma unroll
    for (int j = 0; j < 9; ++j) { const int rl = cx.wave * RPW + j; int m = row0 + rl; const bool ok = (j < RPW) && (rl < RB) && (m < M); if (!ok) m = row0 < M ? row0 : 0;
        const float* xr = X1 + (size_t)m * D; float ss = 0.f;
#pragma unroll
        for (int i = 0; i < 4; ++i) { const f32x4 v = *(const f32x4*)(xr + 256 * i + 4 * cx.lane); ss += v[0] * v[0] + v[1] * v[1] + v[2] * v[2] + v[3] * v[3]; }
        rinv[j] = 1.0f / sqrtf(wave_sum(ss) * (1.0f / D) + 1e-6f); }
    f32x4 acc[3];
#pragma unroll
    for (int nt = 0; nt < 3; ++nt) acc[nt] = (f32x4){0.f, 0.f, 0.f, 0.f};
    const int col = cx.lane & 15, kq = cx.lane >> 4, rA = (col < 9) ? col : 8;
#pragma unroll 1
    for (int i = 0; i < 4; ++i) {
        if (i > 0) __syncthreads();
        RT_WSTORE();
        if (i < 3) RT_WLOAD(i + 1);
        const int k = 256 * i + 4 * cx.lane; const f32x4 g = *(const f32x4*)(n2 + k);
#pragma unroll
        for (int j = 0; j < 9; ++j) { const int rl = cx.wave * RPW + j; int m = row0 + rl; const bool ok = (j < RPW) && (rl < RB) && (m < M); if (!ok) m = row0 < M ? row0 : 0;
            const int rr = (m < NX) ? (m >> 11) : 8; const float* sh = MOD + rr * 6144 + 3 * D; const float* sc = sh + D;
            const f32x4 v = *(const f32x4*)(X1 + (size_t)m * D + k), s1 = *(const f32x4*)(sc + k), h1 = *(const f32x4*)(sh + k);
            const f32x4 t = v * rinv[j] * g * (s1 + 1.0f) + h1;
            u32x2 h, l; h.x = cvtpk(t[0], t[1]); h.y = cvtpk(t[2], t[3]);
            if (ok) *(u32x2*)(TT + (size_t)m * D + k) = h;
            l.x = cvtpk(t[0] - bflo(h.x), t[1] - bfhi(h.x)); l.y = cvtpk(t[2] - bflo(h.y), t[3] - bfhi(h.y));
            *(LAS u32x2*)(wa + j * 528 + 8 * cx.lane) = h; *(LAS u32x2*)(wa + (9 + j) * 528 + 8 * cx.lane) = l; }
        __syncthreads();
#pragma unroll
        for (int ks = 0; ks < 8; ++ks) { const bf16x8 ah = *(const LAS bf16x8*)(wa + rA * 528 + (32 * ks + 8 * kq) * 2), al = *(const LAS bf16x8*)(wa + (9 + rA) * 528 + (32 * ks + 8 * kq) * 2);
#pragma unroll
            for (int nt = 0; nt < 3; ++nt) { const int wo = (16 * nt + col) * 528 + (32 * ks + 8 * kq) * 2;
                const bf16x8 bh = *(const LAS bf16x8*)(wb + wo), bl = *(const LAS bf16x8*)(wb + 48 * 528 + wo);
                acc[nt] = __builtin_amdgcn_mfma_f32_16x16x32_bf16(ah, bh, acc[nt], 0, 0, 0);
                acc[nt] = __builtin_amdgcn_mfma_f32_16x16x32_bf16(ah, bl, acc[nt], 0, 0, 0);
                acc[nt] = __builtin_amdgcn_mfma_f32_16x16x32_bf16(al, bh, acc[nt], 0, 0, 0); } }
    }
#undef RT_WLOAD
#undef RT_WSTORE
#pragma unroll
    for (int nt = 0; nt < 3; ++nt)
#pragma unroll
        for (int r = 0; r < 4; ++r) { const int row = kq * 4 + r, c = 16 * nt + col; if (row < RPW && c < 36 && cx.wave * RPW + row < 72) lg[(cx.wave * RPW + row) * 36 + c] = acc[nt][r]; }
    __syncthreads();
    int e0 = 0, e1 = 0, lr0 = 0, lr1 = 0; float w0 = 0.f, w1 = 0.f; const bool act = (cx.tid < RB) && (row0 + cx.tid < M) && (cx.tid < 72);
    if (act) { const LAS float* l = lg + cx.tid * 36; float gl[4];
#pragma unroll
        for (int i = 0; i < 4; ++i) gl[i] = l[i] + p->b_rg[li * 4 + i];
        int gi = 0; float gm = gl[0];
#pragma unroll
        for (int i = 1; i < 4; ++i) if (gl[i] > gm) { gm = gl[i]; gi = i; }
        float gs = 0.f;
#pragma unroll
        for (int i = 0; i < 4; ++i) gs += __expf(gl[i] - gm);
        const float gw = 1.0f / gs;
        float ev[8];
#pragma unroll
        for (int i = 0; i < 8; ++i) ev[i] = l[4 + gi * 8 + i] + p->b_re[li * 32 + gi * 8 + i];
        int i0 = 0; float v0 = ev[0];
#pragma unroll
        for (int i = 1; i < 8; ++i) if (ev[i] > v0) { v0 = ev[i]; i0 = i; }
        int i1 = -1; float v1 = 0.f;
#pragma unroll
        for (int i = 0; i < 8; ++i) if (i != i0 && (i1 < 0 || ev[i] > v1)) { v1 = ev[i]; i1 = i; }
        const float ex = __expf(v1 - v0); w0 = gw / (1.f + ex); w1 = gw * ex / (1.f + ex);
        e0 = gi * 8 + i0; e1 = gi * 8 + i1;
        lr0 = __hip_atomic_fetch_add(&lcnt[e0], 1, __ATOMIC_RELAXED, __HIP_MEMORY_SCOPE_WORKGROUP); lr1 = __hip_atomic_fetch_add(&lcnt[e1], 1, __ATOMIC_RELAXED, __HIP_MEMORY_SCOPE_WORKGROUP); }
    __syncthreads();
    if (cx.tid < 32) { const int n = lcnt[cx.tid]; int base = 0; if (n > 0) base = (int)xb_add((unsigned*)(ws + WS_CTL) + CW_CNT + li * 2048 + cx.tid * 64 + dummy * 4096, (unsigned)n); lbase[cx.tid] = base; }
    __syncthreads();
    if (act) { const int tok = row0 + cx.tid; int* RL = (int*)(ws + (dummy ? WS_END : WS_ROWLIST)); float* TW = (float*)(ws + (dummy ? WS_END + 3 * MiB : WS_ROUTE));
        RL[(size_t)e0 * MT + lbase[e0] + lr0] = tok * 2; RL[(size_t)e1 * MT + lbase[e1] + lr1] = tok * 2 + 1;
        TW[tok * 2] = w0; TW[tok * 2 + 1] = w1; }
}
__device__ __forceinline__ void moe_tables(CP* p, const Ctx& cx, int li, int& ntiles) {
    LAS int* tcnt = (LAS int*)(cx.lds + MISC_OFF + MO_TCNT); LAS int* tbase = (LAS int*)(cx.lds + MISC_OFF + MO_TBASE);
    __syncthreads();
    if (cx.tid < 32) tcnt[cx.tid] = (int)__hip_atomic_load((unsigned*)(p->ws + WS_CTL) + CW_CNT + li * 2048 + cx.tid * 64, __ATOMIC_RELAXED, __HIP_MEMORY_SCOPE_AGENT);
    __syncthreads();
    if (cx.tid == 0) { int a = 0; for (int e = 0; e < 32; ++e) { tbase[e] = a; a += (tcnt[e] + 255) >> 8; } tbase[32] = a; }
    __syncthreads();
    ntiles = __builtin_amdgcn_readfirstlane(tbase[32]);
}
__device__ __forceinline__ void phase_moe_up(CP* p0, const Ctx& cx0, int li) {
    const Ctx cx = reopaque(cx0); CP* p = opaque_args(p0);
    unsigned char* ws = p->ws; int ntiles; moe_tables(p, cx, li, ntiles);
    LAS int* tcnt = (LAS int*)(cx.lds + MISC_OFF + MO_TCNT); LAS int* tbase = (LAS int*)(cx.lds + MISC_OFF + MO_TBASE); LAS int* idx = (LAS int*)(cx.lds + MISC_OFF + MO_IDX);
    const int* RL = (const int*)(ws + WS_ROWLIST);
    for (int i = 0; i < 3; ++i) { const int L = i * cx.G + cx.vcu, T = L >> 2;
        if (T < ntiles && cx.tid < 256) { int e = 0; for (int j = 1; j < 32; ++j) e += (tbase[j] <= T) ? 1 : 0;
            const int j = (T - tbase[e]) * 256 + cx.tid; const int ts = RL[(size_t)e * MT + (j < tcnt[e] ? j : 0)]; idx[i * 256 + cx.tid] = ts >> 1; } }
    __syncthreads();
    pg8::SchedMoe S; S.tbase = tbase; S.idx = idx; S.A = (const char*)(ws + WS_H1); S.B = (const char*)(ws + WS_WGU) + (size_t)li * 32 * 1024 * 1024 * 2;
    S.tA = 0; S.eB = (size_t)1024 * 1024 * 2; S.tB = (size_t)256 * 1024 * 2; S.G = cx.G; S.c = cx.vcu; S.ntiles = ntiles; S.gather = true;
    pg8::EpiUp E{(bf16_t*)(ws + WS_H)};
    pg8::gemm_phase<pg8::EpiUp, pg8::SchedMoe, true, true, D>(cx.lds, S, E);
}
__device__ __forceinline__ void phase_moe_down(CP* p0, const Ctx& cx0, int li) {
    const Ctx cx = reopaque(cx0); CP* p = opaque_args(p0);
    unsigned char* ws = p->ws; int ntiles; moe_tables(p, cx, li, ntiles);
    LAS int* tcnt = (LAS int*)(cx.lds + MISC_OFF + MO_TCNT); LAS int* tbase = (LAS int*)(cx.lds + MISC_OFF + MO_TBASE); LAS int* idx = (LAS int*)(cx.lds + MISC_OFF + MO_IDX);
    pg8::SchedMoe S; S.tbase = tbase; S.idx = idx; S.A = (const char*)(ws + WS_H); S.B = (const char*)(ws + WS_WD) + (size_t)li * 32 * 1024 * 512 * 2;
    S.tA = (size_t)256 * 512 * 2; S.eB = (size_t)1024 * 512 * 2; S.tB = (size_t)256 * 512 * 2; S.G = cx.G; S.c = cx.vcu; S.ntiles = ntiles; S.gather = false;
    pg8::EpiDown E{(bf16_t*)(ws + WS_Y2), (const int*)(ws + WS_ROWLIST), (const float*)(ws + WS_ROUTE), tcnt, tbase};
    pg8::gemm_phase<pg8::EpiDown, pg8::SchedMoe, false, true, DE>(cx.lds, S, E);
}
__device__ __forceinline__ void phase_final(CP* p0, const Ctx& cx0) {
    const Ctx cx = reopaque(cx0); CP* p = opaque_args(p0);
    unsigned char* ws = p->ws; const float* X1 = (const float*)(ws + WS_X1); const bf16_t* Y2 = (const bf16_t*)(ws + WS_Y2);
    for (int m = cx.gw; m < NX; m += cx.ngw) { const float* xr = X1 + (size_t)m * D; const bf16_t* ya = Y2 + (size_t)m * 2 * D; f32x4 v[4]; float ss = 0.f;
        const float* g2 = (const float*)(ws + WS_MOD) + (size_t)(9 + (m >> 11)) * 6144 + 5 * D;
#pragma unroll
        for (int j = 0; j < 4; ++j) { v[j] = *(const f32x4*)(xr + 256 * j + 4 * cx.lane); const f32x4 gg = *(const f32x4*)(g2 + 256 * j + 4 * cx.lane);
            const u32x2 a = *(const u32x2*)(ya + 256 * j + 4 * cx.lane), b = *(const u32x2*)(ya + D + 256 * j + 4 * cx.lane);
            v[j][0] += gg[0] * (bflo(a.x) + bflo(b.x)); v[j][1] += gg[1] * (bfhi(a.x) + bfhi(b.x)); v[j][2] += gg[2] * (bflo(a.y) + bflo(b.y)); v[j][3] += gg[3] * (bfhi(a.y) + bfhi(b.y));
            ss += v[j][0] * v[j][0] + v[j][1] * v[j][1] + v[j][2] * v[j][2] + v[j][3] * v[j][3]; }
        const float r = 1.0f / sqrtf(wave_sum(ss) * (1.0f / D) + 1e-6f);
#pragma unroll
        for (int j = 0; j < 4; ++j) { const int k = 256 * j + 4 * cx.lane; const f32x4 g = *(const f32x4*)(p->norm_final + k); *(f32x4*)(p->out + (size_t)m * D + k) = v[j] * r * g; } }
}

constexpr int N_PHASES = 17;
__global__ void __launch_bounds__(512, 2) mk_fwd(Params p_unused) {
    CP* p = (CP*)__builtin_amdgcn_kernarg_segment_ptr(); (void)p_unused;
    extern __shared__ __attribute__((aligned(16))) unsigned char lds_raw[];
    Ctx cx; cx.lds = (LAS unsigned char*)lds_raw; cx.tid = threadIdx.x; cx.lane = cx.tid & 63; cx.wave = __builtin_amdgcn_readfirstlane(cx.tid >> 6);
    cx.G = gridDim.x; { const int bx = blockIdx.x; cx.vcu = (cx.G % 8 == 0) ? (bx % 8) * (cx.G / 8) + bx / 8 : bx; }
    cx.gw = cx.vcu * 8 + cx.wave; cx.ngw = cx.G * 8;
    volatile LAS unsigned* misc = (volatile LAS unsigned*)(cx.lds + LDS_BYTES - 16);
    if (cx.tid < 4) misc[cx.tid] = 0u;
    __syncthreads();
#if MK_SPLIT
#define GRID_BAR() do { } while (0)
#else
    XcdBarrier bar = xcd_barrier_post((unsigned*)(p->ws + WS_CTL) + CW_BAR, misc);
#define GRID_BAR() xcd_barrier(bar)
#endif
    const int lo = p->ph_lo, hi = p->ph_hi, rep0 = p->rep0;
#define IN(k) (lo <= (k) && (k) < hi)
#define EN(j) (!((MK_SKIP >> (j)) & 1))
#define SEAM(k) do { if (IN(k) && IN((k) + 1)) GRID_BAR(); } while (0)
#define NREP(k) (((MK_REP >> (k)) & 1) ? 3 : 1)
#define RUN(kind, ph, cond, call) do { if (EN(kind) && IN(ph)) { const int nr_ = (cond) ? NREP(kind) : 1; for (int rep = nr_ - 1 + rep0; rep >= rep0; --rep) { call; if (rep > rep0) GRID_BAR(); } } } while (0)
    RUN(0, 0, true, phase_p0a(p, cx));
    SEAM(0);
    RUN(1, 1, true, phase_p0b(p, cx));
    SEAM(1);
    for (int li = 0; li < 2; ++li) { const int pb = 2 + 7 * li;
        RUN(2, pb + 0, li == 0, phase_norm1(p, cx, li));
        SEAM(pb + 0);
        RUN(3, pb + 1, true, phase_inproj(p, cx, li));
        SEAM(pb + 1);
        RUN(4, pb + 2, true, phase_mix(p, cx, li, rep));
        SEAM(pb + 2);
        RUN(5, pb + 3, li == 0, phase_outproj(p, cx, li));
        SEAM(pb + 3);
        RUN(6, pb + 4, true, phase_router(p, cx, li, rep));
        SEAM(pb + 4);
        RUN(7, pb + 5, true, phase_moe_up(p, cx, li));
        SEAM(pb + 5);
        RUN(8, pb + 6, true, phase_moe_down(p, cx, li));
        SEAM(pb + 6);
    }
    RUN(9, 16, true, phase_final(p, cx));
}

extern "C" void kernel_launch(void* const* d_in, const int* in_sizes, int n_in, void* d_out, int out_size, void* d_ws, size_t ws_size, hipStream_t stream) {
    static int grid = 0;
    if (grid == 0) {
        if (n_in != 21 || out_size != NX * D || ws_size < WS_END) { fprintf(stderr, "kernel_launch: unexpected shapes (n_in %d, out %d, ws %zu)\n", n_in, out_size, ws_size); grid = -1; return; }
        int dev = 0, cus = 0;
        if (hipGetDevice(&dev) != hipSuccess || hipDeviceGetAttribute(&cus, hipDeviceAttributeMultiprocessorCount, dev) != hipSuccess) { grid = -1; return; }
        if (hipFuncSetAttribute((const void*)mk_fwd, hipFuncAttributeMaxDynamicSharedMemorySize, LDS_BYTES) != hipSuccess) { fprintf(stderr, "kernel_launch: hipFuncSetAttribute failed\n"); grid = -1; return; }
        (void)hipGetLastError();
        grid = cus;
        if (grid != 256) fprintf(stderr, "kernel_launch: %d CUs (built for 256)\n", grid);
    }
    if (grid < 0) return;
    (void)in_sizes;
    (void)hipMemsetAsync((char*)d_ws + WS_CTL, 0, CTL_ZERO_BYTES, stream);
    Params a{};
    a.x = (const float*)d_in[0]; a.c = (const float*)d_in[1]; a.ctx = (const float*)d_in[2]; a.c_ctx = (const float*)d_in[3]; a.w_ada = (const float*)d_in[4]; a.b_ada = (const float*)d_in[5];
    a.norm1 = (const float*)d_in[6]; a.norm2 = (const float*)d_in[7]; a.w_in = (const float*)d_in[8]; a.w_fourier = (const float*)d_in[9]; a.w_conv = (const float*)d_in[10]; a.rpb = (const float*)d_in[11];
    a.w_out = (const float*)d_in[12]; a.w_rg = (const float*)d_in[13]; a.b_rg = (const float*)d_in[14]; a.w_re = (const float*)d_in[15]; a.b_re = (const float*)d_in[16];
    a.w_gate = (const float*)d_in[17]; a.w_up = (const float*)d_in[18]; a.w_down = (const float*)d_in[19]; a.norm_final = (const float*)d_in[20];
    a.out = (float*)d_out; a.ws = (unsigned char*)d_ws;
#if MK_SPLIT
    for (int ph = 0; ph < N_PHASES; ++ph) { a.ph_lo = ph; a.ph_hi = ph + 1;
        if (ph == MK_XTRA) for (int r = 2; r >= 1; --r) { a.rep0 = r; hipLaunchKernelGGL(mk_fwd, dim3(grid), dim3(512), LDS_BYTES, stream, a); }
        a.rep0 = 0; hipLaunchKernelGGL(mk_fwd, dim3(grid), dim3(512), LDS_BYTES, stream, a); }
#else
    a.ph_lo = 0; a.ph_hi = N_PHASES; hipLaunchKernelGGL(mk_fwd, dim3(grid), dim3(512), LDS_BYTES, stream, a);
#endif
}
```

```cpp
#include <hip/hip_runtime.h>
#include <cstdio>
#include <cstdint>

#ifndef MK_REP
#define MK_REP 0
#endif
#ifndef MK_MIXREP
#define MK_MIXREP 0
#endif
#ifndef MK_XTRA
#define MK_XTRA -1
#endif
#ifndef MK_SKIP
#define MK_SKIP 0
#endif
#ifndef MK_SUB
#define MK_SUB 0
#endif
#ifndef MK_SPLIT
#define MK_SPLIT 0
#endif

#define GAS __attribute__((address_space(1)))
#define LAS __attribute__((address_space(3)))
typedef unsigned short bf16_t;
typedef short bf16x8 __attribute__((ext_vector_type(8)));
typedef short bf16x4 __attribute__((ext_vector_type(4)));
typedef float f32x2 __attribute__((ext_vector_type(2)));
typedef float f32x4 __attribute__((ext_vector_type(4)));
typedef float f32x16 __attribute__((ext_vector_type(16)));
typedef unsigned u32x2 __attribute__((ext_vector_type(2)));
typedef unsigned u32x4 __attribute__((ext_vector_type(4)));
typedef __bf16 bf16x2_n __attribute__((ext_vector_type(2)));

constexpr int D = 1024, NB = 8, SEQ = 2048, LC = 256, NX = NB * SEQ, NC = NB * LC, MT = NX + NC;
constexpr int NU = 1792;
constexpr int KO = 1280;
constexpr int NE = 32, DE = 512, NHEAD = 8;
constexpr int MAXT = 176;
constexpr float QSCALE = 0.125f * 1.4426950408889634f;
constexpr float LOG2E = 1.4426950408889634f;

constexpr size_t MiB = 1u << 20;
constexpr size_t WS_CTL = 0, CTL_ZERO_BYTES = 1 * MiB;
constexpr size_t WS_MOD = 1 * MiB;
constexpr size_t WS_MODP = 2 * MiB;
constexpr size_t WS_MW = 16 * MiB;
constexpr size_t WS_WRT = 17 * MiB;
constexpr size_t WS_ROUTE = 18 * MiB;
constexpr size_t WS_ROWLIST = 19 * MiB;
constexpr size_t WS_ADFTC = 22 * MiB;
constexpr size_t WS_ADFTX = 23 * MiB;
constexpr size_t WS_WIN = 39 * MiB;
constexpr size_t WS_WOUT = 49 * MiB;
constexpr size_t WS_WGU = 54 * MiB;
constexpr size_t WS_WD = 182 * MiB;
constexpr size_t WS_H1 = 246 * MiB;
constexpr size_t WS_U = 282 * MiB;
constexpr size_t WS_Y2 = WS_U;
constexpr size_t WS_VTX = 354 * MiB;
constexpr size_t WS_VTC = 370 * MiB;
constexpr size_t WS_FTX = 372 * MiB;
constexpr size_t WS_FTC = 380 * MiB;
constexpr size_t WS_CONC = 381 * MiB;
constexpr size_t WS_H = WS_FTX;
constexpr size_t WS_X1 = 426 * MiB;
constexpr size_t WS_END = 498 * MiB;
static_assert(WS_H + (size_t)MAXT * 256 * 512 * 2 <= WS_X1, "H overlay");
static_assert(WS_Y2 + (size_t)MT * 2 * 1024 * 2 <= WS_VTX, "y2 overlay");

constexpr int CW_BAR = 4096;
constexpr int CW_ATTQ = 8192;
constexpr int CW_BGQ = 12288, CW_DONE = 12352;
constexpr int CW_CNT = 16384;

constexpr int RING_BYTES = 131072, MISC_OFF = RING_BYTES, LDS_BYTES = 163840;
constexpr int MO_TCNT = 64, MO_TBASE = 192, MO_LCNT = 384, MO_LBASE = 512, MO_IDX = 1024, MO_RROW = 4096;

__device__ __forceinline__ unsigned cvtpk(float lo, float hi) { f32x2 v = {lo, hi}; bf16x2_n b = __builtin_convertvector(v, bf16x2_n); return __builtin_bit_cast(unsigned, b); }
__device__ __forceinline__ float bf2f(unsigned short b) { return __uint_as_float(((unsigned)b) << 16); }
__device__ __forceinline__ float bflo(unsigned w) { return __uint_as_float(w << 16); }
__device__ __forceinline__ float bfhi(unsigned w) { return __uint_as_float(w & 0xffff0000u); }
__device__ __forceinline__ float wave_sum(float v) {
#pragma unroll
    for (int o = 1; o < 64; o <<= 1) v += __shfl_xor(v, o);
    return v;
}
#define LDS_WAIT() asm volatile("s_waitcnt lgkmcnt(0)" ::: "memory")
#define VM_WAIT() asm volatile("s_waitcnt vmcnt(0)" ::: "memory")

#define XB_TMO      128
#define XB_XCNT(j)  (256  + 64 * (j))
#define XB_XSUB(j)  (1280 + 64 * (j))
#define XB_XGEN(j)  (2304 + 64 * (j))
#define XB_TOP      3328
#define XB_TOPGEN   3392
#define XCD_BAR_WORDS 3456
#define XB_SPIN_CAP (1u << 18)
__device__ __forceinline__ unsigned xb_ld(unsigned* p)              { return __hip_atomic_load(p, __ATOMIC_RELAXED, __HIP_MEMORY_SCOPE_AGENT); }
__device__ __forceinline__ unsigned xb_add(unsigned* p, unsigned v) { return __hip_atomic_fetch_add(p, v, __ATOMIC_RELAXED, __HIP_MEMORY_SCOPE_AGENT); }
__device__ __forceinline__ unsigned xb_xcc_id() { return (unsigned)__builtin_amdgcn_s_getreg((3 << 11) | 20) & 0xFu; }
#define XB_SPIN(cond, bar) do { unsigned _sp = 0; while (cond) { __builtin_amdgcn_s_sleep(1); \
    if ((++_sp & 255u) == 0u) { if (xb_ld(&(bar)[XB_TMO])) break; if (_sp > XB_SPIN_CAP) { atomicAdd(&(bar)[XB_TMO], 1u); break; } } } } while (0)
struct XcdBarrier { unsigned* bar; unsigned x; volatile LAS unsigned* st; };
__device__ __forceinline__ XcdBarrier xcd_barrier_post(unsigned* bar, volatile LAS unsigned* st) {
    XcdBarrier b; b.bar = bar; b.x = xb_xcc_id(); b.st = st;
    if (threadIdx.x == 0) (void)xb_add(&bar[XB_XCNT(b.x)], 1u);
    return b;
}
__device__ __forceinline__ void xcd_barrier_complete(unsigned* bar, unsigned x, unsigned& nloc, unsigned& nx) {
    const unsigned G = gridDim.x * gridDim.y * gridDim.z;
    unsigned sum, cnt, mine, sp = 0u;
    for (;;) {
        sum = 0u; cnt = 0u; mine = 0u;
#pragma unroll
        for (unsigned j = 0; j < 16; ++j) { const unsigned c = xb_ld(&bar[XB_XCNT(j)]); sum += c; cnt += (c > 0u) ? 1u : 0u; mine = (j == x) ? c : mine; }
        if (sum == G) break;
        __builtin_amdgcn_s_sleep(1);
        if ((++sp & 255u) == 0u) { if (xb_ld(&bar[XB_TMO])) break; if (sp > XB_SPIN_CAP) { atomicAdd(&bar[XB_TMO], 1u); break; } }
    }
    nloc = mine > 0u ? mine : 1u; nx = cnt > 0u ? cnt : 1u;
}
__device__ __forceinline__ void xcd_barrier(const XcdBarrier& b) {
    asm volatile("s_waitcnt vmcnt(0)" ::: "memory");
    __syncthreads();
    if (threadIdx.x == 0) {
        unsigned* bar = b.bar;
        __builtin_amdgcn_s_waitcnt(0);
        unsigned nloc = b.st[0], nx = b.st[1];
        if (nloc == 0u) { xcd_barrier_complete(bar, b.x, nloc, nx); b.st[0] = nloc; b.st[1] = nx; }
        const unsigned old = xb_add(&bar[XB_XSUB(b.x)], 1u);
        const unsigned gen = old / nloc;
        if (old + 1u == (gen + 1u) * nloc) {
            __builtin_amdgcn_fence(__ATOMIC_RELEASE, "agent");
            asm volatile("s_waitcnt vmcnt(0)" ::: "memory");
            const unsigned og = xb_add(&bar[XB_TOP], 1u);
            const unsigned tg = og / nx;
            if (og + 1u == (tg + 1u) * nx) xb_add(&bar[XB_TOPGEN], 1u);
            else XB_SPIN(xb_ld(&bar[XB_TOPGEN]) == tg, bar);
            __builtin_amdgcn_fence(__ATOMIC_ACQUIRE, "agent");
            xb_add(&bar[XB_XGEN(b.x)], 1u);
            asm volatile("s_waitcnt vmcnt(0)" ::: "memory");
        } else {
            XB_SPIN(xb_ld(&bar[XB_XGEN(b.x)]) == gen, bar);
            __builtin_amdgcn_fence(__ATOMIC_ACQUIRE, "agent");
            asm volatile("s_waitcnt vmcnt(0)" ::: "memory");
        }
    }
    __syncthreads();
}

namespace pg8 {
constexpr int BM = 256, BK = 64, HALF = 128, HTB = HALF * BK * 2, STAGE_BYTES = 8 * HTB, NXCD = 8, WGM = 8;
__host__ __device__ __forceinline__ int lds_byte(int r, int c) { const int st = (r >> 4) * 2 + (c >> 5), rr = r & 15, cc = c & 31, ob = rr * 64 + cc * 2; return st * 1024 + (ob ^ (((ob >> 9) & 1) << 5)); }
__host__ __device__ __forceinline__ void stage_rc(int b, int& R, int& C) { const int st = b / 1024, sb = b % 1024, swz = sb ^ (((sb >> 9) & 1) << 5); R = (st >> 1) * 16 + swz / 64; C = (st & 1) * 32 + (swz % 64) / 2; }
__host__ __device__ __forceinline__ int perm32(int rho) { const int n = rho >> 4, i = rho & 15; return 8 * (i >> 2) + 4 * n + (i & 3); }

struct Unit { int pm, pn, aux; const char* A; const char* B; };

template <class Epi, class Sched, bool GATHER, bool ALIGN_EPI, int KT>
__device__ __forceinline__ void gemm_phase(LAS unsigned char* lds, const Sched& S, const Epi& E, const int Krt = 0) {
    const int K = KT ? KT : Krt;
    int tid_ = threadIdx.x; asm volatile("" : "+v"(tid_));
    const int tid = tid_, wid = __builtin_amdgcn_readfirstlane(tid >> 6), lane = tid & 63, wr = wid >> 2, wc = wid & 3, fr = lane & 15, fq = lane >> 4;
    const int nt = K / BK;
    int R0, C0; stage_rc(tid * 16, R0, C0);
    unsigned voffA[2], voffB[2];
#pragma unroll
    for (int i = 0; i < 2; ++i) { const int R = R0 + 64 * i; const int Rb = Epi::PERM ? ((R & ~31) + perm32(R & 31)) : R;
        voffA[i] = (unsigned)(R * K + C0) * 2u; voffB[i] = (unsigned)(Rb * K + C0) * 2u; }
    unsigned cvA0[2] = {0u, 0u}, cvA1[2] = {0u, 0u}, nvA0[2] = {0u, 0u}, nvA1[2] = {0u, 0u};
    const size_t kstep = (size_t)(BK * 2);
    const size_t hstep = (size_t)HALF * K * 2;
    const unsigned ldsw = (unsigned)wid * 1024u;
    const int aoff = lds_byte(wr * 64 + fr, fq * 8), boff = lds_byte(wc * 32 + fr, fq * 8);
#define PG8_SA(b, h) (((b) * 2 + (h)) * HTB)
#define PG8_SB(b, h) ((4 + (b) * 2 + (h)) * HTB)
#define PG8_STAGE(bufoff, gbase, voff) do { _Pragma("unroll") for (int _i = 0; _i < 2; ++_i) \
        __builtin_amdgcn_global_load_lds((const unsigned*)((const char*)(gbase) + (voff)[_i]), (LAS unsigned*)(lds + (bufoff) + ldsw + _i * 8192), 16, 0, 0); } while (0)
#define PG8_STAGE_A(b, h, gbase, g0, g1) do { if constexpr (GATHER) { if ((h) == 0) PG8_STAGE(PG8_SA(b, 0), gbase, g0); else PG8_STAGE(PG8_SA(b, 1), gbase, g1); } \
        else { PG8_STAGE(PG8_SA(b, h), (gbase) + ((h) ? hstep : 0), voffA); } } while (0)
#define PG8_ROWS(u, v0, v1) do { _Pragma("unroll") for (int _i = 0; _i < 2; ++_i) { v0[_i] = (unsigned)(S.arow(u, R0 + 64 * _i) * K + C0) * 2u; v1[_i] = (unsigned)(S.arow(u, 128 + R0 + 64 * _i) * K + C0) * 2u; } } while (0)
#define PG8_LDA(dst, b, h) do { _Pragma("unroll") for (int m = 0; m < 4; ++m) _Pragma("unroll") for (int k = 0; k < 2; ++k) dst[m][k] = *(const LAS bf16x8*)(lds + PG8_SA(b, h) + aoff + m * 2048 + k * 1024); } while (0)
#define PG8_LDB(dst, b, h) do { _Pragma("unroll") for (int n = 0; n < 2; ++n) _Pragma("unroll") for (int k = 0; k < 2; ++k) dst[n][k] = *(const LAS bf16x8*)(lds + PG8_SB(b, h) + boff + n * 2048 + k * 1024); } while (0)
#define PG8_MMA(ai, bj, At, Bt) do { __builtin_amdgcn_s_setprio(1); _Pragma("unroll") for (int m = 0; m < 4; ++m) _Pragma("unroll") for (int n = 0; n < 2; ++n) _Pragma("unroll") for (int k = 0; k < 2; ++k) \
        acc[ai][bj][m][n] = __builtin_amdgcn_mfma_f32_16x16x32_bf16(Bt[n][k], At[m][k], acc[ai][bj][m][n], 0, 0, 0); __builtin_amdgcn_s_setprio(0); } while (0)
#define PG8_WAIT_V(n) asm volatile("s_waitcnt vmcnt(" #n ")" ::: "memory")
#define PG8_WAIT_L(n) asm volatile("s_waitcnt lgkmcnt(" #n ")" ::: "memory")
#define PG8_BAR __builtin_amdgcn_s_barrier()
#define PG8_SCHED __builtin_amdgcn_sched_barrier(0)
    Unit cur, nxt; int ui = 0;
    if (!S.next(0, cur)) return;
    f32x4 acc[2][2][4][2];
#pragma unroll
    for (int a = 0; a < 2; ++a)
#pragma unroll
        for (int b = 0; b < 2; ++b)
#pragma unroll
            for (int m = 0; m < 4; ++m)
#pragma unroll
                for (int n = 0; n < 2; ++n) acc[a][b][m][n] = (f32x4){0.f, 0.f, 0.f, 0.f};
    bf16x8 At[4][2], B0[2][2], B1[2][2];
    const char* cA = cur.A; const char* cB = cur.B;
    if constexpr (GATHER) { PG8_ROWS(cur, cvA0, cvA1); }
    PG8_STAGE(PG8_SB(0, 0), cB, voffB); PG8_STAGE(PG8_SB(0, 1), cB + hstep, voffB); PG8_STAGE_A(0, 0, cA, cvA0, cvA1); PG8_STAGE_A(0, 1, cA, cvA0, cvA1);
    if (wr == 1) PG8_BAR;
    PG8_WAIT_V(2); PG8_BAR;
    PG8_STAGE(PG8_SB(1, 0), cB + kstep, voffB); PG8_STAGE_A(1, 0, cA + kstep, cvA0, cvA1); PG8_STAGE(PG8_SB(1, 1), cB + hstep + kstep, voffB);
    PG8_WAIT_V(6); PG8_BAR;
    for (;;) {
        const bool has_next = S.next(ui + 1, nxt);
        const char* nA = has_next ? nxt.A : cA; const char* nB = has_next ? nxt.B : cB;
        if constexpr (GATHER) { if (has_next) { PG8_ROWS(nxt, nvA0, nvA1); } else {
#pragma unroll
            for (int i = 0; i < 2; ++i) { nvA0[i] = cvA0[i]; nvA1[i] = cvA1[i]; } } }
        for (int t = 0; t < nt; t += 2) {
            const bool last = (t == nt - 2);
            const char* a1 = cA + (size_t)(t + 1) * kstep;
            const char* a2 = last ? nA : cA + (size_t)(t + 2) * kstep; const char* b2 = last ? nB : cB + (size_t)(t + 2) * kstep;
            const char* a3 = a2 + kstep; const char* b3 = b2 + kstep;
            unsigned sA0[2], sA1[2];
#pragma unroll
            for (int i = 0; i < 2; ++i) { sA0[i] = last ? nvA0[i] : cvA0[i]; sA1[i] = last ? nvA1[i] : cvA1[i]; }
            PG8_LDB(B0, 0, 0); PG8_LDB(B1, 0, 1); PG8_SCHED; PG8_LDA(At, 0, 0); PG8_STAGE_A(1, 1, a1, cvA0, cvA1);
            PG8_WAIT_V(8); PG8_WAIT_L(0); PG8_BAR; PG8_MMA(0, 0, At, B0); PG8_MMA(0, 1, At, B1); PG8_BAR; PG8_SCHED;
            PG8_LDA(At, 0, 1); PG8_STAGE(PG8_SB(0, 0), b2, voffB); PG8_STAGE(PG8_SB(0, 1), b2 + hstep, voffB); PG8_STAGE_A(0, 0, a2, sA0, sA1);
            PG8_WAIT_V(8); PG8_WAIT_L(0); PG8_BAR; PG8_MMA(1, 0, At, B0); PG8_MMA(1, 1, At, B1); PG8_BAR; PG8_SCHED;
            PG8_LDB(B0, 1, 0); PG8_LDB(B1, 1, 1); PG8_SCHED; PG8_LDA(At, 1, 0); PG8_STAGE_A(0, 1, a2, sA0, sA1);
            PG8_WAIT_V(8); PG8_WAIT_L(0); PG8_BAR; PG8_MMA(0, 0, At, B0); PG8_MMA(0, 1, At, B1); PG8_BAR; PG8_SCHED;
            PG8_LDA(At, 1, 1); PG8_STAGE(PG8_SB(1, 0), b3, voffB); PG8_STAGE(PG8_SB(1, 1), b3 + hstep, voffB); PG8_STAGE_A(1, 0, a3, sA0, sA1);
            PG8_WAIT_V(8); PG8_WAIT_L(0); PG8_BAR; PG8_MMA(1, 0, At, B0); PG8_MMA(1, 1, At, B1); PG8_BAR; PG8_SCHED;
        }
        if constexpr (ALIGN_EPI) { if (wr == 0) PG8_BAR; }
        E(acc, cur, wr, wc, fr, fq);
        if (!has_next) break;
#pragma unroll
        for (int a = 0; a < 2; ++a)
#pragma unroll
            for (int b = 0; b < 2; ++b)
#pragma unroll
                for (int m = 0; m < 4; ++m)
#pragma unroll
                    for (int n = 0; n < 2; ++n) acc[a][b][m][n] = (f32x4){0.f, 0.f, 0.f, 0.f};
        cur = nxt; cA = nA; cB = nB; ++ui;
        if constexpr (GATHER) {
#pragma unroll
            for (int i = 0; i < 2; ++i) { cvA0[i] = nvA0[i]; cvA1[i] = nvA1[i]; } }
        if constexpr (ALIGN_EPI) { if (wr == 1) PG8_BAR; }
    }
    PG8_WAIT_V(0);
    if constexpr (!ALIGN_EPI) { if (wr == 0) PG8_BAR; }
    PG8_BAR;
#undef PG8_SA
#undef PG8_SB
#undef PG8_STAGE
#undef PG8_STAGE_A
#undef PG8_ROWS
#undef PG8_LDA
#undef PG8_LDB
#undef PG8_MMA
#undef PG8_WAIT_V
#undef PG8_WAIT_L
#undef PG8_BAR
#undef PG8_SCHED
}

struct SchedRect {
    const char* A; const char* B; size_t tA, tB; int nM, nN, nwg, G, c;
    __device__ __forceinline__ void init(const void* A_, const void* B_, int M, int N, int K, int G_, int c_) { A = (const char*)A_; B = (const char*)B_; tA = tB = (size_t)BM * K * 2; nM = M / BM; nN = N / BM; nwg = nM * nN; G = G_; c = c_; }
    __device__ __forceinline__ bool next(int i, Unit& u) const {
        const long L = (long)i * G + c; if (L >= nwg) return false;
        int wgid = (int)L; { const int q = nwg / NXCD, r = nwg % NXCD, xcd = wgid % NXCD, off = wgid / NXCD; wgid = (xcd < r ? xcd * (q + 1) : r * (q + 1) + (xcd - r) * q) + off; }
        const int nig = WGM * nN, gid = wgid / nig, fm = gid * WGM, gsz = (nM - fm) < WGM ? (nM - fm) : WGM;
        u.pm = fm + ((wgid % nig) % gsz); u.pn = (wgid % nig) / gsz; u.aux = 0; u.A = A + (size_t)u.pm * tA; u.B = B + (size_t)u.pn * tB; return true;
    }
    __device__ __forceinline__ int arow(const Unit&, int) const { return 0; }
};
struct SchedOne {
    bool has; Unit u0;
    __device__ __forceinline__ bool next(int i, Unit& u) const { if (i > 0 || !has) return false; u = u0; return true; }
    __device__ __forceinline__ int arow(const Unit&, int) const { return 0; }
};
struct SchedMoe {
    const LAS int* tbase; const LAS int* idx; const char* A; const char* B; size_t tA, eB, tB; int G, c, ntiles; bool gather;
    __device__ __forceinline__ bool next(int i, Unit& u) const {
        const int L = i * G + c, T = L >> 2; if (T >= ntiles) return false;
        int e = 0;
#pragma unroll 1
        for (int j = 1; j < 32; ++j) e += (tbase[j] <= T) ? 1 : 0;
        e = __builtin_amdgcn_readfirstlane(e);
        u.pm = T; u.pn = L & 3; u.aux = e | (i << 8); u.A = gather ? A : A + (size_t)T * tA; u.B = B + (size_t)e * eB + (size_t)(L & 3) * tB; return true;
    }
    __device__ __forceinline__ int arow(const Unit& u, int r) const { return idx[(u.aux >> 8) * 256 + r]; }
};

struct EpiBf16 {
    static constexpr bool PERM = true;
    bf16_t* O; int ldc;
    __device__ __forceinline__ void operator()(const f32x4 (&acc)[2][2][4][2], const Unit& u, int wr, int wc, int fr, int fq) const {
        const int row0 = u.pm * BM + wr * 64 + fr, col0 = u.pn * BM + wc * 32 + 8 * fq;
#pragma unroll
        for (int ai = 0; ai < 2; ++ai)
#pragma unroll
            for (int m = 0; m < 4; ++m) { bf16_t* rowp = O + (size_t)(row0 + ai * HALF + m * 16) * ldc + col0;
#pragma unroll
                for (int bj = 0; bj < 2; ++bj) { const f32x4 v0 = acc[ai][bj][m][0], v1 = acc[ai][bj][m][1];
                    u32x4 w; w.x = cvtpk(v0[0], v0[1]); w.y = cvtpk(v0[2], v0[3]); w.z = cvtpk(v1[0], v1[1]); w.w = cvtpk(v1[2], v1[3]);
                    *(u32x4*)(rowp + bj * HALF) = w; } }
    }
};
struct EpiT {
    static constexpr bool PERM = true;
    bf16_t *ftx, *ftc, *vtx, *vtc;
    __device__ __forceinline__ void operator()(const f32x4 (&acc)[2][2][4][2], const Unit& u, int wr, int wc, int fr, int fq) const {
        bf16_t* base; int pitch;
        const int b = (u.pn < 64) ? (u.pn >> 3) : (u.pn - 64);
        if (u.pm == 0) { if (u.pn < 64) { base = ftx + (size_t)b * 256 * 2048 + (u.pn & 7) * 256; pitch = 2048; } else { base = ftc + (size_t)b * 256 * 256; pitch = 256; } }
        else { const int v0 = (u.pm - 1) * 256; if (u.pn < 64) { base = vtx + ((size_t)b * 512 + v0) * 2048 + (u.pn & 7) * 256; pitch = 2048; } else { base = vtc + ((size_t)b * 512 + v0) * 256; pitch = 256; } }
        const int row0 = wr * 64 + fr, col0 = wc * 32 + 8 * fq;
#pragma unroll
        for (int ai = 0; ai < 2; ++ai)
#pragma unroll
            for (int m = 0; m < 4; ++m) { bf16_t* rowp = base + (size_t)(row0 + ai * HALF + m * 16) * pitch + col0;
#pragma unroll
                for (int bj = 0; bj < 2; ++bj) { const f32x4 v0 = acc[ai][bj][m][0], v1 = acc[ai][bj][m][1];
                    u32x4 w; w.x = cvtpk(v0[0], v0[1]); w.y = cvtpk(v0[2], v0[3]); w.z = cvtpk(v1[0], v1[1]); w.w = cvtpk(v1[2], v1[3]);
                    *(u32x4*)(rowp + bj * HALF) = w; } }
    }
};
struct EpiDft {
    static constexpr bool PERM = true;
    bf16_t* conc; int ktiles;
    __device__ __forceinline__ void operator()(const f32x4 (&acc)[2][2][4][2], const Unit& u, int wr, int wc, int fr, int fq) const {
        const int cs = u.pm / ktiles, kt = u.pm % ktiles;
        bf16_t* base = conc + ((size_t)u.pn * (ktiles * 256) + kt * 256) * KO + cs * 256;
        const int row0 = wr * 64 + fr, col0 = wc * 32 + 8 * fq;
#pragma unroll
        for (int ai = 0; ai < 2; ++ai)
#pragma unroll
            for (int m = 0; m < 4; ++m) { bf16_t* rowp = base + (size_t)(row0 + ai * HALF + m * 16) * KO + col0;
#pragma unroll
                for (int bj = 0; bj < 2; ++bj) { const f32x4 v0 = acc[ai][bj][m][0], v1 = acc[ai][bj][m][1];
                    u32x4 w; w.x = cvtpk(v0[0], v0[1]); w.y = cvtpk(v0[2], v0[3]); w.z = cvtpk(v1[0], v1[1]); w.w = cvtpk(v1[2], v1[3]);
                    *(u32x4*)(rowp + bj * HALF) = w; } }
    }
};
struct EpiOut {
    static constexpr bool PERM = false;
    float* x1; const float* xin; const float* cin; const float* mod;
    __device__ __forceinline__ void operator()(const f32x4 (&acc)[2][2][4][2], const Unit& u, int wr, int wc, int fr, int fq) const {
        const int rr = (u.pm < 64) ? (u.pm >> 3) : 8;
        const int row0 = u.pm * BM + wr * 64 + fr, col0 = u.pn * BM + wc * 32 + 4 * fq;
        const float* res = xin ? ((u.pm < 64) ? xin + (size_t)row0 * D : cin + (size_t)(row0 - NX) * D) : x1 + (size_t)row0 * D;
        const float* g1 = mod + rr * 6144 + 2 * D + col0;
        f32x4 gv[2][2];
#pragma unroll
        for (int bj = 0; bj < 2; ++bj)
#pragma unroll
            for (int n = 0; n < 2; ++n) gv[bj][n] = *(const f32x4*)(g1 + bj * HALF + n * 16);
#pragma unroll
        for (int ai = 0; ai < 2; ++ai)
#pragma unroll
            for (int m = 0; m < 4; ++m) { const size_t ro = (size_t)(ai * HALF + m * 16) * D + col0; float* op = x1 + (size_t)row0 * D + ro;
#pragma unroll
                for (int bj = 0; bj < 2; ++bj)
#pragma unroll
                    for (int n = 0; n < 2; ++n) { const f32x4 r = *(const f32x4*)(res + ro + bj * HALF + n * 16);
                        *(f32x4*)(op + bj * HALF + n * 16) = r + gv[bj][n] * acc[ai][bj][m][n]; } }
    }
};
struct EpiUp {
    static constexpr bool PERM = false;
    bf16_t* H;
    __device__ __forceinline__ void operator()(const f32x4 (&acc)[2][2][4][2], const Unit& u, int wr, int wc, int fr, int fq) const {
        const int row0 = u.pm * BM + wr * 64 + fr;
#pragma unroll
        for (int ai = 0; ai < 2; ++ai)
#pragma unroll
            for (int m = 0; m < 4; ++m) { bf16_t* rowp = H + (size_t)(row0 + ai * HALF + m * 16) * DE;
#pragma unroll
                for (int bj = 0; bj < 2; ++bj) { const int hid = 16 * (8 * u.pn + 4 * bj + wc) + 4 * fq;
                    const f32x4 g = acc[ai][bj][m][0], up = acc[ai][bj][m][1]; float h[4];
#pragma unroll
                    for (int j = 0; j < 4; ++j) h[j] = g[j] * __builtin_amdgcn_rcpf(1.f + __builtin_amdgcn_exp2f(-LOG2E * g[j])) * up[j];
                    u32x2 w; w.x = cvtpk(h[0], h[1]); w.y = cvtpk(h[2], h[3]);
                    *(u32x2*)(rowp + hid) = w; } }
    }
};
struct EpiDown {
    static constexpr bool PERM = true;
    bf16_t* y2; const int* rowlist; const float* tokw; const LAS int* tcnt; const LAS int* tbase;
    __device__ __forceinline__ void operator()(const f32x4 (&acc)[2][2][4][2], const Unit& u, int wr, int wc, int fr, int fq) const {
        const int e = u.aux & 255, cnt = tcnt[e], j0 = (u.pm - tbase[e]) * 256 + wr * 64 + fr;
        const int col0 = u.pn * BM + wc * 32 + 8 * fq;
        int ts[2][4]; float pw[2][4];
#pragma unroll
        for (int ai = 0; ai < 2; ++ai)
#pragma unroll
            for (int m = 0; m < 4; ++m) { const int j = j0 + ai * HALF + m * 16; ts[ai][m] = (j < cnt) ? rowlist[(size_t)e * MT + j] : -1; }
#pragma unroll
        for (int ai = 0; ai < 2; ++ai)
#pragma unroll
            for (int m = 0; m < 4; ++m) pw[ai][m] = (ts[ai][m] >= 0) ? tokw[ts[ai][m]] : 0.f;
#pragma unroll
        for (int ai = 0; ai < 2; ++ai)
#pragma unroll
            for (int m = 0; m < 4; ++m) {
                if (ts[ai][m] >= 0) { bf16_t* rowp = y2 + (size_t)ts[ai][m] * D + col0; const float w_ = pw[ai][m];
#pragma unroll
                    for (int bj = 0; bj < 2; ++bj) { const f32x4 v0 = acc[ai][bj][m][0] * w_, v1 = acc[ai][bj][m][1] * w_;
                        u32x4 w; w.x = cvtpk(v0[0], v0[1]); w.y = cvtpk(v0[2], v0[3]); w.z = cvtpk(v1[0], v1[1]); w.w = cvtpk(v1[2], v1[3]);
                        *(u32x4*)(rowp + bj * HALF) = w; } } }
    }
};
struct SchedInproj {
    SchedRect R; const char *A1, *B1; int G, c;
    __device__ __forceinline__ bool next(int i, Unit& u) const {
        const int L = i * G + c; if (L < R.nwg) return R.next(i, u);
        const int j = L - R.nwg; if (j >= 216) return false;
        u.pm = j % 3; u.pn = j / 3; u.aux = 1; u.A = A1 + (size_t)u.pm * ((size_t)BM * D * 2); u.B = B1 + (size_t)u.pn * ((size_t)BM * D * 2); return true;
    }
    __device__ __forceinline__ int arow(const Unit&, int) const { return 0; }
};
struct EpiInproj {
    static constexpr bool PERM = true;
    bf16_t *U, *ftx, *ftc, *vtx, *vtc;
    __device__ __forceinline__ void operator()(const f32x4 (&acc)[2][2][4][2], const Unit& u, int wr, int wc, int fr, int fq) const {
        bf16_t* base; size_t pitch;
        if (u.aux == 0) { base = U + (size_t)u.pm * BM * NU + (size_t)u.pn * BM; pitch = NU; }
        else { const int b = (u.pn < 64) ? (u.pn >> 3) : (u.pn - 64);
            if (u.pm == 0) { if (u.pn < 64) { base = ftx + (size_t)b * 256 * 2048 + (u.pn & 7) * 256; pitch = 2048; } else { base = ftc + (size_t)b * 256 * 256; pitch = 256; } }
            else { const int v0 = (u.pm - 1) * 256; if (u.pn < 64) { base = vtx + ((size_t)b * 512 + v0) * 2048 + (u.pn & 7) * 256; pitch = 2048; } else { base = vtc + ((size_t)b * 512 + v0) * 256; pitch = 256; } } }
        const int row0 = wr * 64 + fr, col0 = wc * 32 + 8 * fq;
#pragma unroll
        for (int ai = 0; ai < 2; ++ai)
#pragma unroll
            for (int m = 0; m < 4; ++m) { bf16_t* rowp = base + (size_t)(row0 + ai * HALF + m * 16) * pitch + col0;
#pragma unroll
                for (int bj = 0; bj < 2; ++bj) { const f32x4 v0 = acc[ai][bj][m][0], v1 = acc[ai][bj][m][1];
                    u32x4 w; w.x = cvtpk(v0[0], v0[1]); w.y = cvtpk(v0[2], v0[3]); w.z = cvtpk(v1[0], v1[1]); w.w = cvtpk(v1[2], v1[3]);
                    *(u32x4*)(rowp + bj * HALF) = w; } }
    }
};
}

struct Params {
    const float *x, *c, *ctx, *c_ctx, *w_ada, *b_ada, *norm1, *norm2, *w_in, *w_fourier, *w_conv, *rpb, *w_out, *w_rg, *b_rg, *w_re, *b_re, *w_gate, *w_up, *w_down, *norm_final;
    float* out; unsigned char* ws; int ph_lo, ph_hi, rep0, pad;
};
typedef const __attribute__((address_space(4))) Params CP;
__device__ __forceinline__ CP* opaque_args(CP* p) { asm volatile("" : "+s"(p)); return p; }
struct Ctx { LAS unsigned char* lds; int tid, lane, wave, G, vcu, gw, ngw; };
__device__ __forceinline__ Ctx reopaque(const Ctx& c) { Ctx r = c; int t = threadIdx.x; asm volatile("" : "+v"(t)); r.tid = t; r.lane = t & 63; return r; }

__device__ __forceinline__ void tr_item(const float* src, int ldn, int k0, int n0, bf16_t* dst, int ldk, int kd0, int rtype, LAS float* scr, int lane) {
    float tv[32];
#pragma unroll
    for (int i = 0; i < 32; ++i) tv[i] = src[(size_t)(k0 + 2 * i + (lane >> 5)) * ldn + n0 + (lane & 31)];
#pragma unroll
    for (int i = 0; i < 32; ++i) scr[(2 * i + (lane >> 5)) * 33 + (lane & 31)] = tv[i];
    LDS_WAIT(); asm volatile("" ::: "memory");
    const int c = lane & 7;
#pragma unroll
    for (int j = 0; j < 4; ++j) { const int n = (lane >> 3) + 8 * j; const LAS float* s = scr + (8 * c) * 33 + n;
        const int sn = n0 + n; int dr; float sc = 1.f;
        if (rtype == 0) { dr = (sn < 256) ? sn : (sn < 1280 ? sn + 512 : (sn < 1792 ? sn - 1024 : sn)); if (sn >= 256 && sn < 768) sc = QSCALE; }
        else if (rtype == 2) dr = 32 * (sn >> 4) + (sn & 15);
        else if (rtype == 3) dr = 32 * (sn >> 4) + 16 + (sn & 15);
        else dr = sn;
        u32x4 o; o.x = cvtpk(s[0 * 33] * sc, s[1 * 33] * sc); o.y = cvtpk(s[2 * 33] * sc, s[3 * 33] * sc); o.z = cvtpk(s[4 * 33] * sc, s[5 * 33] * sc); o.w = cvtpk(s[6 * 33] * sc, s[7 * 33] * sc);
        *(u32x4*)(dst + (size_t)dr * ldk + kd0 + 8 * c) = o; }
    LDS_WAIT(); asm volatile("" ::: "memory");
}
__device__ __forceinline__ void phase_p0a(CP* p0, const Ctx& cx0) {
    const Ctx cx = reopaque(cx0); CP* p = opaque_args(p0);
    LAS float* T = (LAS float*)(cx.lds + 147456);
    LAS float* scr = (LAS float*)(cx.lds + cx.wave * 8448);
    unsigned char* ws = p->ws;
    for (int j = cx.tid; j < 2048; j += 512) T[j] = cospif((float)j * (1.0f / 1024.0f));
    __syncthreads();
    const int gt = cx.vcu * 512 + cx.tid, ngt = cx.G * 512;
    { bf16_t* AX = (bf16_t*)(ws + WS_ADFTX); const float SX = 0.0027621358640099513f;
      for (int it = gt; it < 4096 * 256; it += ngt) { const int R = it >> 8, n0 = (it & 255) * 8, cs = R >> 11, k = R & 2047; float v[8];
#pragma unroll
          for (int j = 0; j < 8; ++j) { const int idx = (k * (n0 + j)) & 2047; v[j] = T[cs ? ((idx - 512) & 2047) : idx] * SX; }
          u32x4 o; o.x = cvtpk(v[0], v[1]); o.y = cvtpk(v[2], v[3]); o.z = cvtpk(v[4], v[5]); o.w = cvtpk(v[6], v[7]);
          *(u32x4*)(AX + (size_t)R * 2048 + n0) = o; }
      bf16_t* AC = (bf16_t*)(ws + WS_ADFTC); const float SC = 1.0f / 128.0f;
      for (int it = gt; it < 512 * 32; it += ngt) { const int R = it >> 5, n0 = (it & 31) * 8, cs = R >> 8, k = R & 255; float v[8];
#pragma unroll
          for (int j = 0; j < 8; ++j) { const int idx = (8 * k * (n0 + j)) & 2047; v[j] = T[cs ? ((idx - 512) & 2047) : idx] * SC; }
          u32x4 o; o.x = cvtpk(v[0], v[1]); o.y = cvtpk(v[2], v[3]); o.z = cvtpk(v[4], v[5]); o.w = cvtpk(v[6], v[7]);
          *(u32x4*)(AC + (size_t)R * 256 + n0) = o; } }
    { bf16_t* WH = (bf16_t*)(ws + WS_WRT); bf16_t* WL = WH + 2 * 48 * 1024;
      for (int it = gt; it < 2 * 48 * 1024; it += ngt) { const int k = it & 1023, c = (it >> 10) % 48, li = it / 49152;
          const float w = (c < 4) ? p->w_rg[(size_t)li * 4096 + k * 4 + c] : ((c < 36) ? p->w_re[(size_t)li * 32768 + k * 32 + (c - 4)] : 0.f);
          const unsigned hb = cvtpk(w, 0.f) & 0xffffu; const float lo = w - bf2f((unsigned short)hb);
          WH[it] = (bf16_t)hb; WL[it] = (bf16_t)(cvtpk(lo, 0.f) & 0xffffu); } }
    for (int task = cx.vcu; task < 256; task += cx.G) { const int li = task >> 7, g = (task >> 5) & 3, n0 = (task & 31) * 32;
        LAS float* Wf = (LAS float*)cx.lds; LAS float* Wo = (LAS float*)(cx.lds + 65536); LAS float* Gs = (LAS float*)(cx.lds + 98304);
        __syncthreads();
        { const float* wf = p->w_fourier + (size_t)li * 65536 + (size_t)(64 * g) * 256; const float* wo = p->w_out + (size_t)li * 1024 * 1024 + n0;
#pragma unroll
          for (int r = 0; r < 8; ++r) { const int pc = cx.tid + 512 * r; *(LAS f32x4*)(Wf + pc * 4) = *(const f32x4*)(wf + pc * 4); }
#pragma unroll
          for (int r = 0; r < 4; ++r) { const int pc = cx.tid + 512 * r, j = pc >> 3, q = pc & 7; *(LAS f32x4*)(Wo + j * 32 + q * 4) = *(const f32x4*)(wo + (size_t)j * 1024 + q * 4); } }
        __syncthreads();
        { const int l = cx.tid >> 3, n4 = (cx.tid & 7) * 4; f32x4 a4 = (f32x4){0.f, 0.f, 0.f, 0.f};
#pragma unroll 8
          for (int j = 0; j < 256; ++j) a4 += *(const LAS f32x4*)(Wo + j * 32 + n4) * Wf[l * 256 + j];
          *(LAS f32x4*)(Gs + l * 32 + n4) = a4; }
        __syncthreads();
        { bf16_t* WOUT = (bf16_t*)(ws + WS_WOUT) + (size_t)li * 1024 * 1280; const int n = cx.tid & 31, combo = cx.tid >> 5, cs = combo >> 3, c8 = combo & 7; float a8[8];
#pragma unroll
          for (int i = 0; i < 8; ++i) a8[i] = 0.f;
          for (int l = 0; l < 64; ++l) { const float gv = Gs[l * 32 + n];
#pragma unroll
              for (int i = 0; i < 8; ++i) { const int idx = (32 * l * (c8 * 8 + i)) & 2047; a8[i] += (cs ? -T[(idx - 512) & 2047] : T[idx]) * gv; } }
          u32x4 o; o.x = cvtpk(a8[0], a8[1]); o.y = cvtpk(a8[2], a8[3]); o.z = cvtpk(a8[4], a8[5]); o.w = cvtpk(a8[6], a8[7]);
          *(u32x4*)(WOUT + (size_t)(n0 + n) * 1280 + cs * 256 + 64 * g + c8 * 8) = o; } }
    __syncthreads();
    { float* MOD = (float*)(ws + WS_MOD); LAS float* sl = (LAS float*)cx.lds; LAS float* red = (LAS float*)(cx.lds + 36864);
      for (int i = cx.tid; i < 9 * 1024; i += 512) { const int r = i >> 10, k = i & 1023; const float v = (r < 8) ? p->c[r * 1024 + k] : p->c_ctx[k]; sl[i] = v / (1.f + __expf(-v)); }
      __syncthreads();
      for (int u = cx.vcu; u < 384; u += cx.G) { const int li = u / 192, j0 = (u % 192) * 32, colj = cx.tid & 31, ksl = cx.tid >> 5; float a[9];
#pragma unroll
          for (int r = 0; r < 9; ++r) a[r] = 0.f;
          const float* wp = p->w_ada + ((size_t)li * 1024 + ksl * 64) * 6144 + j0 + colj;
#pragma unroll 1
          for (int k0 = 0; k0 < 64; k0 += 32) { float w[32];
#pragma unroll
              for (int kk = 0; kk < 32; ++kk) w[kk] = wp[(size_t)(k0 + kk) * 6144];
#pragma unroll
              for (int kk = 0; kk < 32; ++kk)
#pragma unroll
                  for (int r = 0; r < 9; ++r) a[r] += sl[r * 1024 + ksl * 64 + k0 + kk] * w[kk]; }
#pragma unroll
          for (int r = 0; r < 9; ++r) red[(ksl * 9 + r) * 32 + colj] = a[r];
          __syncthreads();
          if (cx.tid < 288) { const int r = cx.tid >> 5; float t2 = p->b_ada[li * 6144 + j0 + colj];
#pragma unroll
              for (int q = 0; q < 16; ++q) t2 += red[(q * 9 + r) * 32 + colj];
              MOD[((size_t)li * 9 + r) * 6144 + j0 + colj] = t2; }
          __syncthreads(); } }
    { bf16_t* WIN = (bf16_t*)(ws + WS_WIN); bf16_t* WOUT = (bf16_t*)(ws + WS_WOUT);
      constexpr int I0 = 2 * 1280, I1 = 2 * 384;
      for (int it = cx.gw; it < I0 + I1; it += cx.ngw) { int r = it;
          if (r < I0) { const int li = r / 1280, q = r % 1280, kb = q / 80, nb = q % 80;
              tr_item(p->w_in + (size_t)li * 1024 * 2560, 2560, kb * 64, nb * 32, WIN + (size_t)li * 2560 * 1024, 1024, kb * 64, 0, scr, cx.lane); continue; } r -= I0;
          { const int li = r / 384, q = r % 384, kb = q / 32, nb = q % 32;
              tr_item(p->w_out + (size_t)li * 1024 * 1024, 1024, 256 + kb * 64, nb * 32, WOUT + (size_t)li * 1024 * 1280, 1280, 512 + kb * 64, 1, scr, cx.lane); } } }
}
constexpr int BG_PER_LAYER = 24576, BG_ALL = 2 * BG_PER_LAYER, BG_STEP = 32;
__device__ __forceinline__ void bg_item(CP* p, int x, LAS float* scr, int lane) {
    unsigned char* ws = p->ws; bf16_t* WGU = (bf16_t*)(ws + WS_WGU); bf16_t* WDN = (bf16_t*)(ws + WS_WD);
    const int li = x / BG_PER_LAYER, y = x % BG_PER_LAYER, type = y >> 13, r = y & 8191, le = li * 32 + (r >> 8), q = r & 255;
    if (type == 0) { const int kb = q >> 4, nb = q & 15; tr_item(p->w_gate + (size_t)le * 1024 * 512, 512, kb * 64, nb * 32, WGU + (size_t)le * 1024 * 1024, 1024, kb * 64, 2, scr, lane); }
    else if (type == 1) { const int kb = q >> 4, nb = q & 15; tr_item(p->w_up + (size_t)le * 1024 * 512, 512, kb * 64, nb * 32, WGU + (size_t)le * 1024 * 1024, 1024, kb * 64, 3, scr, lane); }
    else { const int kb = q >> 5, nb = q & 31; tr_item(p->w_down + (size_t)le * 512 * 1024, 1024, kb * 64, nb * 32, WDN + (size_t)le * 1024 * 512, 512, kb * 64, 4, scr, lane); }
}
__device__ __forceinline__ bool bg_step(CP* p, const Ctx& cx, int limit) {
    volatile LAS int* sel = (volatile LAS int*)(cx.lds + MISC_OFF + 40);
    __syncthreads();
    if (cx.tid == 0) { unsigned* hq = (unsigned*)(p->ws + WS_CTL) + CW_BGQ; int h = limit; if ((int)xb_ld(hq) < limit) h = (int)xb_add(hq, (unsigned)BG_STEP); sel[0] = h; }
    __syncthreads();
    const int h = __builtin_amdgcn_readfirstlane(sel[0]);
    if (h >= limit) return false;
    LAS float* scr = (LAS float*)(cx.lds + cx.wave * 8448);
#pragma unroll 1
    for (int k = 0; k < BG_STEP / 8; ++k) { const int x = h + cx.wave + 8 * k; if (x < limit) bg_item(p, x, scr, cx.lane); }
    return true;
}
__device__ __forceinline__ void bg_idle(CP* p, const Ctx& cx, int ph) {
    unsigned* dn = (unsigned*)(p->ws + WS_CTL) + CW_DONE + 64 * ph; volatile LAS int* sel = (volatile LAS int*)(cx.lds + MISC_OFF + 40);
    __syncthreads();
    if (cx.tid == 0) (void)xb_add(dn, 1u);
    for (;;) {
        __syncthreads();
        if (cx.tid == 0) sel[1] = ((int)xb_ld(dn) < cx.G) ? 1 : 0;
        __syncthreads();
        if (!__builtin_amdgcn_readfirstlane(sel[1])) break;
        if (!bg_step(p, cx, BG_ALL)) break;
    }
}
__device__ __forceinline__ void bg_drain(CP* p, const Ctx& cx, int limit) { while (bg_step(p, cx, limit)) { } }
__device__ __forceinline__ void phase_norm1(CP* p0, const Ctx& cx0, int li) {
    const Ctx cx = reopaque(cx0); CP* p = opaque_args(p0);
    unsigned char* ws = p->ws; float* X1 = (float*)(ws + WS_X1); const bf16_t* Y2 = (const bf16_t*)(ws + WS_Y2); bf16_t* H1 = (bf16_t*)(ws + WS_H1);
    const float* MOD = (const float*)(ws + WS_MOD) + (size_t)li * 9 * 6144; const float* n1 = p->norm1 + li * 1024;
    for (int m = cx.gw; m < MT; m += cx.ngw) {
        f32x4 v[4];
        if (li == 0) { const float* src = (m < NX) ? p->x + (size_t)m * D : p->ctx + (size_t)(m - NX) * D;
#pragma unroll
            for (int j = 0; j < 4; ++j) v[j] = *(const f32x4*)(src + 256 * j + 4 * cx.lane); }
        else { float* xr = X1 + (size_t)m * D; const bf16_t* ya = Y2 + (size_t)m * 2 * D; const float* g2 = MOD - 9 * 6144 + ((m < NX) ? (m >> 11) : 8) * 6144 + 5 * D;
#pragma unroll
            for (int j = 0; j < 4; ++j) { v[j] = *(const f32x4*)(xr + 256 * j + 4 * cx.lane); const f32x4 gg = *(const f32x4*)(g2 + 256 * j + 4 * cx.lane);
                const u32x2 a = *(const u32x2*)(ya + 256 * j + 4 * cx.lane), b = *(const u32x2*)(ya + D + 256 * j + 4 * cx.lane);
                v[j][0] += gg[0] * (bflo(a.x) + bflo(b.x)); v[j][1] += gg[1] * (bfhi(a.x) + bfhi(b.x)); v[j][2] += gg[2] * (bflo(a.y) + bflo(b.y)); v[j][3] += gg[3] * (bfhi(a.y) + bfhi(b.y));
                *(f32x4*)(xr + 256 * j + 4 * cx.lane) = v[j]; } }
        float ss = 0.f;
#pragma unroll
        for (int j = 0; j < 4; ++j) ss += v[j][0] * v[j][0] + v[j][1] * v[j][1] + v[j][2] * v[j][2] + v[j][3] * v[j][3];
        const float r = 1.0f / sqrtf(wave_sum(ss) * (1.0f / D) + 1e-6f);
        const int rr = (m < NX) ? (m >> 11) : 8; const float* sh = MOD + rr * 6144; const float* sc = sh + D;
#pragma unroll
        for (int j = 0; j < 4; ++j) { const int k = 256 * j + 4 * cx.lane; const f32x4 g = *(const f32x4*)(n1 + k), s1 = *(const f32x4*)(sc + k), h1 = *(const f32x4*)(sh + k);
            const f32x4 o = v[j] * r * g * (s1 + 1.0f) + h1; u32x2 w; w.x = cvtpk(o[0], o[1]); w.y = cvtpk(o[2], o[3]);
            *(u32x2*)(H1 + (size_t)m * D + k) = w; }
    }
}
__device__ __forceinline__ void phase_inproj(CP* p0, const Ctx& cx0, int li, int ph) {
    const Ctx cx = reopaque(cx0); CP* p = opaque_args(p0);
    unsigned char* ws = p->ws; const bf16_t* H1 = (const bf16_t*)(ws + WS_H1); const bf16_t* WIN = (const bf16_t*)(ws + WS_WIN) + (size_t)li * 2560 * 1024;
    pg8::SchedInproj S; S.R.init(H1, WIN + (size_t)768 * 1024, MT, NU, D, cx.G, (int)blockIdx.x); S.G = cx.G; S.c = (int)blockIdx.x; S.A1 = (const char*)WIN; S.B1 = (const char*)H1;
    pg8::EpiInproj E{(bf16_t*)(ws + WS_U), (bf16_t*)(ws + WS_FTX), (bf16_t*)(ws + WS_FTC), (bf16_t*)(ws + WS_VTX), (bf16_t*)(ws + WS_VTC)};
    pg8::gemm_phase<pg8::EpiInproj, pg8::SchedInproj, false, true, D>(cx.lds, S, E);
    (void)ph;
}
struct AttnPtrs { const bf16_t* U; const bf16_t* vtx; const bf16_t* vtc; bf16_t* conc; };
__device__ __forceinline__ void attn_dma_step(const AttnPtrs& a, int t, int b, int h, int krlo, int wave, int lane, LAS unsigned char* slot) {
    const bf16_t* kp; const bf16_t* vp; size_t vpitch;
    if (t < 4) { kp = a.U + (size_t)(NX + b * 256 + 64 * t) * NU + 512 + h * 64; vp = a.vtc + ((size_t)b * 512 + h * 64) * 256 + 64 * t; vpitch = 256; }
    else { const int t0 = 64 * (krlo + t - 4); kp = a.U + (size_t)(b * 2048 + t0) * NU + 512 + h * 64; vp = a.vtx + ((size_t)b * 512 + h * 64) * 2048 + t0; vpitch = 2048; }
    const int r = 8 * wave + (lane >> 3);
    __builtin_amdgcn_global_load_lds((const unsigned*)(kp + (size_t)r * NU + 8 * ((lane & 7) ^ (r & 7))), (LAS unsigned*)(slot + wave * 1024), 16, 0, 0);
    __builtin_amdgcn_global_load_lds((const unsigned*)(vp + (size_t)r * vpitch + 8 * ((lane & 7) ^ ((r >> 1) & 7))), (LAS unsigned*)(slot + 8192 + wave * 1024), 16, 0, 0);
}
__device__ __forceinline__ void attn_frags(const LAS unsigned char* sl, int kb0, int lane, bf16x8 (&kf)[4], bf16x8 (&vf)[4]) {
    const int q = lane & 31, hh = lane >> 5, key = kb0 + q;
#pragma unroll
    for (int s = 0; s < 4; ++s) kf[s] = *(const LAS bf16x8*)(sl + key * 128 + (((2 * s + hh) ^ (key & 7)) << 4));
#pragma unroll
    for (int s2 = 0; s2 < 2; ++s2)
#pragma unroll
        for (int dh = 0; dh < 2; ++dh) { const int d = 32 * dh + q, fd = (d >> 1) & 7, ch = (kb0 >> 3) + 2 * s2;
            const bf16x4 lo = *(const LAS bf16x4*)(sl + 8192 + d * 128 + ((ch ^ fd) << 4) + (hh << 3)), hi = *(const LAS bf16x4*)(sl + 8192 + d * 128 + (((ch + 1) ^ fd) << 4) + (hh << 3));
            vf[s2 * 2 + dh] = (bf16x8){lo[0], lo[1], lo[2], lo[3], hi[0], hi[1], hi[2], hi[3]}; }
}
#define ATT_COMPUTE(loc_, kr_, kf_, vf_) do { \
    f32x16 s_; \
    if (loc_) { const bool rok_ = ((kr_) >= rsq) && ((kr_) < rsq + 8); int ro_ = (kr_) - rq + 7; ro_ = ro_ < 0 ? 0 : (ro_ > 14 ? 14 : ro_); \
        const LAS float* bp_ = tblh + ro_ * 64 + cbase; const float rp_ = rok_ ? 0.f : -1e30f; \
        _Pragma("unroll") for (int i_ = 0; i_ < 16; ++i_) s_[i_] = bp_[(i_ & 3) + 8 * (i_ >> 2)] + colpen[i_] + rp_; } \
    else { _Pragma("unroll") for (int i_ = 0; i_ < 16; ++i_) s_[i_] = 0.f; } \
    _Pragma("unroll") for (int k_ = 0; k_ < 4; ++k_) s_ = __builtin_amdgcn_mfma_f32_32x32x16_bf16(kf_[k_], qf[k_], s_, 0, 0, 0); \
    float cm_ = s_[0]; \
    _Pragma("unroll") for (int i_ = 1; i_ < 16; ++i_) cm_ = fmaxf(cm_, s_[i_]); \
    if (__any(cm_ > mrun + 8.0f)) {     \
        cm_ = fmaxf(cm_, __shfl_xor(cm_, 32)); \
        const float mn_ = fmaxf(mrun, cm_); const float al_ = __builtin_amdgcn_exp2f(mrun - mn_); mrun = mn_; lsum *= al_; \
        _Pragma("unroll") for (int i_ = 0; i_ < 16; ++i_) { o0[i_] *= al_; o1[i_] *= al_; } } \
    float ps_ = 0.f; \
    _Pragma("unroll") for (int i_ = 0; i_ < 16; ++i_) { s_[i_] = __builtin_amdgcn_exp2f(s_[i_] - mrun); ps_ += s_[i_]; } \
    lsum += ps_; \
    bf16x8 p0_, p1_; { u32x4 w_; w_.x = cvtpk(s_[0], s_[1]); w_.y = cvtpk(s_[2], s_[3]); w_.z = cvtpk(s_[4], s_[5]); w_.w = cvtpk(s_[6], s_[7]); p0_ = __builtin_bit_cast(bf16x8, w_); \
        w_.x = cvtpk(s_[8], s_[9]); w_.y = cvtpk(s_[10], s_[11]); w_.z = cvtpk(s_[12], s_[13]); w_.w = cvtpk(s_[14], s_[15]); p1_ = __builtin_bit_cast(bf16x8, w_); } \
    o0 = __builtin_amdgcn_mfma_f32_32x32x16_bf16(vf_[0], p0_, o0, 0, 0, 0); o1 = __builtin_amdgcn_mfma_f32_32x32x16_bf16(vf_[1], p0_, o1, 0, 0, 0); \
    o0 = __builtin_amdgcn_mfma_f32_32x32x16_bf16(vf_[2], p1_, o0, 0, 0, 0); o1 = __builtin_amdgcn_mfma_f32_32x32x16_bf16(vf_[3], p1_, o1, 0, 0, 0); \
} while (0)

__device__ __forceinline__ void attn_group(const AttnPtrs& a, const LAS float* tbl, LAS unsigned char* ring, int qi, int gid, int wave, int lane) {
    const int q = lane & 31, hh = lane >> 5;
    int b, h, nsteps, krlo = 0, kr0 = 0, nl = 0, bs = 0, rq = 0, rsq = 0, cq = 0, csq = 0; size_t qrow;
    if (gid < 64) { const int pair = qi * 8 + (gid >> 3), g4 = gid & 7, rp = 2 * g4 + (wave >> 2), cb = wave & 3; b = pair >> 3; h = pair & 7;
        rq = 2 * rp + (q >> 4); cq = 16 * cb + (q & 15);
        rsq = rq - 4; rsq = rsq < 0 ? 0 : (rsq > 24 ? 24 : rsq); csq = cq - 8; csq = csq < 0 ? 0 : (csq > 48 ? 48 : csq);
        kr0 = 2 * rp - 4; kr0 = kr0 < 0 ? 0 : (kr0 > 24 ? 24 : kr0); int kr1 = 2 * rp + 1 - 4; kr1 = kr1 < 0 ? 0 : (kr1 > 24 ? 24 : kr1); nl = kr1 + 8 - kr0;
        krlo = 4 * g4 - 4; krlo = krlo < 0 ? 0 : (krlo > 24 ? 24 : krlo); int krhi = 4 * g4 + 3 - 4; krhi = krhi < 0 ? 0 : (krhi > 24 ? 24 : krhi); nsteps = 4 + (krhi + 8 - krlo);
        bs = (cb == 0) ? 0 : (cb == 1 ? 8 : (cb == 2 ? 24 : 32));
        qrow = (size_t)b * 2048 + 64 * rq + cq; }
    else { const int pair = qi * 8 + (gid - 64); b = pair >> 3; h = pair & 7; nsteps = 4; qrow = (size_t)NX + b * 256 + 32 * wave + q; }
    bf16x8 qf[4];
#pragma unroll
    for (int s = 0; s < 4; ++s) qf[s] = *(const bf16x8*)(a.U + qrow * NU + h * 64 + 16 * s + 8 * hh);
    attn_dma_step(a, 0, b, h, krlo, wave, lane, ring);
    attn_dma_step(a, 1, b, h, krlo, wave, lane, ring + 16384);
    asm volatile("s_waitcnt vmcnt(4)" : "+v"(qf[0]), "+v"(qf[1]), "+v"(qf[2]), "+v"(qf[3]) :: "memory");
    float colpen[16];
#pragma unroll
    for (int i = 0; i < 16; ++i) { const int kc = bs + (i & 3) + 8 * (i >> 2) + 4 * hh; colpen[i] = (kc >= csq && kc < csq + 16) ? 0.f : -1e30f; }
    const LAS float* tblh = tbl + h * (15 * 64); const int cbase = bs - cq + 15 + 16 + 4 * hh;
    f32x16 o0, o1;
#pragma unroll
    for (int i = 0; i < 16; ++i) { o0[i] = 0.f; o1[i] = 0.f; }
    float mrun = -1e30f, lsum = 0.f;
    bf16x8 kf[4], vf[4];
    int slot_t = 0, slot_n = 2;
#pragma unroll 1
    for (int t = 0; t < nsteps; ++t) {
        if (t + 1 < nsteps) asm volatile("s_waitcnt vmcnt(2)" ::: "memory"); else asm volatile("s_waitcnt vmcnt(0)" ::: "memory");
        __builtin_amdgcn_s_barrier();
        if (t + 2 < nsteps) attn_dma_step(a, t + 2, b, h, krlo, wave, lane, ring + slot_n * 16384);
        const LAS unsigned char* sl = ring + slot_t * 16384;
        const bool loc = (t >= 4); const int kr = krlo + t - 4;
        const int nsub = loc ? ((kr >= kr0 && kr < kr0 + nl) ? 1 : 0) : 2;
#pragma unroll 1
        for (int sub = 0; sub < nsub; ++sub) {
            attn_frags(sl, loc ? bs : 32 * sub, lane, kf, vf); asm volatile("s_waitcnt lgkmcnt(0)" ::: "memory"); __builtin_amdgcn_sched_barrier(0);
            ATT_COMPUTE(loc, kr, kf, vf); }
        slot_t = (slot_t == 2) ? 0 : slot_t + 1; slot_n = (slot_n == 2) ? 0 : slot_n + 1;
    }
    const float inv = 1.0f / (lsum + __shfl_xor(lsum, 32));
    bf16_t* op = a.conc + qrow * KO + 512 + h * 64 + 4 * hh;
#pragma unroll
    for (int g = 0; g < 4; ++g) { u32x2 w; w.x = cvtpk(o0[4 * g] * inv, o0[4 * g + 1] * inv); w.y = cvtpk(o0[4 * g + 2] * inv, o0[4 * g + 3] * inv); *(u32x2*)(op + 8 * g) = w;
        w.x = cvtpk(o1[4 * g] * inv, o1[4 * g + 1] * inv); w.y = cvtpk(o1[4 * g + 2] * inv, o1[4 * g + 3] * inv); *(u32x2*)(op + 32 + 8 * g) = w; }
}
__device__ __forceinline__ void phase_mix(CP* p0, const Ctx& cx0, int li, int rep, int ph) {
    const Ctx cx = reopaque(cx0); CP* p = opaque_args(p0);
    unsigned char* ws = p->ws; const bf16_t* U = (const bf16_t*)(ws + WS_U); bf16_t* CONC = (bf16_t*)(ws + WS_CONC);
    const int nrows = (li == 0) ? MT : NX;
    for (int rp_ = 0; rp_ < ((MK_MIXREP & 4) ? 3 : 1); ++rp_) if (!(MK_SUB & 16)) { const float* wc = p->w_conv + li * 768;
      for (int it = cx.vcu * 512 + cx.tid; it < nrows * 32; it += cx.G * 512) { const int m = it >> 5, c0 = (it & 31) * 8;
          const int pos = (m < NX) ? (m & 2047) : ((m - NX) & 255), len = (m < NX) ? 2048 : 256;
          const bf16_t* up = U + (size_t)m * NU; float z[3][8];
#pragma unroll
          for (int d = 0; d < 3; ++d) { const bool ok = (pos + d - 1 >= 0) && (pos + d - 1 < len);
              if (ok) { const u32x4 a = *(const u32x4*)(up + (ptrdiff_t)(d - 1) * NU + 1280 + c0), b = *(const u32x4*)(up + (ptrdiff_t)(d - 1) * NU + 1536 + c0);
                  z[d][0] = bflo(a.x) * bflo(b.x); z[d][1] = bfhi(a.x) * bfhi(b.x); z[d][2] = bflo(a.y) * bflo(b.y); z[d][3] = bfhi(a.y) * bfhi(b.y);
                  z[d][4] = bflo(a.z) * bflo(b.z); z[d][5] = bfhi(a.z) * bfhi(b.z); z[d][6] = bflo(a.w) * bflo(b.w); z[d][7] = bfhi(a.w) * bfhi(b.w); }
              else {
#pragma unroll
                  for (int j = 0; j < 8; ++j) z[d][j] = 0.f; } }
          const u32x4 g = *(const u32x4*)(up + 1024 + c0); float gb[8] = {bflo(g.x), bfhi(g.x), bflo(g.y), bfhi(g.y), bflo(g.z), bfhi(g.z), bflo(g.w), bfhi(g.w)}; float o[8];
#pragma unroll
          for (int j = 0; j < 8; ++j) o[j] = gb[j] * (wc[c0 + j] * z[0][j] + wc[256 + c0 + j] * z[1][j] + wc[512 + c0 + j] * z[2][j]);
          u32x4 w; w.x = cvtpk(o[0], o[1]); w.y = cvtpk(o[2], o[3]); w.z = cvtpk(o[4], o[5]); w.w = cvtpk(o[6], o[7]);
          *(u32x4*)(CONC + (size_t)m * KO + 1024 + c0) = w; } }
    for (int rp_ = 0; rp_ < ((MK_MIXREP & 1) ? 3 : 1); ++rp_) if (!(MK_SUB & 4)) { const int c = (int)blockIdx.x;
      pg8::SchedOne S; int Kd = 2048; pg8::EpiDft E{CONC, 8};
      if (c < 128) { S.has = true; S.u0.pm = c >> 3; S.u0.pn = c & 7; S.u0.aux = 0;
          S.u0.A = (const char*)(ws + WS_ADFTX) + (size_t)(c >> 3) * 256 * 2048 * 2; S.u0.B = (const char*)(ws + WS_FTX) + (size_t)(c & 7) * 256 * 2048 * 2; }
      else { const int c2 = c - 128; S.has = (li == 0 && c2 < 16); S.u0.pm = c2 >> 3; S.u0.pn = c2 & 7; S.u0.aux = 0; Kd = 256; E.conc = CONC + (size_t)NX * KO; E.ktiles = 1;
          S.u0.A = (const char*)(ws + WS_ADFTC) + (size_t)(c2 >> 3) * 256 * 256 * 2; S.u0.B = (const char*)(ws + WS_FTC) + (size_t)(c2 & 7) * 256 * 256 * 2; }
      pg8::gemm_phase<pg8::EpiDft, pg8::SchedOne, false, false, 0>(cx.lds, S, E, Kd); }
    for (int rp_ = 0; rp_ < ((MK_MIXREP & 2) ? 3 : 1); ++rp_) if (!(MK_SUB & 8)) { LAS float* tbl = (LAS float*)(cx.lds + MISC_OFF + 64);
      __syncthreads();
      for (int i = cx.tid; i < 8 * 15 * 64; i += 512) { const int col = (i & 63) - 16, ro = (i >> 6) % 15, h = i / 960;
          tbl[i] = (col >= 0 && col <= 30) ? p->rpb[(size_t)li * 3720 + h * 465 + ro * 31 + col] * LOG2E : 0.f; }
      __syncthreads();
      AttnPtrs a{U, (const bf16_t*)(ws + WS_VTX), (const bf16_t*)(ws + WS_VTC), CONC};
      unsigned* qw = (unsigned*)(ws + WS_CTL) + CW_ATTQ + li * 512 + rep * 1024 + rp_ * 1024;
      volatile LAS int* gsel = (volatile LAS int*)(cx.lds + MISC_OFF + 32);
      const int nper = (li == 0) ? 72 : 64; const int q0 = (int)(xb_xcc_id() & 7u);
      for (int qq = 0; qq < 8; ++qq) { const int qi = (q0 + qq) & 7;
          for (;;) {
              __syncthreads();
              if (cx.tid == 0) { int g = nper; if ((int)xb_ld(qw + qi * 64) < nper) g = (int)xb_add(qw + qi * 64, 1u); gsel[0] = g; }
              __syncthreads();
              const int gid = __builtin_amdgcn_readfirstlane(gsel[0]);
              if (gid >= nper) break;
              attn_group(a, tbl, cx.lds, qi, gid, cx.wave, cx.lane); } } }
    (void)ph;
}
__device__ __forceinline__ void phase_outproj(CP* p0, const Ctx& cx0, int li, int ph) {
    const Ctx cx = reopaque(cx0); CP* p = opaque_args(p0);
    unsigned char* ws = p->ws;
    pg8::SchedRect S; S.init(ws + WS_CONC, (const bf16_t*)(ws + WS_WOUT) + (size_t)li * 1024 * 1280, (li == 0) ? MT : NX, D, KO, cx.G, (int)blockIdx.x);
    pg8::EpiOut E{(float*)(ws + WS_X1), (li == 0) ? p->x : nullptr, (li == 0) ? p->ctx : nullptr, (const float*)(ws + WS_MOD) + (size_t)li * 9 * 6144};
    pg8::gemm_phase<pg8::EpiOut, pg8::SchedRect, false, true, KO>(cx.lds, S, E);
    bg_idle(p, cx, ph);
}
__device__ __forceinline__ void phase_router(CP* p0, const Ctx& cx0, int li, int dummy) {
    const Ctx cx = reopaque(cx0); CP* p = opaque_args(p0);
    unsigned char* ws = p->ws; const float* X1 = (const float*)(ws + WS_X1); bf16_t* TT = (bf16_t*)(ws + WS_H1);
    const float* MOD = (const float*)(ws + WS_MOD) + (size_t)li * 9 * 6144; const float* n2 = p->norm2 + li * 1024;
    const bf16_t* WH = (const bf16_t*)(ws + WS_WRT) + (size_t)li * 48 * 1024; const bf16_t* WL = WH + 2 * 48 * 1024;
    const int M = (li == 0) ? MT : NX; const int RB = (M + cx.G - 1) / cx.G;
    const int RPW = (RB + 7) >> 3;
    const int row0 = cx.vcu * RB;
    LAS float* lg = (LAS float*)cx.lds;
    LAS int* lcnt = (LAS int*)(cx.lds + 12288); LAS int* lbase = (LAS int*)(cx.lds + 12544);
    LAS unsigned char* wb = cx.lds + 16384;
    LAS unsigned char* wa = cx.lds + 16384 + 2 * 48 * 528 + cx.wave * (2 * 9 * 528);
    __syncthreads();
    if (cx.tid < 32) lcnt[cx.tid] = 0;
    u32x4 wreg[6];
#define RT_WLOAD(ii) do { _Pragma("unroll") for (int r_ = 0; r_ < 6; ++r_) { const int p_ = cx.tid + 512 * r_, hl_ = p_ / 1536, q_ = p_ % 1536, c_ = q_ >> 5, k16_ = q_ & 31; \
        wreg[r_] = *(const u32x4*)((hl_ ? WL : WH) + (size_t)c_ * 1024 + 256 * (ii) + 8 * k16_); } } while (0)
#define RT_WSTORE() do { _Pragma("unroll") for (int r_ = 0; r_ < 6; ++r_) { const int p_ = cx.tid + 512 * r_, hl_ = p_ / 1536, q_ = p_ % 1536, c_ = q_ >> 5, k16_ = q_ & 31; \
        *(LAS u32x4*)(wb + hl_ * (48 * 528) + c_ * 528 + 16 * k16_) = wreg[r_]; } } while (0)
    RT_WLOAD(0);
    float rinv[9];
#pragma unroll
    for (int j = 0; j < 9; ++j) { const int rl = cx.wave * RPW + j; int m = row0 + rl; const bool ok = (j < RPW) && (rl < RB) && (m < M); if (!ok) m = row0 < M ? row0 : 0;
        const float* xr = X1 + (size_t)m * D; float ss = 0.f;
#pragma unroll
        for (int i = 0; i < 4; ++i) { const f32x4 v = *(const f32x4*)(xr + 256 * i + 4 * cx.lane); ss += v[0] * v[0] + v[1] * v[1] + v[2] * v[2] + v[3] * v[3]; }
        rinv[j] = 1.0f / sqrtf(wave_sum(ss) * (1.0f / D) + 1e-6f); }
    f32x4 acc[3];
#pragma unroll
    for (int nt = 0; nt < 3; ++nt) acc[nt] = (f32x4){0.f, 0.f, 0.f, 0.f};
    const int col = cx.lane & 15, kq = cx.lane >> 4, rA = (col < 9) ? col : 8;
#pragma unroll 1
    for (int i = 0; i < 4; ++i) {
        if (i > 0) __syncthreads();
        RT_WSTORE();
        if (i < 3) RT_WLOAD(i + 1);
        const int k = 256 * i + 4 * cx.lane; const f32x4 g = *(const f32x4*)(n2 + k);
#pragma unroll
        for (int j = 0; j < 9; ++j) { const int rl = cx.wave * RPW + j; int m = row0 + rl; const bool ok = (j < RPW) && (rl < RB) && (m < M); if (!ok) m = row0 < M ? row0 : 0;
            const int rr = (m < NX) ? (m >> 11) : 8; const float* sh = MOD + rr * 6144 + 3 * D; const float* sc = sh + D;
            const f32x4 v = *(const f32x4*)(X1 + (size_t)m * D + k), s1 = *(const f32x4*)(sc + k), h1 = *(const f32x4*)(sh + k);
            const f32x4 t = v * rinv[j] * g * (s1 + 1.0f) + h1;
            u32x2 h, l; h.x = cvtpk(t[0], t[1]); h.y = cvtpk(t[2], t[3]);
            if (ok) *(u32x2*)(TT + (size_t)m * D + k) = h;
            l.x = cvtpk(t[0] - bflo(h.x), t[1] - bfhi(h.x)); l.y = cvtpk(t[2] - bflo(h.y), t[3] - bfhi(h.y));
            *(LAS u32x2*)(wa + j * 528 + 8 * cx.lane) = h; *(LAS u32x2*)(wa + (9 + j) * 528 + 8 * cx.lane) = l; }
        __syncthreads();
#pragma unroll
        for (int ks = 0; ks < 8; ++ks) { const bf16x8 ah = *(const LAS bf16x8*)(wa + rA * 528 + (32 * ks + 8 * kq) * 2), al = *(const LAS bf16x8*)(wa + (9 + rA) * 528 + (32 * ks + 8 * kq) * 2);
#pragma unroll
            for (int nt = 0; nt < 3; ++nt) { const int wo = (16 * nt + col) * 528 + (32 * ks + 8 * kq) * 2;
                const bf16x8 bh = *(const LAS bf16x8*)(wb + wo), bl = *(const LAS bf16x8*)(wb + 48 * 528 + wo);
                acc[nt] = __builtin_amdgcn_mfma_f32_16x16x32_bf16(ah, bh, acc[nt], 0, 0, 0);
                acc[nt] = __builtin_amdgcn_mfma_f32_16x16x32_bf16(ah, bl, acc[nt], 0, 0, 0);
                acc[nt] = __builtin_amdgcn_mfma_f32_16x16x32_bf16(al, bh, acc[nt], 0, 0, 0); } }
    }
#undef RT_WLOAD
#undef RT_WSTORE
#pragma unroll
    for (int nt = 0; nt < 3; ++nt)
#pragma unroll
        for (int r = 0; r < 4; ++r) { const int row = kq * 4 + r, c = 16 * nt + col; if (row < RPW && c < 36 && cx.wave * RPW + row < 72) lg[(cx.wave * RPW + row) * 36 + c] = acc[nt][r]; }
    __syncthreads();
    int e0 = 0, e1 = 0, lr0 = 0, lr1 = 0; float w0 = 0.f, w1 = 0.f; const bool act = (cx.tid < RB) && (row0 + cx.tid < M) && (cx.tid < 72);
    if (act) { const LAS float* l = lg + cx.tid * 36; float gl[4];
#pragma unroll
        for (int i = 0; i < 4; ++i) gl[i] = l[i] + p->b_rg[li * 4 + i];
        int gi = 0; float gm = gl[0];
#pragma unroll
        for (int i = 1; i < 4; ++i) if (gl[i] > gm) { gm = gl[i]; gi = i; }
        float gs = 0.f;
#pragma unroll
        for (int i = 0; i < 4; ++i) gs += __expf(gl[i] - gm);
        const float gw = 1.0f / gs;
        float ev[8];
#pragma unroll
        for (int i = 0; i < 8; ++i) ev[i] = l[4 + gi * 8 + i] + p->b_re[li * 32 + gi * 8 + i];
        int i0 = 0; float v0 = ev[0];
#pragma unroll
        for (int i = 1; i < 8; ++i) if (ev[i] > v0) { v0 = ev[i]; i0 = i; }
        int i1 = -1; float v1 = 0.f;
#pragma unroll
        for (int i = 0; i < 8; ++i) if (i != i0 && (i1 < 0 || ev[i] > v1)) { v1 = ev[i]; i1 = i; }
        const float ex = __expf(v1 - v0); w0 = gw / (1.f + ex); w1 = gw * ex / (1.f + ex);
        e0 = gi * 8 + i0; e1 = gi * 8 + i1;
        lr0 = __hip_atomic_fetch_add(&lcnt[e0], 1, __ATOMIC_RELAXED, __HIP_MEMORY_SCOPE_WORKGROUP); lr1 = __hip_atomic_fetch_add(&lcnt[e1], 1, __ATOMIC_RELAXED, __HIP_MEMORY_SCOPE_WORKGROUP); }
    __syncthreads();
    if (cx.tid < 32) { const int n = lcnt[cx.tid]; int base = 0; if (n > 0) base = (int)xb_add((unsigned*)(ws + WS_CTL) + CW_CNT + li * 2048 + cx.tid * 64 + dummy * 4096, (unsigned)n); lbase[cx.tid] = base; }
    __syncthreads();
    if (act) { const int tok = row0 + cx.tid; int* RL = (int*)(ws + (dummy ? WS_END : WS_ROWLIST)); float* TW = (float*)(ws + (dummy ? WS_END + 3 * MiB : WS_ROUTE));
        RL[(size_t)e0 * MT + lbase[e0] + lr0] = tok * 2; RL[(size_t)e1 * MT + lbase[e1] + lr1] = tok * 2 + 1;
        TW[tok * 2] = w0; TW[tok * 2 + 1] = w1; }
    if (!dummy) bg_drain(p, cx, (li == 0) ? BG_PER_LAYER : BG_ALL);
}
__device__ __forceinline__ void moe_tables(CP* p, const Ctx& cx, int li, int& ntiles) {
    LAS int* tcnt = (LAS int*)(cx.lds + MISC_OFF + MO_TCNT); LAS int* tbase = (LAS int*)(cx.lds + MISC_OFF + MO_TBASE);
    __syncthreads();
    if (cx.tid < 32) tcnt[cx.tid] = (int)__hip_atomic_load((unsigned*)(p->ws + WS_CTL) + CW_CNT + li * 2048 + cx.tid * 64, __ATOMIC_RELAXED, __HIP_MEMORY_SCOPE_AGENT);
    __syncthreads();
    if (cx.tid == 0) { int a = 0; for (int e = 0; e < 32; ++e) { tbase[e] = a; a += (tcnt[e] + 255) >> 8; } tbase[32] = a; }
    __syncthreads();
    ntiles = __builtin_amdgcn_readfirstlane(tbase[32]);
}
__device__ __forceinline__ void phase_moe_up(CP* p0, const Ctx& cx0, int li, int ph) {
    const Ctx cx = reopaque(cx0); CP* p = opaque_args(p0);
    unsigned char* ws = p->ws; int ntiles; moe_tables(p, cx, li, ntiles);
    LAS int* tcnt = (LAS int*)(cx.lds + MISC_OFF + MO_TCNT); LAS int* tbase = (LAS int*)(cx.lds + MISC_OFF + MO_TBASE); LAS int* idx = (LAS int*)(cx.lds + MISC_OFF + MO_IDX);
    const int* RL = (const int*)(ws + WS_ROWLIST);
    for (int i = 0; i < 3; ++i) { const int L = i * cx.G + cx.vcu, T = L >> 2;
        if (T < ntiles && cx.tid < 256) { int e = 0; for (int j = 1; j < 32; ++j) e += (tbase[j] <= T) ? 1 : 0;
            const int j = (T - tbase[e]) * 256 + cx.tid; const int ts = RL[(size_t)e * MT + (j < tcnt[e] ? j : 0)]; idx[i * 256 + cx.tid] = ts >> 1; } }
    __syncthreads();
    pg8::SchedMoe S; S.tbase = tbase; S.idx = idx; S.A = (const char*)(ws + WS_H1); S.B = (const char*)(ws + WS_WGU) + (size_t)li * 32 * 1024 * 1024 * 2;
    S.tA = 0; S.eB = (size_t)1024 * 1024 * 2; S.tB = (size_t)256 * 1024 * 2; S.G = cx.G; S.c = cx.vcu; S.ntiles = ntiles; S.gather = true;
    pg8::EpiUp E{(bf16_t*)(ws + WS_H)};
    pg8::gemm_phase<pg8::EpiUp, pg8::SchedMoe, true, true, D>(cx.lds, S, E);
    (void)ph;
}
__device__ __forceinline__ void phase_moe_down(CP* p0, const Ctx& cx0, int li, int ph) {
    const Ctx cx = reopaque(cx0); CP* p = opaque_args(p0);
    unsigned char* ws = p->ws; int ntiles; moe_tables(p, cx, li, ntiles);
    LAS int* tcnt = (LAS int*)(cx.lds + MISC_OFF + MO_TCNT); LAS int* tbase = (LAS int*)(cx.lds + MISC_OFF + MO_TBASE); LAS int* idx = (LAS int*)(cx.lds + MISC_OFF + MO_IDX);
    pg8::SchedMoe S; S.tbase = tbase; S.idx = idx; S.A = (const char*)(ws + WS_H); S.B = (const char*)(ws + WS_WD) + (size_t)li * 32 * 1024 * 512 * 2;
    S.tA = (size_t)256 * 512 * 2; S.eB = (size_t)1024 * 512 * 2; S.tB = (size_t)256 * 512 * 2; S.G = cx.G; S.c = cx.vcu; S.ntiles = ntiles; S.gather = false;
    pg8::EpiDown E{(bf16_t*)(ws + WS_Y2), (const int*)(ws + WS_ROWLIST), (const float*)(ws + WS_ROUTE), tcnt, tbase};
    pg8::gemm_phase<pg8::EpiDown, pg8::SchedMoe, false, true, DE>(cx.lds, S, E);
    (void)ph;
}
__device__ __forceinline__ void phase_final(CP* p0, const Ctx& cx0) {
    const Ctx cx = reopaque(cx0); CP* p = opaque_args(p0);
    unsigned char* ws = p->ws; const float* X1 = (const float*)(ws + WS_X1); const bf16_t* Y2 = (const bf16_t*)(ws + WS_Y2);
    for (int m = cx.gw; m < NX; m += cx.ngw) { const float* xr = X1 + (size_t)m * D; const bf16_t* ya = Y2 + (size_t)m * 2 * D; f32x4 v[4]; float ss = 0.f;
        const float* g2 = (const float*)(ws + WS_MOD) + (size_t)(9 + (m >> 11)) * 6144 + 5 * D;
#pragma unroll
        for (int j = 0; j < 4; ++j) { v[j] = *(const f32x4*)(xr + 256 * j + 4 * cx.lane); const f32x4 gg = *(const f32x4*)(g2 + 256 * j + 4 * cx.lane);
            const u32x2 a = *(const u32x2*)(ya + 256 * j + 4 * cx.lane), b = *(const u32x2*)(ya + D + 256 * j + 4 * cx.lane);
            v[j][0] += gg[0] * (bflo(a.x) + bflo(b.x)); v[j][1] += gg[1] * (bfhi(a.x) + bfhi(b.x)); v[j][2] += gg[2] * (bflo(a.y) + bflo(b.y)); v[j][3] += gg[3] * (bfhi(a.y) + bfhi(b.y));
            ss += v[j][0] * v[j][0] + v[j][1] * v[j][1] + v[j][2] * v[j][2] + v[j][3] * v[j][3]; }
        const float r = 1.0f / sqrtf(wave_sum(ss) * (1.0f / D) + 1e-6f);
#pragma unroll
        for (int j = 0; j < 4; ++j) { const int k = 256 * j + 4 * cx.lane; const f32x4 g = *(const f32x4*)(p->norm_final + k); *(f32x4*)(p->out + (size_t)m * D + k) = v[j] * r * g; } }
}

constexpr int N_PHASES = 16;
__global__ void __launch_bounds__(512, 2) mk_fwd(Params p_unused) {
    CP* p = (CP*)__builtin_amdgcn_kernarg_segment_ptr(); (void)p_unused;
    extern __shared__ __attribute__((aligned(16))) unsigned char lds_raw[];
    Ctx cx; cx.lds = (LAS unsigned char*)lds_raw; cx.tid = threadIdx.x; cx.lane = cx.tid & 63; cx.wave = __builtin_amdgcn_readfirstlane(cx.tid >> 6);
    cx.G = gridDim.x; { const int bx = blockIdx.x; cx.vcu = (cx.G % 8 == 0) ? (bx % 8) * (cx.G / 8) + bx / 8 : bx; }
    cx.gw = cx.vcu * 8 + cx.wave; cx.ngw = cx.G * 8;
    volatile LAS unsigned* misc = (volatile LAS unsigned*)(cx.lds + LDS_BYTES - 16);
    if (cx.tid < 4) misc[cx.tid] = 0u;
    __syncthreads();
#if MK_SPLIT
#define GRID_BAR() do { } while (0)
#else
    XcdBarrier bar = xcd_barrier_post((unsigned*)(p->ws + WS_CTL) + CW_BAR, misc);
#define GRID_BAR() xcd_barrier(bar)
#endif
    const int lo = p->ph_lo, hi = p->ph_hi, rep0 = p->rep0;
#define IN(k) (lo <= (k) && (k) < hi)
#define EN(j) (!((MK_SKIP >> (j)) & 1))
#define SEAM(k) do { if (IN(k) && IN((k) + 1)) GRID_BAR(); } while (0)
#define NREP(k) (((MK_REP >> (k)) & 1) ? 3 : 1)
#define RUN(kind, ph, cond, call) do { if (EN(kind) && IN(ph)) { const int nr_ = (cond) ? NREP(kind) : 1; for (int rep = nr_ - 1 + rep0; rep >= rep0; --rep) { call; if (rep > rep0) GRID_BAR(); } } } while (0)
    RUN(0, 0, true, phase_p0a(p, cx));
    SEAM(0);
    for (int li = 0; li < 2; ++li) { const int pb = 1 + 7 * li;
        RUN(2, pb + 0, li == 0, phase_norm1(p, cx, li));
        SEAM(pb + 0);
        RUN(3, pb + 1, true, phase_inproj(p, cx, li, pb + 1));
        SEAM(pb + 1);
        RUN(4, pb + 2, true, phase_mix(p, cx, li, rep, pb + 2));
        SEAM(pb + 2);
        RUN(5, pb + 3, li == 0, phase_outproj(p, cx, li, pb + 3));
        SEAM(pb + 3);
        RUN(6, pb + 4, true, phase_router(p, cx, li, rep));
        SEAM(pb + 4);
        RUN(7, pb + 5, true, phase_moe_up(p, cx, li, pb + 5));
        SEAM(pb + 5);
        RUN(8, pb + 6, true, phase_moe_down(p, cx, li, pb + 6));
        SEAM(pb + 6);
    }
    RUN(9, 15, true, phase_final(p, cx));
}

extern "C" void kernel_launch(void* const* d_in, const int* in_sizes, int n_in, void* d_out, int out_size, void* d_ws, size_t ws_size, hipStream_t stream) {
    static int grid = 0;
    if (grid == 0) {
        if (n_in != 21 || out_size != NX * D || ws_size < WS_END) { fprintf(stderr, "kernel_launch: unexpected shapes (n_in %d, out %d, ws %zu)\n", n_in, out_size, ws_size); grid = -1; return; }
        int dev = 0, cus = 0;
        if (hipGetDevice(&dev) != hipSuccess || hipDeviceGetAttribute(&cus, hipDeviceAttributeMultiprocessorCount, dev) != hipSuccess) { grid = -1; return; }
        if (hipFuncSetAttribute((const void*)mk_fwd, hipFuncAttributeMaxDynamicSharedMemorySize, LDS_BYTES) != hipSuccess) { fprintf(stderr, "kernel_launch: hipFuncSetAttribute failed\n"); grid = -1; return; }
        (void)hipGetLastError();
        grid = cus;
        if (grid != 256) fprintf(stderr, "kernel_launch: %d CUs (built for 256)\n", grid);
    }
    if (grid < 0) return;
    (void)in_sizes;
    (void)hipMemsetAsync((char*)d_ws + WS_CTL, 0, CTL_ZERO_BYTES, stream);
    Params a{};
    a.x = (const float*)d_in[0]; a.c = (const float*)d_in[1]; a.ctx = (const float*)d_in[2]; a.c_ctx = (const float*)d_in[3]; a.w_ada = (const float*)d_in[4]; a.b_ada = (const float*)d_in[5];
    a.norm1 = (const float*)d_in[6]; a.norm2 = (const float*)d_in[7]; a.w_in = (const float*)d_in[8]; a.w_fourier = (const float*)d_in[9]; a.w_conv = (const float*)d_in[10]; a.rpb = (const float*)d_in[11];
    a.w_out = (const float*)d_in[12]; a.w_rg = (const float*)d_in[13]; a.b_rg = (const float*)d_in[14]; a.w_re = (const float*)d_in[15]; a.b_re = (const float*)d_in[16];
    a.w_gate = (const float*)d_in[17]; a.w_up = (const float*)d_in[18]; a.w_down = (const float*)d_in[19]; a.norm_final = (const float*)d_in[20];
    a.out = (float*)d_out; a.ws = (unsigned char*)d_ws;
#if MK_SPLIT
    for (int ph = 0; ph < N_PHASES; ++ph) { a.ph_lo = ph; a.ph_hi = ph + 1;
        if (ph == MK_XTRA) for (int r = 2; r >= 1; --r) { a.rep0 = r; hipLaunchKernelGGL(mk_fwd, dim3(grid), dim3(512), LDS_BYTES, stream, a); }
        a.rep0 = 0; hipLaunchKernelGGL(mk_fwd, dim3(grid), dim3(512), LDS_BYTES, stream, a); }
#else
    a.ph_lo = 0; a.ph_hi = N_PHASES; hipLaunchKernelGGL(mk_fwd, dim3(grid), dim3(512), LDS_BYTES, stream, a);
#endif
}
```

```cpp
#include <hip/hip_runtime.h>
#include <cstdio>
#include <cstdint>

#ifndef MK_REP
#define MK_REP 0
#endif
#ifndef MK_MIXREP
#define MK_MIXREP 0
#endif
#ifndef MK_XTRA
#define MK_XTRA -1
#endif
#ifndef MK_TS
#define MK_TS 0
#endif
#ifndef MK_TSA
#define MK_TSA 0
#endif
#ifndef MK_TSB
#define MK_TSB 1
#endif
#ifndef MK_P0REP
#define MK_P0REP 0
#endif
#ifndef MK_SKIP
#define MK_SKIP 0
#endif
#ifndef MK_SUB
#define MK_SUB 0
#endif
#ifndef MK_SPLIT
#define MK_SPLIT 0
#endif

#define GAS __attribute__((address_space(1)))
#define LAS __attribute__((address_space(3)))
typedef unsigned short bf16_t;
typedef short bf16x8 __attribute__((ext_vector_type(8)));
typedef short bf16x4 __attribute__((ext_vector_type(4)));
typedef float f32x2 __attribute__((ext_vector_type(2)));
typedef float f32x4 __attribute__((ext_vector_type(4)));
typedef float f32x16 __attribute__((ext_vector_type(16)));
typedef unsigned u32x2 __attribute__((ext_vector_type(2)));
typedef unsigned u32x4 __attribute__((ext_vector_type(4)));
typedef __bf16 bf16x2_n __attribute__((ext_vector_type(2)));

constexpr int D = 1024, NB = 8, SEQ = 2048, LC = 256, NX = NB * SEQ, NC = NB * LC, MT = NX + NC;
constexpr int NU = 1792;
constexpr int KO = 1280;
constexpr int NE = 32, DE = 512, NHEAD = 8;
constexpr int MAXT = 176;
constexpr float QSCALE = 0.125f * 1.4426950408889634f;
constexpr float LOG2E = 1.4426950408889634f;

constexpr size_t MiB = 1u << 20;
constexpr size_t WS_CTL = 0, CTL_ZERO_BYTES = 1 * MiB;
constexpr size_t WS_MOD = 1 * MiB;
constexpr size_t WS_MODP = 2 * MiB;
constexpr size_t WS_MW = 16 * MiB;
constexpr size_t WS_WRT = 17 * MiB;
constexpr size_t WS_ROUTE = 18 * MiB;
constexpr size_t WS_ROWLIST = 19 * MiB;
constexpr size_t WS_ADFTC = 22 * MiB;
constexpr size_t WS_ADFTX = 23 * MiB;
constexpr size_t WS_WIN = 39 * MiB;
constexpr size_t WS_WOUT = 49 * MiB;
constexpr size_t WS_WGU = 54 * MiB;
constexpr size_t WS_WD = 182 * MiB;
constexpr size_t WS_H1 = 246 * MiB;
constexpr size_t WS_U = 282 * MiB;
constexpr size_t WS_Y2 = WS_U;
constexpr size_t WS_VTX = 354 * MiB;
constexpr size_t WS_VTC = 370 * MiB;
constexpr size_t WS_FTX = 372 * MiB;
constexpr size_t WS_FTC = 380 * MiB;
constexpr size_t WS_CONC = 381 * MiB;
constexpr size_t WS_H = WS_FTX;
constexpr size_t WS_X1 = 426 * MiB;
constexpr size_t WS_END = 498 * MiB;
static_assert(WS_H + (size_t)MAXT * 256 * 512 * 2 <= WS_X1, "H overlay");
static_assert(WS_Y2 + (size_t)MT * 2 * 1024 * 2 <= WS_VTX, "y2 overlay");

constexpr int CW_BAR = 4096;
constexpr int CW_ATTQ = 8192;
constexpr int CW_BGQ = 12288, CW_DONE = 12352;
constexpr int CW_CNT = 16384;

constexpr int RING_BYTES = 131072, MISC_OFF = RING_BYTES, LDS_BYTES = 163840;
constexpr int MO_TCNT = 64, MO_TBASE = 192, MO_LCNT = 384, MO_LBASE = 512, MO_IDX = 1024, MO_RROW = 4096;

__device__ __forceinline__ unsigned cvtpk(float lo, float hi) { f32x2 v = {lo, hi}; bf16x2_n b = __builtin_convertvector(v, bf16x2_n); return __builtin_bit_cast(unsigned, b); }
__device__ __forceinline__ float bf2f(unsigned short b) { return __uint_as_float(((unsigned)b) << 16); }
__device__ __forceinline__ float bflo(unsigned w) { return __uint_as_float(w << 16); }
__device__ __forceinline__ float bfhi(unsigned w) { return __uint_as_float(w & 0xffff0000u); }
__device__ __forceinline__ f32x4 ld_bf4(const bf16_t* p) { const u32x2 a = *(const u32x2*)p; return (f32x4){bflo(a.x), bfhi(a.x), bflo(a.y), bfhi(a.y)}; }
__device__ __forceinline__ float wave_sum(float v) {
#pragma unroll
    for (int o = 1; o < 64; o <<= 1) v += __shfl_xor(v, o);
    return v;
}
#define LDS_WAIT() asm volatile("s_waitcnt lgkmcnt(0)" ::: "memory")
#define LDS_BARRIER() do { asm volatile("s_waitcnt lgkmcnt(0)" ::: "memory"); __builtin_amdgcn_s_barrier(); asm volatile("" ::: "memory"); } while (0)
#define VM_WAIT() asm volatile("s_waitcnt vmcnt(0)" ::: "memory")

#define XB_TMO      128
#define XB_XCNT(j)  (256  + 64 * (j))
#define XB_XSUB(j)  (1280 + 64 * (j))
#define XB_XGEN(j)  (2304 + 64 * (j))
#define XB_TOP      3328
#define XB_TOPGEN   3392
#define XCD_BAR_WORDS 3456
#define XB_SPIN_CAP (1u << 18)
__device__ __forceinline__ unsigned xb_ld(unsigned* p)              { return __hip_atomic_load(p, __ATOMIC_RELAXED, __HIP_MEMORY_SCOPE_AGENT); }
__device__ __forceinline__ unsigned xb_add(unsigned* p, unsigned v) { return __hip_atomic_fetch_add(p, v, __ATOMIC_RELAXED, __HIP_MEMORY_SCOPE_AGENT); }
__device__ __forceinline__ unsigned xb_xcc_id() { return (unsigned)__builtin_amdgcn_s_getreg((3 << 11) | 20) & 0xFu; }
#define XB_SPIN(cond, bar) do { unsigned _sp = 0; while (cond) { __builtin_amdgcn_s_sleep(1); \
    if ((++_sp & 255u) == 0u) { if (xb_ld(&(bar)[XB_TMO])) break; if (_sp > XB_SPIN_CAP) { atomicAdd(&(bar)[XB_TMO], 1u); break; } } } } while (0)
struct XcdBarrier { unsigned* bar; unsigned x; volatile LAS unsigned* st; };
__device__ __forceinline__ XcdBarrier xcd_barrier_post(unsigned* bar, volatile LAS unsigned* st) {
    XcdBarrier b; b.bar = bar; b.x = xb_xcc_id(); b.st = st;
    if (threadIdx.x == 0) (void)xb_add(&bar[XB_XCNT(b.x)], 1u);
    return b;
}
__device__ __forceinline__ void xcd_barrier_complete(unsigned* bar, unsigned x, unsigned& nloc, unsigned& nx) {
    const unsigned G = gridDim.x * gridDim.y * gridDim.z;
    unsigned sum, cnt, mine, sp = 0u;
    for (;;) {
        sum = 0u; cnt = 0u; mine = 0u;
#pragma unroll
        for (unsigned j = 0; j < 16; ++j) { const unsigned c = xb_ld(&bar[XB_XCNT(j)]); sum += c; cnt += (c > 0u) ? 1u : 0u; mine = (j == x) ? c : mine; }
        if (sum == G) break;
        __builtin_amdgcn_s_sleep(1);
        if ((++sp & 255u) == 0u) { if (xb_ld(&bar[XB_TMO])) break; if (sp > XB_SPIN_CAP) { atomicAdd(&bar[XB_TMO], 1u); break; } }
    }
    nloc = mine > 0u ? mine : 1u; nx = cnt > 0u ? cnt : 1u;
}
__device__ __forceinline__ void xcd_barrier(const XcdBarrier& b) {
    asm volatile("s_waitcnt vmcnt(0)" ::: "memory");
    __syncthreads();
    if (threadIdx.x == 0) {
        unsigned* bar = b.bar;
        __builtin_amdgcn_s_waitcnt(0);
        unsigned nloc = b.st[0], nx = b.st[1];
        if (nloc == 0u) { xcd_barrier_complete(bar, b.x, nloc, nx); b.st[0] = nloc; b.st[1] = nx; }
        const unsigned old = xb_add(&bar[XB_XSUB(b.x)], 1u);
        const unsigned gen = old / nloc;
        if (old + 1u == (gen + 1u) * nloc) {
            __builtin_amdgcn_fence(__ATOMIC_RELEASE, "agent");
            asm volatile("s_waitcnt vmcnt(0)" ::: "memory");
            const unsigned og = xb_add(&bar[XB_TOP], 1u);
            const unsigned tg = og / nx;
            if (og + 1u == (tg + 1u) * nx) xb_add(&bar[XB_TOPGEN], 1u);
            else XB_SPIN(xb_ld(&bar[XB_TOPGEN]) == tg, bar);
            __builtin_amdgcn_fence(__ATOMIC_ACQUIRE, "agent");
            xb_add(&bar[XB_XGEN(b.x)], 1u);
            asm volatile("s_waitcnt vmcnt(0)" ::: "memory");
        } else {
            XB_SPIN(xb_ld(&bar[XB_XGEN(b.x)]) == gen, bar);
            __builtin_amdgcn_fence(__ATOMIC_ACQUIRE, "agent");
            asm volatile("s_waitcnt vmcnt(0)" ::: "memory");
        }
    }
    __syncthreads();
}

namespace pg8 {
constexpr int BM = 256, BK = 64, HALF = 128, HTB = HALF * BK * 2, STAGE_BYTES = 8 * HTB, NXCD = 8, WGM = 8;
__host__ __device__ __forceinline__ int lds_byte(int r, int c) { const int st = (r >> 4) * 2 + (c >> 5), rr = r & 15, cc = c & 31, ob = rr * 64 + cc * 2; return st * 1024 + (ob ^ (((ob >> 9) & 1) << 5)); }
__host__ __device__ __forceinline__ void stage_rc(int b, int& R, int& C) { const int st = b / 1024, sb = b % 1024, swz = sb ^ (((sb >> 9) & 1) << 5); R = (st >> 1) * 16 + swz / 64; C = (st & 1) * 32 + (swz % 64) / 2; }
__host__ __device__ __forceinline__ int perm32(int rho) { const int n = rho >> 4, i = rho & 15; return 8 * (i >> 2) + 4 * n + (i & 3); }

struct Unit { int pm, pn, aux; const char* A; const char* B; };

template <class Epi, class Sched, bool GATHER, bool ALIGN_EPI, int KT>
__device__ __forceinline__ void gemm_phase(LAS unsigned char* lds, const Sched& S, const Epi& E, const int Krt = 0) {
    const int K = KT ? KT : Krt;
    int tid_ = threadIdx.x; asm volatile("" : "+v"(tid_));
    const int tid = tid_, wid = __builtin_amdgcn_readfirstlane(tid >> 6), lane = tid & 63, wr = wid >> 2, wc = wid & 3, fr = lane & 15, fq = lane >> 4;
    const int nt = K / BK;
    int R0, C0; stage_rc(tid * 16, R0, C0);
    unsigned voffA[2], voffB[2];
#pragma unroll
    for (int i = 0; i < 2; ++i) { const int R = R0 + 64 * i; const int Rb = Epi::PERM ? ((R & ~31) + perm32(R & 31)) : R;
        voffA[i] = (unsigned)(R * K + C0) * 2u; voffB[i] = (unsigned)(Rb * K + C0) * 2u; }
    unsigned cvA0[2] = {0u, 0u}, cvA1[2] = {0u, 0u}, nvA0[2] = {0u, 0u}, nvA1[2] = {0u, 0u};
    const size_t kstep = (size_t)(BK * 2);
    const size_t hstep = (size_t)HALF * K * 2;
    const unsigned ldsw = (unsigned)wid * 1024u;
    const int aoff = lds_byte(wr * 64 + fr, fq * 8), boff = lds_byte(wc * 32 + fr, fq * 8);
#define PG8_SA(b, h) (((b) * 2 + (h)) * HTB)
#define PG8_SB(b, h) ((4 + (b) * 2 + (h)) * HTB)
#define PG8_STAGE(bufoff, gbase, voff) do { _Pragma("unroll") for (int _i = 0; _i < 2; ++_i) \
        __builtin_amdgcn_global_load_lds((const unsigned*)((const char*)(gbase) + (voff)[_i]), (LAS unsigned*)(lds + (bufoff) + ldsw + _i * 8192), 16, 0, 0); } while (0)
#define PG8_STAGE_A(b, h, gbase, g0, g1) do { if constexpr (GATHER) { if ((h) == 0) PG8_STAGE(PG8_SA(b, 0), gbase, g0); else PG8_STAGE(PG8_SA(b, 1), gbase, g1); } \
        else { PG8_STAGE(PG8_SA(b, h), (gbase) + ((h) ? hstep : 0), voffA); } } while (0)
#define PG8_ROWS(u, v0, v1) do { _Pragma("unroll") for (int _i = 0; _i < 2; ++_i) { v0[_i] = (unsigned)(S.arow(u, R0 + 64 * _i) * K + C0) * 2u; v1[_i] = (unsigned)(S.arow(u, 128 + R0 + 64 * _i) * K + C0) * 2u; } } while (0)
#define PG8_LDA(dst, b, h) do { _Pragma("unroll") for (int m = 0; m < 4; ++m) _Pragma("unroll") for (int k = 0; k < 2; ++k) dst[m][k] = *(const LAS bf16x8*)(lds + PG8_SA(b, h) + aoff + m * 2048 + k * 1024); } while (0)
#define PG8_LDB(dst, b, h) do { _Pragma("unroll") for (int n = 0; n < 2; ++n) _Pragma("unroll") for (int k = 0; k < 2; ++k) dst[n][k] = *(const LAS bf16x8*)(lds + PG8_SB(b, h) + boff + n * 2048 + k * 1024); } while (0)
#define PG8_MMA(ai, bj, At, Bt) do { __builtin_amdgcn_s_setprio(1); _Pragma("unroll") for (int m = 0; m < 4; ++m) _Pragma("unroll") for (int n = 0; n < 2; ++n) _Pragma("unroll") for (int k = 0; k < 2; ++k) \
        acc[ai][bj][m][n] = __builtin_amdgcn_mfma_f32_16x16x32_bf16(Bt[n][k], At[m][k], acc[ai][bj][m][n], 0, 0, 0); __builtin_amdgcn_s_setprio(0); } while (0)
#define PG8_WAIT_V(n) asm volatile("s_waitcnt vmcnt(" #n ")" ::: "memory")
#define PG8_WAIT_L(n) asm volatile("s_waitcnt lgkmcnt(" #n ")" ::: "memory")
#define PG8_BAR __builtin_amdgcn_s_barrier()
#define PG8_SCHED __builtin_amdgcn_sched_barrier(0)
    Unit cur, nxt; int ui = 0;
    if (!S.next(0, cur)) return;
    f32x4 acc[2][2][4][2];
#pragma unroll
    for (int a = 0; a < 2; ++a)
#pragma unroll
        for (int b = 0; b < 2; ++b)
#pragma unroll
            for (int m = 0; m < 4; ++m)
#pragma unroll
                for (int n = 0; n < 2; ++n) acc[a][b][m][n] = (f32x4){0.f, 0.f, 0.f, 0.f};
    bf16x8 At[4][2], B0[2][2], B1[2][2];
    const char* cA = cur.A; const char* cB = cur.B;
    if constexpr (GATHER) { PG8_ROWS(cur, cvA0, cvA1); }
    PG8_STAGE(PG8_SB(0, 0), cB, voffB); PG8_STAGE(PG8_SB(0, 1), cB + hstep, voffB); PG8_STAGE_A(0, 0, cA, cvA0, cvA1); PG8_STAGE_A(0, 1, cA, cvA0, cvA1);
    if (wr == 1) PG8_BAR;
    PG8_WAIT_V(2); PG8_BAR;
    PG8_STAGE(PG8_SB(1, 0), cB + kstep, voffB); PG8_STAGE_A(1, 0, cA + kstep, cvA0, cvA1); PG8_STAGE(PG8_SB(1, 1), cB + hstep + kstep, voffB);
    PG8_WAIT_V(6); PG8_BAR;
    for (;;) {
        const bool has_next = S.next(ui + 1, nxt);
        const char* nA = has_next ? nxt.A : cA; const char* nB = has_next ? nxt.B : cB;
        if constexpr (GATHER) { if (has_next) { PG8_ROWS(nxt, nvA0, nvA1); } else {
#pragma unroll
            for (int i = 0; i < 2; ++i) { nvA0[i] = cvA0[i]; nvA1[i] = cvA1[i]; } } }
        for (int t = 0; t < nt; t += 2) {
            const bool last = (t == nt - 2);
            const char* a1 = cA + (size_t)(t + 1) * kstep;
            const char* a2 = last ? nA : cA + (size_t)(t + 2) * kstep; const char* b2 = last ? nB : cB + (size_t)(t + 2) * kstep;
            const char* a3 = a2 + kstep; const char* b3 = b2 + kstep;
            unsigned sA0[2], sA1[2];
#pragma unroll
            for (int i = 0; i < 2; ++i) { sA0[i] = last ? nvA0[i] : cvA0[i]; sA1[i] = last ? nvA1[i] : cvA1[i]; }
            PG8_LDB(B0, 0, 0); PG8_LDB(B1, 0, 1); PG8_SCHED; PG8_LDA(At, 0, 0); PG8_STAGE_A(1, 1, a1, cvA0, cvA1);
            PG8_WAIT_V(8); PG8_WAIT_L(0); PG8_BAR; PG8_MMA(0, 0, At, B0); PG8_MMA(0, 1, At, B1); PG8_BAR; PG8_SCHED;
            PG8_LDA(At, 0, 1); PG8_STAGE(PG8_SB(0, 0), b2, voffB); PG8_STAGE(PG8_SB(0, 1), b2 + hstep, voffB); PG8_STAGE_A(0, 0, a2, sA0, sA1);
            PG8_WAIT_V(8); PG8_WAIT_L(0); PG8_BAR; PG8_MMA(1, 0, At, B0); PG8_MMA(1, 1, At, B1); PG8_BAR; PG8_SCHED;
            PG8_LDB(B0, 1, 0); PG8_LDB(B1, 1, 1); PG8_SCHED; PG8_LDA(At, 1, 0); PG8_STAGE_A(0, 1, a2, sA0, sA1);
            PG8_WAIT_V(8); PG8_WAIT_L(0); PG8_BAR; PG8_MMA(0, 0, At, B0); PG8_MMA(0, 1, At, B1); PG8_BAR; PG8_SCHED;
            PG8_LDA(At, 1, 1); PG8_STAGE(PG8_SB(1, 0), b3, voffB); PG8_STAGE(PG8_SB(1, 1), b3 + hstep, voffB); PG8_STAGE_A(1, 0, a3, sA0, sA1);
            PG8_WAIT_V(8); PG8_WAIT_L(0); PG8_BAR; PG8_MMA(1, 0, At, B0); PG8_MMA(1, 1, At, B1); PG8_BAR; PG8_SCHED;
        }
        if constexpr (ALIGN_EPI) { if (wr == 0) PG8_BAR; }
        E(acc, cur, wr, wc, fr, fq);
        if (!has_next) break;
#pragma unroll
        for (int a = 0; a < 2; ++a)
#pragma unroll
            for (int b = 0; b < 2; ++b)
#pragma unroll
                for (int m = 0; m < 4; ++m)
#pragma unroll
                    for (int n = 0; n < 2; ++n) acc[a][b][m][n] = (f32x4){0.f, 0.f, 0.f, 0.f};
        cur = nxt; cA = nA; cB = nB; ++ui;
        if constexpr (GATHER) {
#pragma unroll
            for (int i = 0; i < 2; ++i) { cvA0[i] = nvA0[i]; cvA1[i] = nvA1[i]; } }
        if constexpr (ALIGN_EPI) { if (wr == 1) PG8_BAR; }
    }
    PG8_WAIT_V(0);
    if constexpr (!ALIGN_EPI) { if (wr == 0) PG8_BAR; }
    PG8_BAR;
#undef PG8_SA
#undef PG8_SB
#undef PG8_STAGE
#undef PG8_STAGE_A
#undef PG8_ROWS
#undef PG8_LDA
#undef PG8_LDB
#undef PG8_MMA
#undef PG8_WAIT_V
#undef PG8_WAIT_L
#undef PG8_BAR
#undef PG8_SCHED
}

struct SchedRect {
    const char* A; const char* B; size_t tA, tB; int nM, nN, nwg, G, c;
    __device__ __forceinline__ void init(const void* A_, const void* B_, int M, int N, int K, int G_, int c_) { A = (const char*)A_; B = (const char*)B_; tA = tB = (size_t)BM * K * 2; nM = M / BM; nN = N / BM; nwg = nM * nN; G = G_; c = c_; }
    __device__ __forceinline__ bool next(int i, Unit& u) const {
        const long L = (long)i * G + c; if (L >= nwg) return false;
        int wgid = (int)L; { const int q = nwg / NXCD, r = nwg % NXCD, xcd = wgid % NXCD, off = wgid / NXCD; wgid = (xcd < r ? xcd * (q + 1) : r * (q + 1) + (xcd - r) * q) + off; }
        const int nig = WGM * nN, gid = wgid / nig, fm = gid * WGM, gsz = (nM - fm) < WGM ? (nM - fm) : WGM;
        u.pm = fm + ((wgid % nig) % gsz); u.pn = (wgid % nig) / gsz; u.aux = 0; u.A = A + (size_t)u.pm * tA; u.B = B + (size_t)u.pn * tB; return true;
    }
    __device__ __forceinline__ int arow(const Unit&, int) const { return 0; }
};
struct SchedOne {
    bool has; Unit u0;
    __device__ __forceinline__ bool next(int i, Unit& u) const { if (i > 0 || !has) return false; u = u0; return true; }
    __device__ __forceinline__ int arow(const Unit&, int) const { return 0; }
};
struct SchedMoe {
    const LAS int* tbase; const LAS int* idx; const char* A; const char* B; size_t tA, eB, tB; int G, c, ntiles; bool gather;
    __device__ __forceinline__ bool next(int i, Unit& u) const {
        const int L = i * G + c, T = L >> 2; if (T >= ntiles) return false;
        int e = 0;
#pragma unroll 1
        for (int j = 1; j < 32; ++j) e += (tbase[j] <= T) ? 1 : 0;
        e = __builtin_amdgcn_readfirstlane(e);
        u.pm = T; u.pn = L & 3; u.aux = e | (i << 8); u.A = gather ? A : A + (size_t)T * tA; u.B = B + (size_t)e * eB + (size_t)(L & 3) * tB; return true;
    }
    __device__ __forceinline__ int arow(const Unit& u, int r) const { return idx[(u.aux >> 8) * 256 + r]; }
};

struct EpiBf16 {
    static constexpr bool PERM = true;
    bf16_t* O; int ldc;
    __device__ __forceinline__ void operator()(const f32x4 (&acc)[2][2][4][2], const Unit& u, int wr, int wc, int fr, int fq) const {
        const int row0 = u.pm * BM + wr * 64 + fr, col0 = u.pn * BM + wc * 32 + 8 * fq;
#pragma unroll
        for (int ai = 0; ai < 2; ++ai)
#pragma unroll
            for (int m = 0; m < 4; ++m) { bf16_t* rowp = O + (size_t)(row0 + ai * HALF + m * 16) * ldc + col0;
#pragma unroll
                for (int bj = 0; bj < 2; ++bj) { const f32x4 v0 = acc[ai][bj][m][0], v1 = acc[ai][bj][m][1];
                    u32x4 w; w.x = cvtpk(v0[0], v0[1]); w.y = cvtpk(v0[2], v0[3]); w.z = cvtpk(v1[0], v1[1]); w.w = cvtpk(v1[2], v1[3]);
                    *(u32x4*)(rowp + bj * HALF) = w; } }
    }
};
struct EpiT {
    static constexpr bool PERM = true;
    bf16_t *ftx, *ftc, *vtx, *vtc;
    __device__ __forceinline__ void operator()(const f32x4 (&acc)[2][2][4][2], const Unit& u, int wr, int wc, int fr, int fq) const {
        bf16_t* base; int pitch;
        const int b = (u.pn < 64) ? (u.pn >> 3) : (u.pn - 64);
        if (u.pm == 0) { if (u.pn < 64) { base = ftx + (size_t)b * 256 * 2048 + (u.pn & 7) * 256; pitch = 2048; } else { base = ftc + (size_t)b * 256 * 256; pitch = 256; } }
        else { const int v0 = (u.pm - 1) * 256; if (u.pn < 64) { base = vtx + ((size_t)b * 512 + v0) * 2048 + (u.pn & 7) * 256; pitch = 2048; } else { base = vtc + ((size_t)b * 512 + v0) * 256; pitch = 256; } }
        const int row0 = wr * 64 + fr, col0 = wc * 32 + 8 * fq;
#pragma unroll
        for (int ai = 0; ai < 2; ++ai)
#pragma unroll
            for (int m = 0; m < 4; ++m) { bf16_t* rowp = base + (size_t)(row0 + ai * HALF + m * 16) * pitch + col0;
#pragma unroll
                for (int bj = 0; bj < 2; ++bj) { const f32x4 v0 = acc[ai][bj][m][0], v1 = acc[ai][bj][m][1];
                    u32x4 w; w.x = cvtpk(v0[0], v0[1]); w.y = cvtpk(v0[2], v0[3]); w.z = cvtpk(v1[0], v1[1]); w.w = cvtpk(v1[2], v1[3]);
                    *(u32x4*)(rowp + bj * HALF) = w; } }
    }
};
struct EpiDft {
    static constexpr bool PERM = true;
    bf16_t* conc; int ctxmode;
    __device__ __forceinline__ void operator()(const f32x4 (&acc)[2][2][4][2], const Unit& u, int wr, int wc, int fr, int fq) const {
        const int N = ctxmode ? 256 : 2048; bf16_t* base = conc + (size_t)u.pn * N * KO + wc * 32 + 8 * fq;
#pragma unroll
        for (int ai = 0; ai < 2; ++ai)
#pragma unroll
            for (int m = 0; m < 4; ++m) { const int r = ai * HALF + wr * 64 + m * 16 + fr;
                const int cs = ctxmode ? ai : (u.pm >> 2), k = ctxmode ? (r - ai * HALF) : ((u.pm & 3) * 256 + r);
                bf16_t* rowp = base + (size_t)k * KO + cs * 256; bf16_t* mirp = base + (size_t)(N - k) * KO + cs * 256; const float sg = cs ? -1.f : 1.f;
#pragma unroll
                for (int bj = 0; bj < 2; ++bj) { const f32x4 v0 = acc[ai][bj][m][0], v1 = acc[ai][bj][m][1];
                    u32x4 w; w.x = cvtpk(v0[0], v0[1]); w.y = cvtpk(v0[2], v0[3]); w.z = cvtpk(v1[0], v1[1]); w.w = cvtpk(v1[2], v1[3]);
                    *(u32x4*)(rowp + bj * HALF) = w;
                    if (k > 0) { u32x4 x; x.x = cvtpk(v0[0] * sg, v0[1] * sg); x.y = cvtpk(v0[2] * sg, v0[3] * sg); x.z = cvtpk(v1[0] * sg, v1[1] * sg); x.w = cvtpk(v1[2] * sg, v1[3] * sg);
                        *(u32x4*)(mirp + bj * HALF) = x; } } }
    }
};
struct EpiOut {
    static constexpr bool PERM = true;
    bf16_t* x1; const float* xin; const float* cin; const float* mod;
    __device__ __forceinline__ void operator()(const f32x4 (&acc)[2][2][4][2], const Unit& u, int wr, int wc, int fr, int fq) const {
        const int rr = (u.pm < 64) ? (u.pm >> 3) : 8;
        const int row0 = u.pm * BM + wr * 64 + fr, col0 = u.pn * BM + wc * 32 + 8 * fq;
        const float* res = xin ? ((u.pm < 64) ? xin + (size_t)row0 * D : cin + (size_t)(row0 - NX) * D) : nullptr;
        const float* g1 = mod + rr * 6144 + 2 * D + col0;
        f32x4 gv[2][2];
#pragma unroll
        for (int bj = 0; bj < 2; ++bj)
#pragma unroll
            for (int n = 0; n < 2; ++n) gv[bj][n] = *(const f32x4*)(g1 + bj * HALF + 4 * n);
#pragma unroll
        for (int ai = 0; ai < 2; ++ai)
#pragma unroll
            for (int m = 0; m < 4; ++m) { const size_t ro = (size_t)(ai * HALF + m * 16) * D + col0; bf16_t* op = x1 + (size_t)row0 * D + ro;
#pragma unroll
                for (int bj = 0; bj < 2; ++bj) { f32x4 r0, r1;
                    if (res) { r0 = *(const f32x4*)(res + ro + bj * HALF); r1 = *(const f32x4*)(res + ro + bj * HALF + 4); }
                    else { const u32x4 q = *(const u32x4*)(op + bj * HALF); r0 = (f32x4){bflo(q.x), bfhi(q.x), bflo(q.y), bfhi(q.y)}; r1 = (f32x4){bflo(q.z), bfhi(q.z), bflo(q.w), bfhi(q.w)}; }
                    const f32x4 v0 = r0 + gv[bj][0] * acc[ai][bj][m][0], v1 = r1 + gv[bj][1] * acc[ai][bj][m][1];
                    u32x4 w; w.x = cvtpk(v0[0], v0[1]); w.y = cvtpk(v0[2], v0[3]); w.z = cvtpk(v1[0], v1[1]); w.w = cvtpk(v1[2], v1[3]);
                    *(u32x4*)(op + bj * HALF) = w; } }
    }
};
struct EpiUp {
    static constexpr bool PERM = false;
    bf16_t* H;
    __device__ __forceinline__ void operator()(const f32x4 (&acc)[2][2][4][2], const Unit& u, int wr, int wc, int fr, int fq) const {
        const int row0 = u.pm * BM + wr * 64 + fr;
#pragma unroll
        for (int ai = 0; ai < 2; ++ai)
#pragma unroll
            for (int m = 0; m < 4; ++m) { bf16_t* rowp = H + (size_t)(row0 + ai * HALF + m * 16) * DE;
#pragma unroll
                for (int bj = 0; bj < 2; ++bj) { const int hid = 16 * (8 * u.pn + 4 * bj + wc) + 4 * fq;
                    const f32x4 g = acc[ai][bj][m][0], up = acc[ai][bj][m][1]; float h[4];
#pragma unroll
                    for (int j = 0; j < 4; ++j) h[j] = g[j] * __builtin_amdgcn_rcpf(1.f + __builtin_amdgcn_exp2f(-LOG2E * g[j])) * up[j];
                    u32x2 w; w.x = cvtpk(h[0], h[1]); w.y = cvtpk(h[2], h[3]);
                    *(u32x2*)(rowp + hid) = w; } }
    }
};
struct EpiDown {
    static constexpr bool PERM = true;
    bf16_t* y2; const int* rowlist; const float* tokw; const LAS int* tcnt; const LAS int* tbase;
    __device__ __forceinline__ void operator()(const f32x4 (&acc)[2][2][4][2], const Unit& u, int wr, int wc, int fr, int fq) const {
        const int e = u.aux & 255, cnt = tcnt[e], j0 = (u.pm - tbase[e]) * 256 + wr * 64 + fr;
        const int col0 = u.pn * BM + wc * 32 + 8 * fq;
        int ts[2][4]; float pw[2][4];
#pragma unroll
        for (int ai = 0; ai < 2; ++ai)
#pragma unroll
            for (int m = 0; m < 4; ++m) { const int j = j0 + ai * HALF + m * 16; ts[ai][m] = (j < cnt) ? rowlist[(size_t)e * MT + j] : -1; }
#pragma unroll
        for (int ai = 0; ai < 2; ++ai)
#pragma unroll
            for (int m = 0; m < 4; ++m) pw[ai][m] = (ts[ai][m] >= 0) ? tokw[ts[ai][m]] : 0.f;
#pragma unroll
        for (int ai = 0; ai < 2; ++ai)
#pragma unroll
            for (int m = 0; m < 4; ++m) {
                if (ts[ai][m] >= 0) { bf16_t* rowp = y2 + (size_t)ts[ai][m] * D + col0; const float w_ = pw[ai][m];
#pragma unroll
                    for (int bj = 0; bj < 2; ++bj) { const f32x4 v0 = acc[ai][bj][m][0] * w_, v1 = acc[ai][bj][m][1] * w_;
                        u32x4 w; w.x = cvtpk(v0[0], v0[1]); w.y = cvtpk(v0[2], v0[3]); w.z = cvtpk(v1[0], v1[1]); w.w = cvtpk(v1[2], v1[3]);
                        *(u32x4*)(rowp + bj * HALF) = w; } } }
    }
};
struct SchedInproj {
    SchedRect R; const char *A1, *B1; int G, c;
    __device__ __forceinline__ bool next(int i, Unit& u) const {
        const int L = i * G + c; if (L < R.nwg) return R.next(i, u);
        const int j = L - R.nwg; if (j >= 216) return false;
        u.pm = j % 3; u.pn = j / 3; u.aux = 1; u.A = A1 + (size_t)u.pm * ((size_t)BM * D * 2); u.B = B1 + (size_t)u.pn * ((size_t)BM * D * 2); return true;
    }
    __device__ __forceinline__ int arow(const Unit&, int) const { return 0; }
};
struct EpiInproj {
    static constexpr bool PERM = true;
    bf16_t *U, *ftx, *ftc, *vtx, *vtc;
    __device__ __forceinline__ void operator()(const f32x4 (&acc)[2][2][4][2], const Unit& u, int wr, int wc, int fr, int fq) const {
        bf16_t* base; size_t pitch;
        if (u.aux == 0) { base = U + (size_t)u.pm * BM * NU + (size_t)u.pn * BM; pitch = NU; }
        else { const int b = (u.pn < 64) ? (u.pn >> 3) : (u.pn - 64);
            if (u.pm == 0) { if (u.pn < 64) { base = ftx + (size_t)b * 256 * 2048 + (u.pn & 7) * 256; pitch = 2048; } else { base = ftc + (size_t)b * 256 * 256; pitch = 256; } }
            else { const int v0 = (u.pm - 1) * 256; if (u.pn < 64) { base = vtx + ((size_t)b * 512 + v0) * 2048 + (u.pn & 7) * 256; pitch = 2048; } else { base = vtc + ((size_t)b * 512 + v0) * 256; pitch = 256; } } }
        const int row0 = wr * 64 + fr, col0 = wc * 32 + 8 * fq;
#pragma unroll
        for (int ai = 0; ai < 2; ++ai)
#pragma unroll
            for (int m = 0; m < 4; ++m) { bf16_t* rowp = base + (size_t)(row0 + ai * HALF + m * 16) * pitch + col0;
#pragma unroll
                for (int bj = 0; bj < 2; ++bj) { const f32x4 v0 = acc[ai][bj][m][0], v1 = acc[ai][bj][m][1];
                    u32x4 w; w.x = cvtpk(v0[0], v0[1]); w.y = cvtpk(v0[2], v0[3]); w.z = cvtpk(v1[0], v1[1]); w.w = cvtpk(v1[2], v1[3]);
                    *(u32x4*)(rowp + bj * HALF) = w; } }
    }
};
}

struct Params {
    const float *x, *c, *ctx, *c_ctx, *w_ada, *b_ada, *norm1, *norm2, *w_in, *w_fourier, *w_conv, *rpb, *w_out, *w_rg, *b_rg, *w_re, *b_re, *w_gate, *w_up, *w_down, *norm_final;
    float* out; unsigned char* ws; int ph_lo, ph_hi, rep0, pad;
};
typedef const __attribute__((address_space(4))) Params CP;
__device__ __forceinline__ CP* opaque_args(CP* p) { asm volatile("" : "+s"(p)); return p; }
struct Ctx { LAS unsigned char* lds; int tid, lane, wave, G, vcu, gw, ngw; };
__device__ __forceinline__ Ctx reopaque(const Ctx& c) { Ctx r = c; int t = threadIdx.x; asm volatile("" : "+v"(t)); r.tid = t; r.lane = t & 63; return r; }

__device__ __forceinline__ void tr_item(const float* src, int ldn, int k0, int n0, bf16_t* dst, int ldk, int kd0, int rtype, LAS float* scr, int lane) {
    float tv[32];
#pragma unroll
    for (int i = 0; i < 32; ++i) tv[i] = src[(size_t)(k0 + 2 * i + (lane >> 5)) * ldn + n0 + (lane & 31)];
#pragma unroll
    for (int i = 0; i < 32; ++i) scr[(2 * i + (lane >> 5)) * 33 + (lane & 31)] = tv[i];
    LDS_WAIT(); asm volatile("" ::: "memory");
    const int c = lane & 7;
#pragma unroll
    for (int j = 0; j < 4; ++j) { const int n = (lane >> 3) + 8 * j; const LAS float* s = scr + (8 * c) * 33 + n;
        const int sn = n0 + n; int dr; float sc = 1.f;
        if (rtype == 0) { dr = (sn < 256) ? sn : (sn < 1280 ? sn + 512 : (sn < 1792 ? sn - 1024 : sn)); if (sn >= 256 && sn < 768) sc = QSCALE; }
        else if (rtype == 2) dr = 32 * (sn >> 4) + (sn & 15);
        else if (rtype == 3) dr = 32 * (sn >> 4) + 16 + (sn & 15);
        else dr = sn;
        u32x4 o; o.x = cvtpk(s[0 * 33] * sc, s[1 * 33] * sc); o.y = cvtpk(s[2 * 33] * sc, s[3 * 33] * sc); o.z = cvtpk(s[4 * 33] * sc, s[5 * 33] * sc); o.w = cvtpk(s[6 * 33] * sc, s[7 * 33] * sc);
        *(u32x4*)(dst + (size_t)dr * ldk + kd0 + 8 * c) = o; }
    LDS_WAIT(); asm volatile("" ::: "memory");
}
__device__ __forceinline__ void phase_p0a(CP* p0, const Ctx& cx0) {
    const Ctx cx = reopaque(cx0); CP* p = opaque_args(p0);
    LAS float* T = (LAS float*)(cx.lds + 147456);
    LAS float* scr = (LAS float*)(cx.lds + cx.wave * 8448);
    unsigned char* ws = p->ws;
    for (int j = cx.tid; j < 2048; j += 512) T[j] = cospif((float)j * (1.0f / 1024.0f));
    __syncthreads();
    const int gt = cx.vcu * 512 + cx.tid, ngt = cx.G * 512;
    for (int rp_ = 0; rp_ < ((MK_P0REP & 1) ? 3 : 1); ++rp_) { bf16_t* AX = (bf16_t*)(ws + WS_ADFTX); const float SX = 0.0027621358640099513f;
      for (int it = gt; it < 2048 * 256; it += ngt) { const int R = it >> 8, n0 = (it & 255) * 8, cs = R >> 10, k = R & 1023; float v[8];
#pragma unroll
          for (int j = 0; j < 8; ++j) { const int idx = (k * (n0 + j)) & 2047; v[j] = T[cs ? ((idx - 512) & 2047) : idx] * SX; }
          u32x4 o; o.x = cvtpk(v[0], v[1]); o.y = cvtpk(v[2], v[3]); o.z = cvtpk(v[4], v[5]); o.w = cvtpk(v[6], v[7]);
          *(u32x4*)(AX + (size_t)R * 2048 + n0) = o; }
      bf16_t* AC = (bf16_t*)(ws + WS_ADFTC); const float SC = 1.0f / 128.0f;
      for (int it = gt; it < 256 * 32; it += ngt) { const int R = it >> 5, n0 = (it & 31) * 8, cs = R >> 7, k = R & 127; float v[8];
#pragma unroll
          for (int j = 0; j < 8; ++j) { const int idx = (8 * k * (n0 + j)) & 2047; v[j] = T[cs ? ((idx - 512) & 2047) : idx] * SC; }
          u32x4 o; o.x = cvtpk(v[0], v[1]); o.y = cvtpk(v[2], v[3]); o.z = cvtpk(v[4], v[5]); o.w = cvtpk(v[6], v[7]);
          *(u32x4*)(AC + (size_t)R * 256 + n0) = o; } }
    { bf16_t* WH = (bf16_t*)(ws + WS_WRT); bf16_t* WL = WH + 2 * 48 * 1024;
      for (int it = gt; it < 2 * 48 * 1024; it += ngt) { const int k = it & 1023, c = (it >> 10) % 48, li = it / 49152;
          const float w = (c < 4) ? p->w_rg[(size_t)li * 4096 + k * 4 + c] : ((c < 36) ? p->w_re[(size_t)li * 32768 + k * 32 + (c - 4)] : 0.f);
          const unsigned hb = cvtpk(w, 0.f) & 0xffffu; const float lo = w - bf2f((unsigned short)hb);
          WH[it] = (bf16_t)hb; WL[it] = (bf16_t)(cvtpk(lo, 0.f) & 0xffffu); } }
    for (int rp_ = 0; rp_ < ((MK_P0REP & 2) ? 3 : 1); ++rp_) for (int task = cx.vcu; task < 256; task += cx.G) { const int li = task >> 7, g = (task >> 5) & 3, n0 = (task & 31) * 32;
        LAS float* WfT = (LAS float*)cx.lds; LAS float* Wo = (LAS float*)(cx.lds + 65536); LAS float* Gs = (LAS float*)(cx.lds + 98304); LAS float* Pp = (LAS float*)(cx.lds + 106496);
        LDS_BARRIER();
        { const float* wf = p->w_fourier + (size_t)li * 65536 + (size_t)(64 * g) * 256; const float* wo = p->w_out + (size_t)li * 1024 * 1024 + n0;
          const int l = cx.tid & 63, jb = cx.tid >> 6; f32x4 v[8];
#pragma unroll
          for (int r = 0; r < 8; ++r) v[r] = *(const f32x4*)(wf + (size_t)l * 256 + jb * 32 + 4 * r);
#pragma unroll
          for (int r = 0; r < 8; ++r)
#pragma unroll
              for (int e = 0; e < 4; ++e) WfT[(jb * 32 + 4 * r + e) * 64 + l] = v[r][e];
#pragma unroll
          for (int r = 0; r < 4; ++r) { const int pc = cx.tid + 512 * r, j = pc >> 3, q = pc & 7; *(LAS f32x4*)(Wo + j * 32 + q * 4) = *(const f32x4*)(wo + (size_t)j * 1024 + q * 4); } }
        __syncthreads();
        { const int n4 = cx.tid & 7, l4 = (cx.tid >> 3) & 15, kq = cx.tid >> 7; f32x4 acc4[4];
#pragma unroll
          for (int x = 0; x < 4; ++x) acc4[x] = (f32x4){0.f, 0.f, 0.f, 0.f};
#pragma unroll 4
          for (int j = kq * 64; j < kq * 64 + 64; ++j) { const f32x4 av = *(const LAS f32x4*)(WfT + j * 64 + l4 * 4), bv = *(const LAS f32x4*)(Wo + j * 32 + n4 * 4);
#pragma unroll
              for (int x = 0; x < 4; ++x) acc4[x] += bv * av[x]; }
#pragma unroll
          for (int x = 0; x < 4; ++x) *(LAS f32x4*)(Pp + (kq * 64 + l4 * 4 + x) * 32 + n4 * 4) = acc4[x]; }
        __syncthreads();
        { const int o4 = cx.tid * 4; const f32x4 s4 = *(const LAS f32x4*)(Pp + o4) + *(const LAS f32x4*)(Pp + 2048 + o4) + *(const LAS f32x4*)(Pp + 4096 + o4) + *(const LAS f32x4*)(Pp + 6144 + o4);
          *(LAS f32x4*)(Gs + o4) = s4;
          LAS float* Mx = WfT;
#pragma unroll
          for (int r = 0; r < 16; ++r) { const int e = cx.tid + 512 * r, cs2 = e >> 12, l2 = (e >> 6) & 63, c2 = e & 63; const int idx = (32 * l2 * c2) & 2047; Mx[e] = cs2 ? -T[(idx - 512) & 2047] : T[idx]; } }
        __syncthreads();
        { bf16_t* WOUT = (bf16_t*)(ws + WS_WOUT) + (size_t)li * 1024 * 1280; const int n = cx.tid & 31, combo = cx.tid >> 5, cs = combo >> 3, c8 = combo & 7; float a8[8];
          const LAS float* Mx = WfT + cs * 4096 + c8 * 8;
#pragma unroll
          for (int i = 0; i < 8; ++i) a8[i] = 0.f;
#pragma unroll 4
          for (int l = 0; l < 64; ++l) { const float gv = Gs[l * 32 + n]; const f32x4 m0 = *(const LAS f32x4*)(Mx + l * 64), m1 = *(const LAS f32x4*)(Mx + l * 64 + 4);
              a8[0] += m0[0] * gv; a8[1] += m0[1] * gv; a8[2] += m0[2] * gv; a8[3] += m0[3] * gv; a8[4] += m1[0] * gv; a8[5] += m1[1] * gv; a8[6] += m1[2] * gv; a8[7] += m1[3] * gv; }
          u32x4 o; o.x = cvtpk(a8[0], a8[1]); o.y = cvtpk(a8[2], a8[3]); o.z = cvtpk(a8[4], a8[5]); o.w = cvtpk(a8[6], a8[7]);
          *(u32x4*)(WOUT + (size_t)(n0 + n) * 1280 + cs * 256 + 64 * g + c8 * 8) = o; } }
    LDS_BARRIER();
    for (int rp_ = 0; rp_ < ((MK_P0REP & 4) ? 3 : 1); ++rp_) { float* MOD = (float*)(ws + WS_MOD); LAS float* sl = (LAS float*)cx.lds; LAS float* red = (LAS float*)(cx.lds + 36864);
      LDS_BARRIER();
      for (int i = cx.tid; i < 9 * 1024; i += 512) { const int r = i >> 10, k = i & 1023; const float v = (r < 8) ? p->c[r * 1024 + k] : p->c_ctx[k]; sl[i] = v / (1.f + __expf(-v)); }
      LDS_BARRIER();
      for (int u = cx.vcu; u < 192; u += cx.G) { const int li = u / 96, j0 = (u % 96) * 64, c4 = (cx.tid & 15) * 4, ksl = cx.tid >> 4; f32x4 a[9];
#pragma unroll
          for (int r = 0; r < 9; ++r) a[r] = (f32x4){0.f, 0.f, 0.f, 0.f};
          const float* wp = p->w_ada + ((size_t)li * 1024 + ksl * 32) * 6144 + j0 + c4;
#pragma unroll 1
          for (int k0 = 0; k0 < 32; k0 += 8) { f32x4 w[8];
#pragma unroll
              for (int kk = 0; kk < 8; ++kk) w[kk] = *(const f32x4*)(wp + (size_t)(k0 + kk) * 6144);
#pragma unroll
              for (int kk = 0; kk < 8; ++kk)
#pragma unroll
                  for (int r = 0; r < 9; ++r) a[r] += w[kk] * sl[r * 1024 + ksl * 32 + k0 + kk]; }
#pragma unroll
          for (int r = 0; r < 9; ++r) *(LAS f32x4*)(red + (ksl * 9 + r) * 64 + c4) = a[r];
          __syncthreads();
          for (int o = cx.tid; o < 576; o += 512) { const int r = o >> 6, cj = o & 63; float t2 = p->b_ada[li * 6144 + j0 + cj];
#pragma unroll
              for (int q = 0; q < 32; ++q) t2 += red[(q * 9 + r) * 64 + cj];
              MOD[((size_t)li * 9 + r) * 6144 + j0 + cj] = t2; }
          LDS_BARRIER(); } }
    for (int rp_ = 0; rp_ < ((MK_P0REP & 8) ? 3 : 1); ++rp_) { bf16_t* WIN = (bf16_t*)(ws + WS_WIN); bf16_t* WOUT = (bf16_t*)(ws + WS_WOUT);
      constexpr int I0 = 2 * 1280, I1 = 2 * 384;
      for (int it = cx.gw; it < I0 + I1; it += cx.ngw) { int r = it;
          if (r < I0) { const int li = r / 1280, q = r % 1280, kb = q / 80, nb = q % 80;
              tr_item(p->w_in + (size_t)li * 1024 * 2560, 2560, kb * 64, nb * 32, WIN + (size_t)li * 2560 * 1024, 1024, kb * 64, 0, scr, cx.lane); continue; } r -= I0;
          { const int li = r / 384, q = r % 384, kb = q / 32, nb = q % 32;
              tr_item(p->w_out + (size_t)li * 1024 * 1024, 1024, 256 + kb * 64, nb * 32, WOUT + (size_t)li * 1024 * 1280, 1280, 512 + kb * 64, 1, scr, cx.lane); } } }
}
constexpr int BG_PER_LAYER = 24576, BG_ALL = 2 * BG_PER_LAYER, BG_STEP = 32;
__device__ __forceinline__ void bg_item(CP* p, int x, LAS float* scr, int lane) {
    unsigned char* ws = p->ws; bf16_t* WGU = (bf16_t*)(ws + WS_WGU); bf16_t* WDN = (bf16_t*)(ws + WS_WD);
    const int li = x / BG_PER_LAYER, y = x % BG_PER_LAYER, type = y >> 13, r = y & 8191, le = li * 32 + (r >> 8), q = r & 255;
    if (type == 0) { const int kb = q >> 4, nb = q & 15; tr_item(p->w_gate + (size_t)le * 1024 * 512, 512, kb * 64, nb * 32, WGU + (size_t)le * 1024 * 1024, 1024, kb * 64, 2, scr, lane); }
    else if (type == 1) { const int kb = q >> 4, nb = q & 15; tr_item(p->w_up + (size_t)le * 1024 * 512, 512, kb * 64, nb * 32, WGU + (size_t)le * 1024 * 1024, 1024, kb * 64, 3, scr, lane); }
    else { const int kb = q >> 5, nb = q & 31; tr_item(p->w_down + (size_t)le * 512 * 1024, 1024, kb * 64, nb * 32, WDN + (size_t)le * 1024 * 512, 512, kb * 64, 4, scr, lane); }
}
__device__ __forceinline__ bool bg_step(CP* p, const Ctx& cx, int limit, int nclaim) {
    volatile LAS int* sel = (volatile LAS int*)(cx.lds + MISC_OFF + 40);
    __syncthreads();
    if (cx.tid == 0) { unsigned* hq = (unsigned*)(p->ws + WS_CTL) + CW_BGQ; int h = BG_ALL; if ((int)xb_ld(hq) < limit) h = (int)xb_add(hq, (unsigned)nclaim); sel[0] = h; }
    __syncthreads();
    const int h = __builtin_amdgcn_readfirstlane(sel[0]);
    if (h >= BG_ALL) return false;
    LAS float* scr = (LAS float*)(cx.lds + cx.wave * 8448);
#pragma unroll 1
    for (int k = 0; k < nclaim / 8; ++k) { const int x = h + cx.wave + 8 * k; if (x < BG_ALL) bg_item(p, x, scr, cx.lane); }
    return h < limit;
}
__device__ __forceinline__ void bg_idle(CP* p, const Ctx& cx, int ph) {
    unsigned* dn = (unsigned*)(p->ws + WS_CTL) + CW_DONE + 64 * ph; volatile LAS int* sel = (volatile LAS int*)(cx.lds + MISC_OFF + 40);
    __syncthreads();
    if (cx.tid == 0) (void)xb_add(dn, 1u);
    for (;;) {
        __syncthreads();
        if (cx.tid == 0) sel[1] = ((int)xb_ld(dn) < cx.G) ? 1 : 0;
        __syncthreads();
        if (!__builtin_amdgcn_readfirstlane(sel[1])) break;
        if (!bg_step(p, cx, BG_ALL, BG_STEP)) break;
    }
}
__device__ __forceinline__ void bg_drain(CP* p, const Ctx& cx, int limit) { while (bg_step(p, cx, limit, 8 * BG_STEP)) { } }
__device__ __forceinline__ void phase_norm1(CP* p0, const Ctx& cx0, int li) {
    const Ctx cx = reopaque(cx0); CP* p = opaque_args(p0);
    unsigned char* ws = p->ws; bf16_t* X1 = (bf16_t*)(ws + WS_X1); const bf16_t* Y2 = (const bf16_t*)(ws + WS_Y2); bf16_t* H1 = (bf16_t*)(ws + WS_H1);
    const float* MOD = (const float*)(ws + WS_MOD) + (size_t)li * 9 * 6144; const float* n1 = p->norm1 + li * 1024;
    for (int m = cx.gw; m < MT; m += cx.ngw) {
        f32x4 v[4];
        if (li == 0) { const float* src = (m < NX) ? p->x + (size_t)m * D : p->ctx + (size_t)(m - NX) * D;
#pragma unroll
            for (int j = 0; j < 4; ++j) v[j] = *(const f32x4*)(src + 256 * j + 4 * cx.lane); }
        else { bf16_t* xr = X1 + (size_t)m * D; const bf16_t* ya = Y2 + (size_t)m * 2 * D; const float* g2 = MOD - 9 * 6144 + ((m < NX) ? (m >> 11) : 8) * 6144 + 5 * D;
#pragma unroll
            for (int j = 0; j < 4; ++j) { const int k = 256 * j + 4 * cx.lane; v[j] = ld_bf4(xr + k) + *(const f32x4*)(g2 + k) * (ld_bf4(ya + k) + ld_bf4(ya + D + k));
                u32x2 w; w.x = cvtpk(v[j][0], v[j][1]); w.y = cvtpk(v[j][2], v[j][3]); *(u32x2*)(xr + k) = w; } }
        float ss = 0.f;
#pragma unroll
        for (int j = 0; j < 4; ++j) ss += v[j][0] * v[j][0] + v[j][1] * v[j][1] + v[j][2] * v[j][2] + v[j][3] * v[j][3];
        const float r = 1.0f / sqrtf(wave_sum(ss) * (1.0f / D) + 1e-6f);
        const int rr = (m < NX) ? (m >> 11) : 8; const float* sh = MOD + rr * 6144; const float* sc = sh + D;
#pragma unroll
        for (int j = 0; j < 4; ++j) { const int k = 256 * j + 4 * cx.lane; const f32x4 g = *(const f32x4*)(n1 + k), s1 = *(const f32x4*)(sc + k), h1 = *(const f32x4*)(sh + k);
            const f32x4 o = v[j] * r * g * (s1 + 1.0f) + h1; u32x2 w; w.x = cvtpk(o[0], o[1]); w.y = cvtpk(o[2], o[3]);
            *(u32x2*)(H1 + (size_t)m * D + k) = w; }
    }
}
__device__ __forceinline__ void phase_inproj(CP* p0, const Ctx& cx0, int li, int ph) {
    const Ctx cx = reopaque(cx0); CP* p = opaque_args(p0);
    unsigned char* ws = p->ws; const bf16_t* H1 = (const bf16_t*)(ws + WS_H1); const bf16_t* WIN = (const bf16_t*)(ws + WS_WIN) + (size_t)li * 2560 * 1024;
    pg8::SchedInproj S; S.R.init(H1, WIN + (size_t)768 * 1024, MT, NU, D, cx.G, (int)blockIdx.x); S.G = cx.G; S.c = (int)blockIdx.x; S.A1 = (const char*)WIN; S.B1 = (const char*)H1;
    pg8::EpiInproj E{(bf16_t*)(ws + WS_U), (bf16_t*)(ws + WS_FTX), (bf16_t*)(ws + WS_FTC), (bf16_t*)(ws + WS_VTX), (bf16_t*)(ws + WS_VTC)};
    pg8::gemm_phase<pg8::EpiInproj, pg8::SchedInproj, false, true, D>(cx.lds, S, E);
    (void)ph;
}
struct AttnPtrs { const bf16_t* U; const bf16_t* vtx; const bf16_t* vtc; bf16_t* conc; };
__device__ __forceinline__ void attn_dma_step(const AttnPtrs& a, int t, int b, int h, int krlo, int wave, int lane, LAS unsigned char* slot) {
    const bf16_t* kp; const bf16_t* vp; size_t vpitch;
    if (t < 4) { kp = a.U + (size_t)(NX + b * 256 + 64 * t) * NU + 512 + h * 64; vp = a.vtc + ((size_t)b * 512 + h * 64) * 256 + 64 * t; vpitch = 256; }
    else { const int t0 = 64 * (krlo + t - 4); kp = a.U + (size_t)(b * 2048 + t0) * NU + 512 + h * 64; vp = a.vtx + ((size_t)b * 512 + h * 64) * 2048 + t0; vpitch = 2048; }
    const int r = 8 * wave + (lane >> 3);
    __builtin_amdgcn_global_load_lds((const unsigned*)(kp + (size_t)r * NU + 8 * ((lane & 7) ^ (r & 7))), (LAS unsigned*)(slot + wave * 1024), 16, 0, 0);
    __builtin_amdgcn_global_load_lds((const unsigned*)(vp + (size_t)r * vpitch + 8 * ((lane & 7) ^ ((r >> 1) & 7))), (LAS unsigned*)(slot + 8192 + wave * 1024), 16, 0, 0);
}
__device__ __forceinline__ void attn_frags(const LAS unsigned char* sl, int kb0, int lane, bf16x8 (&kf)[4], bf16x8 (&vf)[4]) {
    const int q = lane & 31, hh = lane >> 5, key = kb0 + q;
#pragma unroll
    for (int s = 0; s < 4; ++s) kf[s] = *(const LAS bf16x8*)(sl + key * 128 + (((2 * s + hh) ^ (key & 7)) << 4));
#pragma unroll
    for (int s2 = 0; s2 < 2; ++s2)
#pragma unroll
        for (int dh = 0; dh < 2; ++dh) { const int d = 32 * dh + q, fd = (d >> 1) & 7, ch = (kb0 >> 3) + 2 * s2;
            const bf16x4 lo = *(const LAS bf16x4*)(sl + 8192 + d * 128 + ((ch ^ fd) << 4) + (hh << 3)), hi = *(const LAS bf16x4*)(sl + 8192 + d * 128 + (((ch + 1) ^ fd) << 4) + (hh << 3));
            vf[s2 * 2 + dh] = (bf16x8){lo[0], lo[1], lo[2], lo[3], hi[0], hi[1], hi[2], hi[3]}; }
}
#define ATT_COMPUTE(loc_, kr_, kf_, vf_) do { \
    f32x16 s_; \
    if (loc_) { const bool rok_ = ((kr_) >= rsq) && ((kr_) < rsq + 8); int ro_ = (kr_) - rq + 7; ro_ = ro_ < 0 ? 0 : (ro_ > 14 ? 14 : ro_); \
        const LAS float* bp_ = tblh + ro_ * 64 + cbase; const float rp_ = rok_ ? 0.f : -1e30f; \
        _Pragma("unroll") for (int i_ = 0; i_ < 16; ++i_) s_[i_] = bp_[(i_ & 3) + 8 * (i_ >> 2)] + colpen[i_] + rp_; } \
    else { _Pragma("unroll") for (int i_ = 0; i_ < 16; ++i_) s_[i_] = 0.f; } \
    _Pragma("unroll") for (int k_ = 0; k_ < 4; ++k_) s_ = __builtin_amdgcn_mfma_f32_32x32x16_bf16(kf_[k_], qf[k_], s_, 0, 0, 0); \
    float cm_ = s_[0]; \
    _Pragma("unroll") for (int i_ = 1; i_ < 16; ++i_) cm_ = fmaxf(cm_, s_[i_]); \
    if (__any(cm_ > mrun + 8.0f)) {     \
        cm_ = fmaxf(cm_, __shfl_xor(cm_, 32)); \
        const float mn_ = fmaxf(mrun, cm_); const float al_ = __builtin_amdgcn_exp2f(mrun - mn_); mrun = mn_; lsum *= al_; \
        _Pragma("unroll") for (int i_ = 0; i_ < 16; ++i_) { o0[i_] *= al_; o1[i_] *= al_; } } \
    float ps_ = 0.f; \
    _Pragma("unroll") for (int i_ = 0; i_ < 16; ++i_) { s_[i_] = __builtin_amdgcn_exp2f(s_[i_] - mrun); ps_ += s_[i_]; } \
    lsum += ps_; \
    bf16x8 p0_, p1_; { u32x4 w_; w_.x = cvtpk(s_[0], s_[1]); w_.y = cvtpk(s_[2], s_[3]); w_.z = cvtpk(s_[4], s_[5]); w_.w = cvtpk(s_[6], s_[7]); p0_ = __builtin_bit_cast(bf16x8, w_); \
        w_.x = cvtpk(s_[8], s_[9]); w_.y = cvtpk(s_[10], s_[11]); w_.z = cvtpk(s_[12], s_[13]); w_.w = cvtpk(s_[14], s_[15]); p1_ = __builtin_bit_cast(bf16x8, w_); } \
    o0 = __builtin_amdgcn_mfma_f32_32x32x16_bf16(vf_[0], p0_, o0, 0, 0, 0); o1 = __builtin_amdgcn_mfma_f32_32x32x16_bf16(vf_[1], p0_, o1, 0, 0, 0); \
    o0 = __builtin_amdgcn_mfma_f32_32x32x16_bf16(vf_[2], p1_, o0, 0, 0, 0); o1 = __builtin_amdgcn_mfma_f32_32x32x16_bf16(vf_[3], p1_, o1, 0, 0, 0); \
} while (0)

__device__ __forceinline__ void attn_group(const AttnPtrs& a, const LAS float* tbl, LAS unsigned char* ring, int qi, int gid, int wave, int lane) {
    const int q = lane & 31, hh = lane >> 5;
    int b, h, nsteps, krlo = 0, kr0 = 0, nl = 0, bs = 0, rq = 0, rsq = 0, cq = 0, csq = 0; size_t qrow;
    if (gid < 64) { const int pair = qi * 8 + (gid >> 3), g4 = gid & 7, rp = 2 * g4 + (wave >> 2), cb = wave & 3; b = pair >> 3; h = pair & 7;
        rq = 2 * rp + (q >> 4); cq = 16 * cb + (q & 15);
        rsq = rq - 4; rsq = rsq < 0 ? 0 : (rsq > 24 ? 24 : rsq); csq = cq - 8; csq = csq < 0 ? 0 : (csq > 48 ? 48 : csq);
        kr0 = 2 * rp - 4; kr0 = kr0 < 0 ? 0 : (kr0 > 24 ? 24 : kr0); int kr1 = 2 * rp + 1 - 4; kr1 = kr1 < 0 ? 0 : (kr1 > 24 ? 24 : kr1); nl = kr1 + 8 - kr0;
        krlo = 4 * g4 - 4; krlo = krlo < 0 ? 0 : (krlo > 24 ? 24 : krlo); int krhi = 4 * g4 + 3 - 4; krhi = krhi < 0 ? 0 : (krhi > 24 ? 24 : krhi); nsteps = 4 + (krhi + 8 - krlo);
        bs = (cb == 0) ? 0 : (cb == 1 ? 8 : (cb == 2 ? 24 : 32));
        qrow = (size_t)b * 2048 + 64 * rq + cq; }
    else { const int pair = qi * 8 + (gid - 64); b = pair >> 3; h = pair & 7; nsteps = 4; qrow = (size_t)NX + b * 256 + 32 * wave + q; }
    bf16x8 qf[4];
#pragma unroll
    for (int s = 0; s < 4; ++s) qf[s] = *(const bf16x8*)(a.U + qrow * NU + h * 64 + 16 * s + 8 * hh);
    attn_dma_step(a, 0, b, h, krlo, wave, lane, ring);
    attn_dma_step(a, 1, b, h, krlo, wave, lane, ring + 16384);
    asm volatile("s_waitcnt vmcnt(4)" : "+v"(qf[0]), "+v"(qf[1]), "+v"(qf[2]), "+v"(qf[3]) :: "memory");
    float colpen[16];
#pragma unroll
    for (int i = 0; i < 16; ++i) { const int kc = bs + (i & 3) + 8 * (i >> 2) + 4 * hh; colpen[i] = (kc >= csq && kc < csq + 16) ? 0.f : -1e30f; }
    const LAS float* tblh = tbl + h * (15 * 64); const int cbase = bs - cq + 15 + 16 + 4 * hh;
    f32x16 o0, o1;
#pragma unroll
    for (int i = 0; i < 16; ++i) { o0[i] = 0.f; o1[i] = 0.f; }
    float mrun = -1e30f, lsum = 0.f;
    bf16x8 kf[4], vf[4];
    int slot_t = 0, slot_n = 2;
#pragma unroll 1
    for (int t = 0; t < nsteps; ++t) {
        if (t + 1 < nsteps) asm volatile("s_waitcnt vmcnt(2)" ::: "memory"); else asm volatile("s_waitcnt vmcnt(0)" ::: "memory");
        __builtin_amdgcn_s_barrier();
        if (t + 2 < nsteps) attn_dma_step(a, t + 2, b, h, krlo, wave, lane, ring + slot_n * 16384);
        const LAS unsigned char* sl = ring + slot_t * 16384;
        const bool loc = (t >= 4); const int kr = krlo + t - 4;
        const int nsub = loc ? ((kr >= kr0 && kr < kr0 + nl) ? 1 : 0) : 2;
#pragma unroll 1
        for (int sub = 0; sub < nsub; ++sub) {
            attn_frags(sl, loc ? bs : 32 * sub, lane, kf, vf); asm volatile("s_waitcnt lgkmcnt(0)" ::: "memory"); __builtin_amdgcn_sched_barrier(0);
            ATT_COMPUTE(loc, kr, kf, vf); }
        slot_t = (slot_t == 2) ? 0 : slot_t + 1; slot_n = (slot_n == 2) ? 0 : slot_n + 1;
    }
    const float inv = 1.0f / (lsum + __shfl_xor(lsum, 32));
    bf16_t* op = a.conc + qrow * KO + 512 + h * 64 + 4 * hh;
#pragma unroll
    for (int g = 0; g < 4; ++g) { u32x2 w; w.x = cvtpk(o0[4 * g] * inv, o0[4 * g + 1] * inv); w.y = cvtpk(o0[4 * g + 2] * inv, o0[4 * g + 3] * inv); *(u32x2*)(op + 8 * g) = w;
        w.x = cvtpk(o1[4 * g] * inv, o1[4 * g + 1] * inv); w.y = cvtpk(o1[4 * g + 2] * inv, o1[4 * g + 3] * inv); *(u32x2*)(op + 32 + 8 * g) = w; }
}
__device__ __forceinline__ void phase_mix(CP* p0, const Ctx& cx0, int li, int rep, int ph) {
    const Ctx cx = reopaque(cx0); CP* p = opaque_args(p0);
    unsigned char* ws = p->ws; const bf16_t* U = (const bf16_t*)(ws + WS_U); bf16_t* CONC = (bf16_t*)(ws + WS_CONC);
    const int nrows = (li == 0) ? MT : NX;
    for (int rp_ = 0; rp_ < ((MK_MIXREP & 4) ? 3 : 1); ++rp_) if (!(MK_SUB & 16)) { const float* wc = p->w_conv + li * 768;
      for (int it = cx.vcu * 512 + cx.tid; it < nrows * 32; it += cx.G * 512) { const int m = it >> 5, c0 = (it & 31) * 8;
          const int pos = (m < NX) ? (m & 2047) : ((m - NX) & 255), len = (m < NX) ? 2048 : 256;
          const bf16_t* up = U + (size_t)m * NU; float z[3][8];
#pragma unroll
          for (int d = 0; d < 3; ++d) { const bool ok = (pos + d - 1 >= 0) && (pos + d - 1 < len);
              if (ok) { const u32x4 a = *(const u32x4*)(up + (ptrdiff_t)(d - 1) * NU + 1280 + c0), b = *(const u32x4*)(up + (ptrdiff_t)(d - 1) * NU + 1536 + c0);
                  z[d][0] = bflo(a.x) * bflo(b.x); z[d][1] = bfhi(a.x) * bfhi(b.x); z[d][2] = bflo(a.y) * bflo(b.y); z[d][3] = bfhi(a.y) * bfhi(b.y);
                  z[d][4] = bflo(a.z) * bflo(b.z); z[d][5] = bfhi(a.z) * bfhi(b.z); z[d][6] = bflo(a.w) * bflo(b.w); z[d][7] = bfhi(a.w) * bfhi(b.w); }
              else {
#pragma unroll
                  for (int j = 0; j < 8; ++j) z[d][j] = 0.f; } }
          const u32x4 g = *(const u32x4*)(up + 1024 + c0); float gb[8] = {bflo(g.x), bfhi(g.x), bflo(g.y), bfhi(g.y), bflo(g.z), bfhi(g.z), bflo(g.w), bfhi(g.w)}; float o[8];
#pragma unroll
          for (int j = 0; j < 8; ++j) o[j] = gb[j] * (wc[c0 + j] * z[0][j] + wc[256 + c0 + j] * z[1][j] + wc[512 + c0 + j] * z[2][j]);
          u32x4 w; w.x = cvtpk(o[0], o[1]); w.y = cvtpk(o[2], o[3]); w.z = cvtpk(o[4], o[5]); w.w = cvtpk(o[6], o[7]);
          *(u32x4*)(CONC + (size_t)m * KO + 1024 + c0) = w; } }
    { const bf16_t* FTX = (const bf16_t*)(ws + WS_FTX); const bf16_t* FTC = (const bf16_t*)(ws + WS_FTC); const int ntask = (li == 0) ? 512 : 256;
      for (int tk = cx.gw; tk < ntask; tk += cx.ngw) { const bool cxm = tk >= 256; const int b = (tk & 255) >> 5, ch0 = (tk & 31) * 8; float sm[8];
#pragma unroll
          for (int c = 0; c < 8; ++c) { float a = 0.f;
              if (!cxm) { const bf16_t* fp = FTX + ((size_t)(b * 256 + ch0 + c)) * 2048 + 8 * cx.lane;
#pragma unroll
                  for (int q = 0; q < 4; ++q) { const u32x4 v = *(const u32x4*)(fp + 512 * q); a += (bflo(v.x) - bfhi(v.x)) + (bflo(v.y) - bfhi(v.y)) + (bflo(v.z) - bfhi(v.z)) + (bflo(v.w) - bfhi(v.w)); } }
              else { const u32x2 v = *(const u32x2*)(FTC + ((size_t)(b * 256 + ch0 + c)) * 256 + 4 * cx.lane); a = (bflo(v.x) - bfhi(v.x)) + (bflo(v.y) - bfhi(v.y)); }
              sm[c] = wave_sum(a) * (cxm ? (1.0f / 128.0f) : 0.0027621358640099513f); }
          if (cx.lane == 0) { bf16_t* dst = CONC + (cxm ? ((size_t)NX + b * 256 + 128) : ((size_t)b * 2048 + 1024)) * KO + ch0;
              u32x4 w; w.x = cvtpk(sm[0], sm[1]); w.y = cvtpk(sm[2], sm[3]); w.z = cvtpk(sm[4], sm[5]); w.w = cvtpk(sm[6], sm[7]);
              *(u32x4*)dst = w; *(u32x4*)(dst + 256) = (u32x4){0u, 0u, 0u, 0u}; } } }
    for (int rp_ = 0; rp_ < ((MK_MIXREP & 1) ? 3 : 1); ++rp_) if (!(MK_SUB & 4)) { const int c = (int)blockIdx.x;
      pg8::SchedOne S; int Kd = 2048; pg8::EpiDft E{CONC, 0};
      if (c < 64) { S.has = true; S.u0.pm = c >> 3; S.u0.pn = c & 7; S.u0.aux = 0;
          S.u0.A = (const char*)(ws + WS_ADFTX) + (size_t)(c >> 3) * 256 * 2048 * 2; S.u0.B = (const char*)(ws + WS_FTX) + (size_t)(c & 7) * 256 * 2048 * 2; }
      else { const int c2 = c - 64; S.has = (li == 0 && c2 < 8); S.u0.pm = 0; S.u0.pn = c2 & 7; S.u0.aux = 0; Kd = 256; E.conc = CONC + (size_t)NX * KO; E.ctxmode = 1;
          S.u0.A = (const char*)(ws + WS_ADFTC); S.u0.B = (const char*)(ws + WS_FTC) + (size_t)(c2 & 7) * 256 * 256 * 2; }
      pg8::gemm_phase<pg8::EpiDft, pg8::SchedOne, false, false, 0>(cx.lds, S, E, Kd); }
    for (int rp_ = 0; rp_ < ((MK_MIXREP & 2) ? 3 : 1); ++rp_) if (!(MK_SUB & 8)) { LAS float* tbl = (LAS float*)(cx.lds + MISC_OFF + 64);
      __syncthreads();
      for (int i = cx.tid; i < 8 * 15 * 64; i += 512) { const int col = (i & 63) - 16, ro = (i >> 6) % 15, h = i / 960;
          tbl[i] = (col >= 0 && col <= 30) ? p->rpb[(size_t)li * 3720 + h * 465 + ro * 31 + col] * LOG2E : 0.f; }
      __syncthreads();
      AttnPtrs a{U, (const bf16_t*)(ws + WS_VTX), (const bf16_t*)(ws + WS_VTC), CONC};
      unsigned* qw = (unsigned*)(ws + WS_CTL) + CW_ATTQ + li * 512 + rep * 1024 + rp_ * 1024;
      volatile LAS int* gsel = (volatile LAS int*)(cx.lds + MISC_OFF + 32);
      const int nper = (li == 0) ? 72 : 64; const int q0 = (int)(xb_xcc_id() & 7u);
      for (int qq = 0; qq < 8; ++qq) { const int qi = (q0 + qq) & 7;
          for (;;) {
              __syncthreads();
              if (cx.tid == 0) { int g = nper; if ((int)xb_ld(qw + qi * 64) < nper) g = (int)xb_add(qw + qi * 64, 1u); gsel[0] = g; }
              __syncthreads();
              const int gid = __builtin_amdgcn_readfirstlane(gsel[0]);
              if (gid >= nper) break;
              attn_group(a, tbl, cx.lds, qi, gid, cx.wave, cx.lane); } } }
    (void)ph;
}
__device__ __forceinline__ void phase_outproj(CP* p0, const Ctx& cx0, int li, int ph) {
    const Ctx cx = reopaque(cx0); CP* p = opaque_args(p0);
    unsigned char* ws = p->ws;
    pg8::SchedRect S; S.init(ws + WS_CONC, (const bf16_t*)(ws + WS_WOUT) + (size_t)li * 1024 * 1280, (li == 0) ? MT : NX, D, KO, cx.G, (int)blockIdx.x);
    pg8::EpiOut E{(bf16_t*)(ws + WS_X1), (li == 0) ? p->x : nullptr, (li == 0) ? p->ctx : nullptr, (const float*)(ws + WS_MOD) + (size_t)li * 9 * 6144};
    pg8::gemm_phase<pg8::EpiOut, pg8::SchedRect, false, true, KO>(cx.lds, S, E);
    bg_idle(p, cx, ph);
}
__device__ __forceinline__ void phase_router(CP* p0, const Ctx& cx0, int li, int dummy) {
    const Ctx cx = reopaque(cx0); CP* p = opaque_args(p0);
    unsigned char* ws = p->ws; const bf16_t* X1 = (const bf16_t*)(ws + WS_X1); bf16_t* TT = (bf16_t*)(ws + WS_H1);
    const float* MOD = (const float*)(ws + WS_MOD) + (size_t)li * 9 * 6144; const float* n2 = p->norm2 + li * 1024;
    const bf16_t* WH = (const bf16_t*)(ws + WS_WRT) + (size_t)li * 48 * 1024; const bf16_t* WL = WH + 2 * 48 * 1024;
    const int M = (li == 0) ? MT : NX; const int RB = (M + cx.G - 1) / cx.G;
    const int RPW = (RB + 7) >> 3;
    const int row0 = cx.vcu * RB;
    LAS float* lg = (LAS float*)cx.lds;
    LAS int* lcnt = (LAS int*)(cx.lds + 12288); LAS int* lbase = (LAS int*)(cx.lds + 12544);
    LAS unsigned char* wb = cx.lds + 16384;
    LAS unsigned char* wa = cx.lds + 16384 + 2 * 48 * 528 + cx.wave * (2 * 9 * 528);
    __syncthreads();
    if (cx.tid < 32) lcnt[cx.tid] = 0;
    u32x4 wreg[6];
#define RT_WLOAD(ii) do { _Pragma("unroll") for (int r_ = 0; r_ < 6; ++r_) { const int p_ = cx.tid + 512 * r_, hl_ = p_ / 1536, q_ = p_ % 1536, c_ = q_ >> 5, k16_ = q_ & 31; \
        wreg[r_] = *(const u32x4*)((hl_ ? WL : WH) + (size_t)c_ * 1024 + 256 * (ii) + 8 * k16_); } } while (0)
#define RT_WSTORE() do { _Pragma("unroll") for (int r_ = 0; r_ < 6; ++r_) { const int p_ = cx.tid + 512 * r_, hl_ = p_ / 1536, q_ = p_ % 1536, c_ = q_ >> 5, k16_ = q_ & 31; \
        *(LAS u32x4*)(wb + hl_ * (48 * 528) + c_ * 528 + 16 * k16_) = wreg[r_]; } } while (0)
    RT_WLOAD(0);
    float rinv[9];
#pragma unroll
    for (int j = 0; j < 9; ++j) { const int rl = cx.wave * RPW + j; int m = row0 + rl; const bool ok = (j < RPW) && (rl < RB) && (m < M); if (!ok) m = row0 < M ? row0 : 0;
        const bf16_t* xr = X1 + (size_t)m * D; float ss = 0.f;
#pragma unroll
        for (int i = 0; i < 4; ++i) { const f32x4 v = ld_bf4(xr + 256 * i + 4 * cx.lane); ss += v[0] * v[0] + v[1] * v[1] + v[2] * v[2] + v[3] * v[3]; }
        rinv[j] = 1.0f / sqrtf(wave_sum(ss) * (1.0f / D) + 1e-6f); }
    f32x4 acc[3];
#pragma unroll
    for (int nt = 0; nt < 3; ++nt) acc[nt] = (f32x4){0.f, 0.f, 0.f, 0.f};
    const int col = cx.lane & 15, kq = cx.lane >> 4, rA = (col < 9) ? col : 8;
#pragma unroll 1
    for (int i = 0; i < 4; ++i) {
        if (i > 0) __syncthreads();
        RT_WSTORE();
        if (i < 3) RT_WLOAD(i + 1);
        const int k = 256 * i + 4 * cx.lane; const f32x4 g = *(const f32x4*)(n2 + k);
#pragma unroll
        for (int j = 0; j < 9; ++j) { const int rl = cx.wave * RPW + j; int m = row0 + rl; const bool ok = (j < RPW) && (rl < RB) && (m < M); if (!ok) m = row0 < M ? row0 : 0;
            const int rr = (m < NX) ? (m >> 11) : 8; const float* sh = MOD + rr * 6144 + 3 * D; const float* sc = sh + D;
            const f32x4 v = ld_bf4(X1 + (size_t)m * D + k), s1 = *(const f32x4*)(sc + k), h1 = *(const f32x4*)(sh + k);
            const f32x4 t = v * rinv[j] * g * (s1 + 1.0f) + h1;
            u32x2 h, l; h.x = cvtpk(t[0], t[1]); h.y = cvtpk(t[2], t[3]);
            if (ok) *(u32x2*)(TT + (size_t)m * D + k) = h;
            l.x = cvtpk(t[0] - bflo(h.x), t[1] - bfhi(h.x)); l.y = cvtpk(t[2] - bflo(h.y), t[3] - bfhi(h.y));
            *(LAS u32x2*)(wa + j * 528 + 8 * cx.lane) = h; *(LAS u32x2*)(wa + (9 + j) * 528 + 8 * cx.lane) = l; }
        __syncthreads();
#pragma unroll
        for (int ks = 0; ks < 8; ++ks) { const bf16x8 ah = *(const LAS bf16x8*)(wa + rA * 528 + (32 * ks + 8 * kq) * 2), al = *(const LAS bf16x8*)(wa + (9 + rA) * 528 + (32 * ks + 8 * kq) * 2);
#pragma unroll
            for (int nt = 0; nt < 3; ++nt) { const int wo = (16 * nt + col) * 528 + (32 * ks + 8 * kq) * 2;
                const bf16x8 bh = *(const LAS bf16x8*)(wb + wo), bl = *(const LAS bf16x8*)(wb + 48 * 528 + wo);
                acc[nt] = __builtin_amdgcn_mfma_f32_16x16x32_bf16(ah, bh, acc[nt], 0, 0, 0);
                acc[nt] = __builtin_amdgcn_mfma_f32_16x16x32_bf16(ah, bl, acc[nt], 0, 0, 0);
                acc[nt] = __builtin_amdgcn_mfma_f32_16x16x32_bf16(al, bh, acc[nt], 0, 0, 0); } }
    }
#undef RT_WLOAD
#undef RT_WSTORE
#pragma unroll
    for (int nt = 0; nt < 3; ++nt)
#pragma unroll
        for (int r = 0; r < 4; ++r) { const int row = kq * 4 + r, c = 16 * nt + col; if (row < RPW && c < 36 && cx.wave * RPW + row < 72) lg[(cx.wave * RPW + row) * 36 + c] = acc[nt][r]; }
    __syncthreads();
    int e0 = 0, e1 = 0, lr0 = 0, lr1 = 0; float w0 = 0.f, w1 = 0.f; const bool act = (cx.tid < RB) && (row0 + cx.tid < M) && (cx.tid < 72);
    if (act) { const LAS float* l = lg + cx.tid * 36; float gl[4];
#pragma unroll
        for (int i = 0; i < 4; ++i) gl[i] = l[i] + p->b_rg[li * 4 + i];
        int gi = 0; float gm = gl[0];
#pragma unroll
        for (int i = 1; i < 4; ++i) if (gl[i] > gm) { gm = gl[i]; gi = i; }
        float gs = 0.f;
#pragma unroll
        for (int i = 0; i < 4; ++i) gs += __expf(gl[i] - gm);
        const float gw = 1.0f / gs;
        float ev[8];
#pragma unroll
        for (int i = 0; i < 8; ++i) ev[i] = l[4 + gi * 8 + i] + p->b_re[li * 32 + gi * 8 + i];
        int i0 = 0; float v0 = ev[0];
#pragma unroll
        for (int i = 1; i < 8; ++i) if (ev[i] > v0) { v0 = ev[i]; i0 = i; }
        int i1 = -1; float v1 = 0.f;
#pragma unroll
        for (int i = 0; i < 8; ++i) if (i != i0 && (i1 < 0 || ev[i] > v1)) { v1 = ev[i]; i1 = i; }
        const float ex = __expf(v1 - v0); w0 = gw / (1.f + ex); w1 = gw * ex / (1.f + ex);
        e0 = gi * 8 + i0; e1 = gi * 8 + i1;
        lr0 = __hip_atomic_fetch_add(&lcnt[e0], 1, __ATOMIC_RELAXED, __HIP_MEMORY_SCOPE_WORKGROUP); lr1 = __hip_atomic_fetch_add(&lcnt[e1], 1, __ATOMIC_RELAXED, __HIP_MEMORY_SCOPE_WORKGROUP); }
    __syncthreads();
    if (cx.tid < 32) { const int n = lcnt[cx.tid]; int base = 0; if (n > 0) base = (int)xb_add((unsigned*)(ws + WS_CTL) + CW_CNT + li * 2048 + cx.tid * 64 + dummy * 4096, (unsigned)n); lbase[cx.tid] = base; }
    __syncthreads();
    if (act) { const int tok = row0 + cx.tid; int* RL = (int*)(ws + (dummy ? WS_END : WS_ROWLIST)); float* TW = (float*)(ws + (dummy ? WS_END + 3 * MiB : WS_ROUTE));
        RL[(size_t)e0 * MT + lbase[e0] + lr0] = tok * 2; RL[(size_t)e1 * MT + lbase[e1] + lr1] = tok * 2 + 1;
        TW[tok * 2] = w0; TW[tok * 2 + 1] = w1; }
    if (!dummy) bg_drain(p, cx, (li == 0) ? BG_PER_LAYER : BG_ALL);
}
__device__ __forceinline__ void moe_tables(CP* p, const Ctx& cx, int li, int& ntiles) {
    LAS int* tcnt = (LAS int*)(cx.lds + MISC_OFF + MO_TCNT); LAS int* tbase = (LAS int*)(cx.lds + MISC_OFF + MO_TBASE);
    __syncthreads();
    if (cx.tid < 32) tcnt[cx.tid] = (int)__hip_atomic_load((unsigned*)(p->ws + WS_CTL) + CW_CNT + li * 2048 + cx.tid * 64, __ATOMIC_RELAXED, __HIP_MEMORY_SCOPE_AGENT);
    __syncthreads();
    if (cx.tid == 0) { int a = 0; for (int e = 0; e < 32; ++e) { tbase[e] = a; a += (tcnt[e] + 255) >> 8; } tbase[32] = a; }
    __syncthreads();
    ntiles = __builtin_amdgcn_readfirstlane(tbase[32]);
}
__device__ __forceinline__ void phase_moe_up(CP* p0, const Ctx& cx0, int li, int ph) {
    const Ctx cx = reopaque(cx0); CP* p = opaque_args(p0);
    unsigned char* ws = p->ws; int ntiles; moe_tables(p, cx, li, ntiles);
    LAS int* tcnt = (LAS int*)(cx.lds + MISC_OFF + MO_TCNT); LAS int* tbase = (LAS int*)(cx.lds + MISC_OFF + MO_TBASE); LAS int* idx = (LAS int*)(cx.lds + MISC_OFF + MO_IDX);
    const int* RL = (const int*)(ws + WS_ROWLIST);
    for (int i = 0; i < 3; ++i) { const int L = i * cx.G + cx.vcu, T = L >> 2;
        if (T < ntiles && cx.tid < 256) { int e = 0; for (int j = 1; j < 32; ++j) e += (tbase[j] <= T) ? 1 : 0;
            const int j = (T - tbase[e]) * 256 + cx.tid; const int ts = RL[(size_t)e * MT + (j < tcnt[e] ? j : 0)]; idx[i * 256 + cx.tid] = ts >> 1; } }
    __syncthreads();
    pg8::SchedMoe S; S.tbase = tbase; S.idx = idx; S.A = (const char*)(ws + WS_H1); S.B = (const char*)(ws + WS_WGU) + (size_t)li * 32 * 1024 * 1024 * 2;
    S.tA = 0; S.eB = (size_t)1024 * 1024 * 2; S.tB = (size_t)256 * 1024 * 2; S.G = cx.G; S.c = cx.vcu; S.ntiles = ntiles; S.gather = true;
    pg8::EpiUp E{(bf16_t*)(ws + WS_H)};
    pg8::gemm_phase<pg8::EpiUp, pg8::SchedMoe, true, true, D>(cx.lds, S, E);
    (void)ph;
}
__device__ __forceinline__ void phase_moe_down(CP* p0, const Ctx& cx0, int li, int ph) {
    const Ctx cx = reopaque(cx0); CP* p = opaque_args(p0);
    unsigned char* ws = p->ws; int ntiles; moe_tables(p, cx, li, ntiles);
    LAS int* tcnt = (LAS int*)(cx.lds + MISC_OFF + MO_TCNT); LAS int* tbase = (LAS int*)(cx.lds + MISC_OFF + MO_TBASE); LAS int* idx = (LAS int*)(cx.lds + MISC_OFF + MO_IDX);
    pg8::SchedMoe S; S.tbase = tbase; S.idx = idx; S.A = (const char*)(ws + WS_H); S.B = (const char*)(ws + WS_WD) + (size_t)li * 32 * 1024 * 512 * 2;
    S.tA = (size_t)256 * 512 * 2; S.eB = (size_t)1024 * 512 * 2; S.tB = (size_t)256 * 512 * 2; S.G = cx.G; S.c = cx.vcu; S.ntiles = ntiles; S.gather = false;
    pg8::EpiDown E{(bf16_t*)(ws + WS_Y2), (const int*)(ws + WS_ROWLIST), (const float*)(ws + WS_ROUTE), tcnt, tbase};
    pg8::gemm_phase<pg8::EpiDown, pg8::SchedMoe, false, true, DE>(cx.lds, S, E);
    (void)ph;
}
__device__ __forceinline__ void phase_final(CP* p0, const Ctx& cx0) {
    const Ctx cx = reopaque(cx0); CP* p = opaque_args(p0);
    unsigned char* ws = p->ws; const bf16_t* X1 = (const bf16_t*)(ws + WS_X1); const bf16_t* Y2 = (const bf16_t*)(ws + WS_Y2);
    for (int m = cx.gw; m < NX; m += cx.ngw) { const bf16_t* xr = X1 + (size_t)m * D; const bf16_t* ya = Y2 + (size_t)m * 2 * D; f32x4 v[4]; float ss = 0.f;
        const float* g2 = (const float*)(ws + WS_MOD) + (size_t)(9 + (m >> 11)) * 6144 + 5 * D;
#pragma unroll
        for (int j = 0; j < 4; ++j) { const int k = 256 * j + 4 * cx.lane; v[j] = ld_bf4(xr + k) + *(const f32x4*)(g2 + k) * (ld_bf4(ya + k) + ld_bf4(ya + D + k));
            ss += v[j][0] * v[j][0] + v[j][1] * v[j][1] + v[j][2] * v[j][2] + v[j][3] * v[j][3]; }
        const float r = 1.0f / sqrtf(wave_sum(ss) * (1.0f / D) + 1e-6f);
#pragma unroll
        for (int j = 0; j < 4; ++j) { const int k = 256 * j + 4 * cx.lane; const f32x4 g = *(const f32x4*)(p->norm_final + k); *(f32x4*)(p->out + (size_t)m * D + k) = v[j] * r * g; } }
}

constexpr int N_PHASES = 16;
__global__ void __launch_bounds__(512, 2) mk_fwd(Params p_unused) {
    CP* p = (CP*)__builtin_amdgcn_kernarg_segment_ptr(); (void)p_unused;
    extern __shared__ __attribute__((aligned(16))) unsigned char lds_raw[];
    Ctx cx; cx.lds = (LAS unsigned char*)lds_raw; cx.tid = threadIdx.x; cx.lane = cx.tid & 63; cx.wave = __builtin_amdgcn_readfirstlane(cx.tid >> 6);
    cx.G = gridDim.x; { const int bx = blockIdx.x; cx.vcu = (cx.G % 8 == 0) ? (bx % 8) * (cx.G / 8) + bx / 8 : bx; }
    cx.gw = cx.vcu * 8 + cx.wave; cx.ngw = cx.G * 8;
    volatile LAS unsigned* misc = (volatile LAS unsigned*)(cx.lds + LDS_BYTES - 16);
    if (cx.tid < 4) misc[cx.tid] = 0u;
    __syncthreads();
#if MK_SPLIT
#define GRID_BAR() do { } while (0)
#else
    XcdBarrier bar = xcd_barrier_post((unsigned*)(p->ws + WS_CTL) + CW_BAR, misc);
#define GRID_BAR() xcd_barrier(bar)
#endif
    const int lo = p->ph_lo, hi = p->ph_hi, rep0 = p->rep0;
    unsigned long long* tsbuf = (unsigned long long*)(p->ws + WS_END + 8 * MiB);
    if (MK_TS && blockIdx.x == 0 && threadIdx.x == 0) tsbuf[0] = __builtin_amdgcn_s_memrealtime();
#define IN(k) (lo <= (k) && (k) < hi)
#define EN(j) (!((MK_SKIP >> (j)) & 1))
#define SEAM(k) do { if (IN(k) && IN((k) + 1)) GRID_BAR(); if (MK_TS && blockIdx.x == 0 && threadIdx.x == 0) tsbuf[(k) + 1] = __builtin_amdgcn_s_memrealtime(); } while (0)
#define NREP(k) (((MK_REP >> (k)) & 1) ? 3 : 1)
#define RUN(kind, ph, cond, call) do { if (EN(kind) && IN(ph)) { const int nr_ = (cond) ? NREP(kind) : 1; for (int rep = nr_ - 1 + rep0; rep >= rep0; --rep) { call; if (rep > rep0) GRID_BAR(); } } } while (0)
    RUN(0, 0, true, phase_p0a(p, cx));
    SEAM(0);
    for (int li = 0; li < 2; ++li) { const int pb = 1 + 7 * li;
        RUN(2, pb + 0, li == 0, phase_norm1(p, cx, li));
        SEAM(pb + 0);
        RUN(3, pb + 1, true, phase_inproj(p, cx, li, pb + 1));
        SEAM(pb + 1);
        RUN(4, pb + 2, true, phase_mix(p, cx, li, rep, pb + 2));
        SEAM(pb + 2);
        RUN(5, pb + 3, li == 0, phase_outproj(p, cx, li, pb + 3));
        SEAM(pb + 3);
        RUN(6, pb + 4, true, phase_router(p, cx, li, rep));
        SEAM(pb + 4);
        RUN(7, pb + 5, true, phase_moe_up(p, cx, li, pb + 5));
        SEAM(pb + 5);
        RUN(8, pb + 6, true, phase_moe_down(p, cx, li, pb + 6));
        SEAM(pb + 6);
    }
    RUN(9, 15, true, phase_final(p, cx));
#if MK_TS
    if (blockIdx.x == 0 && threadIdx.x == 0) { tsbuf[16] = __builtin_amdgcn_s_memrealtime();
        const unsigned long long d = 4ull * (tsbuf[MK_TSB + 1] - tsbuf[MK_TSA]), t0 = __builtin_amdgcn_s_memrealtime();
        while (__builtin_amdgcn_s_memrealtime() - t0 < d) __builtin_amdgcn_s_sleep(8); }
#endif
}

extern "C" void kernel_launch(void* const* d_in, const int* in_sizes, int n_in, void* d_out, int out_size, void* d_ws, size_t ws_size, hipStream_t stream) {
    static int grid = 0;
    if (grid == 0) {
        if (n_in != 21 || out_size != NX * D || ws_size < WS_END) { fprintf(stderr, "kernel_launch: unexpected shapes (n_in %d, out %d, ws %zu)\n", n_in, out_size, ws_size); grid = -1; return; }
        int dev = 0, cus = 0;
        if (hipGetDevice(&dev) != hipSuccess || hipDeviceGetAttribute(&cus, hipDeviceAttributeMultiprocessorCount, dev) != hipSuccess) { grid = -1; return; }
        if (hipFuncSetAttribute((const void*)mk_fwd, hipFuncAttributeMaxDynamicSharedMemorySize, LDS_BYTES) != hipSuccess) { fprintf(stderr, "kernel_launch: hipFuncSetAttribute failed\n"); grid = -1; return; }
        (void)hipGetLastError();
        grid = cus;
        if (grid != 256) fprintf(stderr, "kernel_launch: %d CUs (built for 256)\n", grid);
    }
    if (grid < 0) return;
    (void)in_sizes;
    (void)hipMemsetAsync((char*)d_ws + WS_CTL, 0, CTL_ZERO_BYTES, stream);
    Params a{};
    a.x = (const float*)d_in[0]; a.c = (const float*)d_in[1]; a.ctx = (const float*)d_in[2]; a.c_ctx = (const float*)d_in[3]; a.w_ada = (const float*)d_in[4]; a.b_ada = (const float*)d_in[5];
    a.norm1 = (const float*)d_in[6]; a.norm2 = (const float*)d_in[7]; a.w_in = (const float*)d_in[8]; a.w_fourier = (const float*)d_in[9]; a.w_conv = (const float*)d_in[10]; a.rpb = (const float*)d_in[11];
    a.w_out = (const float*)d_in[12]; a.w_rg = (const float*)d_in[13]; a.b_rg = (const float*)d_in[14]; a.w_re = (const float*)d_in[15]; a.b_re = (const float*)d_in[16];
    a.w_gate = (const float*)d_in[17]; a.w_up = (const float*)d_in[18]; a.w_down = (const float*)d_in[19]; a.norm_final = (const float*)d_in[20];
    a.out = (float*)d_out; a.ws = (unsigned char*)d_ws;
#if MK_SPLIT
    for (int ph = 0; ph < N_PHASES; ++ph) { a.ph_lo = ph; a.ph_hi = ph + 1;
        if (ph == MK_XTRA) for (int r = 2; r >= 1; --r) { a.rep0 = r; hipLaunchKernelGGL(mk_fwd, dim3(grid), dim3(512), LDS_BYTES, stream, a); }
        a.rep0 = 0; hipLaunchKernelGGL(mk_fwd, dim3(grid), dim3(512), LDS_BYTES, stream, a); }
#else
    a.ph_lo = 0; a.ph_hi = N_PHASES; hipLaunchKernelGGL(mk_fwd, dim3(grid), dim3(512), LDS_BYTES, stream, a);
#endif
}
```

```cpp
#include <hip/hip_runtime.h>
#include <cstdio>
#include <cstdint>

#ifndef MK_REP
#define MK_REP 0
#endif
#ifndef MK_MIXREP
#define MK_MIXREP 0
#endif
#ifndef MK_XTRA
#define MK_XTRA -1
#endif
#ifndef MK_TS
#define MK_TS 0
#endif
#ifndef MK_TSA
#define MK_TSA 0
#endif
#ifndef MK_TSB
#define MK_TSB 1
#endif
#ifndef MK_P0REP
#define MK_P0REP 0
#endif
#ifndef MK_SKIP
#define MK_SKIP 0
#endif
#ifndef MK_SUB
#define MK_SUB 0
#endif
#ifndef MK_SPLIT
#define MK_SPLIT 0
#endif

#define GAS __attribute__((address_space(1)))
#define LAS __attribute__((address_space(3)))
typedef unsigned short bf16_t;
typedef short bf16x8 __attribute__((ext_vector_type(8)));
typedef short bf16x4 __attribute__((ext_vector_type(4)));
typedef float f32x2 __attribute__((ext_vector_type(2)));
typedef float f32x4 __attribute__((ext_vector_type(4)));
typedef float f32x16 __attribute__((ext_vector_type(16)));
typedef unsigned u32x2 __attribute__((ext_vector_type(2)));
typedef unsigned u32x4 __attribute__((ext_vector_type(4)));
typedef __bf16 bf16x2_n __attribute__((ext_vector_type(2)));

constexpr int D = 1024, NB = 8, SEQ = 2048, LC = 256, NX = NB * SEQ, NC = NB * LC, MT = NX + NC;
constexpr int NU = 1792;
constexpr int KO = 1280;
constexpr int NE = 32, DE = 512, NHEAD = 8;
constexpr int MAXT = 176;
constexpr float QSCALE = 0.125f * 1.4426950408889634f;
constexpr float LOG2E = 1.4426950408889634f;

constexpr size_t MiB = 1u << 20;
constexpr size_t WS_CTL = 0, CTL_ZERO_BYTES = 1 * MiB;
constexpr size_t WS_MOD = 1 * MiB;
constexpr size_t WS_MODP = 2 * MiB;
constexpr size_t WS_MW = 16 * MiB;
constexpr size_t WS_WRT = 17 * MiB;
constexpr size_t WS_ROUTE = 18 * MiB;
constexpr size_t WS_ROWLIST = 2 * MiB;
constexpr size_t WS_ADFTC = 22 * MiB;
constexpr size_t WS_ADFTX = 23 * MiB;
constexpr size_t WS_WIN = 39 * MiB;
constexpr size_t WS_WOUT = 49 * MiB;
constexpr size_t WS_WGU = 54 * MiB;
constexpr size_t WS_WD = 182 * MiB;
constexpr size_t WS_H1 = 246 * MiB;
constexpr size_t WS_U = 282 * MiB;
constexpr size_t WS_Y2 = WS_U;
constexpr size_t WS_VTX = 354 * MiB;
constexpr size_t WS_VTC = 370 * MiB;
constexpr size_t WS_FTX = 372 * MiB;
constexpr size_t WS_FTC = 380 * MiB;
constexpr size_t WS_CONC = 381 * MiB;
constexpr size_t WS_H = WS_FTX;
constexpr size_t WS_X1 = 426 * MiB;
constexpr size_t WS_END = 498 * MiB;
static_assert(WS_H + (size_t)MAXT * 256 * 512 * 2 <= WS_X1, "H overlay");
static_assert(WS_Y2 + (size_t)MT * 2 * 1024 * 2 <= WS_VTX, "y2 overlay");

constexpr int CW_BAR = 4096;
constexpr int CW_ATTQ = 8192;
constexpr int CW_BGQ = 12288, CW_DONE = 12352;
constexpr int CW_CNT = 16384;

constexpr int RING_BYTES = 131072, MISC_OFF = RING_BYTES, LDS_BYTES = 163840;
constexpr int MO_TCNT = 64, MO_TBASE = 192, MO_LCNT = 384, MO_LBASE = 512, MO_IDX = 1024, MO_RROW = 4096, MO_TEXP = 16384;

__device__ __forceinline__ unsigned cvtpk(float lo, float hi) { f32x2 v = {lo, hi}; bf16x2_n b = __builtin_convertvector(v, bf16x2_n); return __builtin_bit_cast(unsigned, b); }
__device__ __forceinline__ float bf2f(unsigned short b) { return __uint_as_float(((unsigned)b) << 16); }
__device__ __forceinline__ float bflo(unsigned w) { return __uint_as_float(w << 16); }
__device__ __forceinline__ float bfhi(unsigned w) { return __uint_as_float(w & 0xffff0000u); }
__device__ __forceinline__ f32x4 ld_bf4(const bf16_t* p) { const u32x2 a = *(const u32x2*)p; return (f32x4){bflo(a.x), bfhi(a.x), bflo(a.y), bfhi(a.y)}; }
__device__ __forceinline__ float wave_sum(float v) {
#pragma unroll
    for (int o = 1; o < 64; o <<= 1) v += __shfl_xor(v, o);
    return v;
}
#define LDS_WAIT() asm volatile("s_waitcnt lgkmcnt(0)" ::: "memory")
#define LDS_BARRIER() do { asm volatile("s_waitcnt lgkmcnt(0)" ::: "memory"); __builtin_amdgcn_s_barrier(); asm volatile("" ::: "memory"); } while (0)
#define VM_WAIT() asm volatile("s_waitcnt vmcnt(0)" ::: "memory")

#define XB_TMO      128
#define XB_XCNT(j)  (256  + 64 * (j))
#define XB_XSUB(j)  (1280 + 64 * (j))
#define XB_XGEN(j)  (2304 + 64 * (j))
#define XB_TOP      3328
#define XB_TOPGEN   3392
#define XCD_BAR_WORDS 3456
#define XB_SPIN_CAP (1u << 18)
__device__ __forceinline__ unsigned xb_ld(unsigned* p)              { return __hip_atomic_load(p, __ATOMIC_RELAXED, __HIP_MEMORY_SCOPE_AGENT); }
__device__ __forceinline__ unsigned xb_add(unsigned* p, unsigned v) { return __hip_atomic_fetch_add(p, v, __ATOMIC_RELAXED, __HIP_MEMORY_SCOPE_AGENT); }
__device__ __forceinline__ unsigned xb_xcc_id() { return (unsigned)__builtin_amdgcn_s_getreg((3 << 11) | 20) & 0xFu; }
#define XB_SPIN(cond, bar) do { unsigned _sp = 0; while (cond) { __builtin_amdgcn_s_sleep(1); \
    if ((++_sp & 255u) == 0u) { if (xb_ld(&(bar)[XB_TMO])) break; if (_sp > XB_SPIN_CAP) { atomicAdd(&(bar)[XB_TMO], 1u); break; } } } } while (0)
struct XcdBarrier { unsigned* bar; unsigned x; volatile LAS unsigned* st; };
__device__ __forceinline__ XcdBarrier xcd_barrier_post(unsigned* bar, volatile LAS unsigned* st) {
    XcdBarrier b; b.bar = bar; b.x = xb_xcc_id(); b.st = st;
    if (threadIdx.x == 0) (void)xb_add(&bar[XB_XCNT(b.x)], 1u);
    return b;
}
__device__ __forceinline__ void xcd_barrier_complete(unsigned* bar, unsigned x, unsigned& nloc, unsigned& nx) {
    const unsigned G = gridDim.x * gridDim.y * gridDim.z;
    unsigned sum, cnt, mine, sp = 0u;
    for (;;) {
        sum = 0u; cnt = 0u; mine = 0u;
#pragma unroll
        for (unsigned j = 0; j < 16; ++j) { const unsigned c = xb_ld(&bar[XB_XCNT(j)]); sum += c; cnt += (c > 0u) ? 1u : 0u; mine = (j == x) ? c : mine; }
        if (sum == G) break;
        __builtin_amdgcn_s_sleep(1);
        if ((++sp & 255u) == 0u) { if (xb_ld(&bar[XB_TMO])) break; if (sp > XB_SPIN_CAP) { atomicAdd(&bar[XB_TMO], 1u); break; } }
    }
    nloc = mine > 0u ? mine : 1u; nx = cnt > 0u ? cnt : 1u;
}
__device__ __forceinline__ void xcd_barrier(const XcdBarrier& b) {
    asm volatile("s_waitcnt vmcnt(0)" ::: "memory");
    __syncthreads();
    if (threadIdx.x == 64) asm volatile("buffer_inv sc1" ::: "memory");
    if (threadIdx.x == 0) {
        unsigned* bar = b.bar;
        __builtin_amdgcn_s_waitcnt(0);
        unsigned nloc = b.st[0], nx = b.st[1];
        if (nloc == 0u) { xcd_barrier_complete(bar, b.x, nloc, nx); b.st[0] = nloc; b.st[1] = nx; }
        const unsigned old = xb_add(&bar[XB_XSUB(b.x)], 1u);
        const unsigned gen = old / nloc;
        if (old + 1u == (gen + 1u) * nloc) {
            __builtin_amdgcn_fence(__ATOMIC_RELEASE, "agent");
            asm volatile("s_waitcnt vmcnt(0)" ::: "memory");
            const unsigned og = xb_add(&bar[XB_TOP], 1u);
            const unsigned tg = og / nx;
            if (og + 1u == (tg + 1u) * nx) xb_add(&bar[XB_TOPGEN], 1u);
            else XB_SPIN(xb_ld(&bar[XB_TOPGEN]) == tg, bar);
            asm volatile("" ::: "memory");
            xb_add(&bar[XB_XGEN(b.x)], 1u);
            asm volatile("s_waitcnt vmcnt(0)" ::: "memory");
        } else {
            XB_SPIN(xb_ld(&bar[XB_XGEN(b.x)]) == gen, bar);
            asm volatile("s_waitcnt vmcnt(0)" ::: "memory");
        }
    }
    if (threadIdx.x == 64) asm volatile("s_waitcnt vmcnt(0)" ::: "memory");
    __syncthreads();
}

namespace pg8 {
constexpr int BM = 256, BK = 64, HALF = 128, HTB = HALF * BK * 2, STAGE_BYTES = 8 * HTB, NXCD = 8, WGM = 8;
__host__ __device__ __forceinline__ int lds_byte(int r, int c) { const int st = (r >> 4) * 2 + (c >> 5), rr = r & 15, cc = c & 31, ob = rr * 64 + cc * 2; return st * 1024 + (ob ^ (((ob >> 9) & 1) << 5)); }
__host__ __device__ __forceinline__ void stage_rc(int b, int& R, int& C) { const int st = b / 1024, sb = b % 1024, swz = sb ^ (((sb >> 9) & 1) << 5); R = (st >> 1) * 16 + swz / 64; C = (st & 1) * 32 + (swz % 64) / 2; }
__host__ __device__ __forceinline__ int perm32(int rho) { const int n = rho >> 4, i = rho & 15; return 8 * (i >> 2) + 4 * n + (i & 3); }

struct Unit { int pm, pn, aux; const char* A; const char* B; };
template <class E, class = void> struct epi_has_pre { static constexpr bool value = false; };
template <class E> struct epi_has_pre<E, decltype((void)E::PRE)> { static constexpr bool value = E::PRE; };

template <class Epi, class Sched, bool GATHER, bool ALIGN_EPI, int KT>
__device__ __forceinline__ void gemm_phase(LAS unsigned char* lds, const Sched& S, const Epi& E, const int Krt = 0) {
    const int K = KT ? KT : Krt;
    int tid_ = threadIdx.x; asm volatile("" : "+v"(tid_));
    const int tid = tid_, wid = __builtin_amdgcn_readfirstlane(tid >> 6), lane = tid & 63, wr = wid >> 2, wc = wid & 3, fr = lane & 15, fq = lane >> 4;
    const int nt = K / BK;
    int R0, C0; stage_rc(tid * 16, R0, C0);
    unsigned voffA[2], voffB[2];
#pragma unroll
    for (int i = 0; i < 2; ++i) { const int R = R0 + 64 * i; const int Rb = Epi::PERM ? ((R & ~31) + perm32(R & 31)) : R;
        voffA[i] = (unsigned)(R * K + C0) * 2u; voffB[i] = (unsigned)(Rb * K + C0) * 2u; }
    unsigned cvA0[2] = {0u, 0u}, cvA1[2] = {0u, 0u}, nvA0[2] = {0u, 0u}, nvA1[2] = {0u, 0u};
    const size_t kstep = (size_t)(BK * 2);
    const size_t hstep = (size_t)HALF * K * 2;
    const unsigned ldsw = (unsigned)wid * 1024u;
    const int aoff = lds_byte(wr * 64 + fr, fq * 8), boff = lds_byte(wc * 32 + fr, fq * 8);
#define PG8_SA(b, h) (((b) * 2 + (h)) * HTB)
#define PG8_SB(b, h) ((4 + (b) * 2 + (h)) * HTB)
#define PG8_STAGE(bufoff, gbase, voff) do { _Pragma("unroll") for (int _i = 0; _i < 2; ++_i) \
        __builtin_amdgcn_global_load_lds((const unsigned*)((const char*)(gbase) + (voff)[_i]), (LAS unsigned*)(lds + (bufoff) + ldsw + _i * 8192), 16, 0, 0); } while (0)
#define PG8_STAGE_A(b, h, gbase, g0, g1) do { if constexpr (GATHER) { if ((h) == 0) PG8_STAGE(PG8_SA(b, 0), gbase, g0); else PG8_STAGE(PG8_SA(b, 1), gbase, g1); } \
        else { PG8_STAGE(PG8_SA(b, h), (gbase) + ((h) ? hstep : 0), voffA); } } while (0)
#define PG8_ROWS(u, v0, v1) do { _Pragma("unroll") for (int _i = 0; _i < 2; ++_i) { v0[_i] = (unsigned)(S.arow(u, R0 + 64 * _i) * K + C0) * 2u; v1[_i] = (unsigned)(S.arow(u, 128 + R0 + 64 * _i) * K + C0) * 2u; } } while (0)
#define PG8_LDA(dst, b, h) do { _Pragma("unroll") for (int m = 0; m < 4; ++m) _Pragma("unroll") for (int k = 0; k < 2; ++k) dst[m][k] = *(const LAS bf16x8*)(lds + PG8_SA(b, h) + aoff + m * 2048 + k * 1024); } while (0)
#define PG8_LDB(dst, b, h) do { _Pragma("unroll") for (int n = 0; n < 2; ++n) _Pragma("unroll") for (int k = 0; k < 2; ++k) dst[n][k] = *(const LAS bf16x8*)(lds + PG8_SB(b, h) + boff + n * 2048 + k * 1024); } while (0)
#define PG8_MMA(ai, bj, At, Bt) do { __builtin_amdgcn_s_setprio(1); _Pragma("unroll") for (int m = 0; m < 4; ++m) _Pragma("unroll") for (int n = 0; n < 2; ++n) _Pragma("unroll") for (int k = 0; k < 2; ++k) \
        acc[ai][bj][m][n] = __builtin_amdgcn_mfma_f32_16x16x32_bf16(Bt[n][k], At[m][k], acc[ai][bj][m][n], 0, 0, 0); __builtin_amdgcn_s_setprio(0); } while (0)
#define PG8_WAIT_V(n) asm volatile("s_waitcnt vmcnt(" #n ")" ::: "memory")
#define PG8_WAIT_L(n) asm volatile("s_waitcnt lgkmcnt(" #n ")" ::: "memory")
#define PG8_BAR __builtin_amdgcn_s_barrier()
#define PG8_SCHED __builtin_amdgcn_sched_barrier(0)
    Unit cur, nxt; int ui = 0;
    if (!S.next(0, cur)) return;
    f32x4 acc[2][2][4][2];
#pragma unroll
    for (int a = 0; a < 2; ++a)
#pragma unroll
        for (int b = 0; b < 2; ++b)
#pragma unroll
            for (int m = 0; m < 4; ++m)
#pragma unroll
                for (int n = 0; n < 2; ++n) acc[a][b][m][n] = (f32x4){0.f, 0.f, 0.f, 0.f};
    bf16x8 At[4][2], B0[2][2], B1[2][2];
    unsigned long long pre_[8] = {0ull, 0ull, 0ull, 0ull, 0ull, 0ull, 0ull, 0ull};
    const char* cA = cur.A; const char* cB = cur.B;
    if constexpr (GATHER) { PG8_ROWS(cur, cvA0, cvA1); }
    PG8_STAGE(PG8_SB(0, 0), cB, voffB); PG8_STAGE(PG8_SB(0, 1), cB + hstep, voffB); PG8_STAGE_A(0, 0, cA, cvA0, cvA1); PG8_STAGE_A(0, 1, cA, cvA0, cvA1);
    if (wr == 1) PG8_BAR;
    PG8_WAIT_V(2); PG8_BAR;
    PG8_STAGE(PG8_SB(1, 0), cB + kstep, voffB); PG8_STAGE_A(1, 0, cA + kstep, cvA0, cvA1); PG8_STAGE(PG8_SB(1, 1), cB + hstep + kstep, voffB);
    PG8_WAIT_V(6); PG8_BAR;
    for (;;) {
        const bool has_next = S.next(ui + 1, nxt);
        const char* nA = has_next ? nxt.A : cA; const char* nB = has_next ? nxt.B : cB;
        if constexpr (GATHER) { if (has_next) { PG8_ROWS(nxt, nvA0, nvA1); } else {
#pragma unroll
            for (int i = 0; i < 2; ++i) { nvA0[i] = cvA0[i]; nvA1[i] = cvA1[i]; } } }
        for (int t = 0; t < nt; t += 2) {
            const bool last = (t == nt - 2);
            const char* a1 = cA + (size_t)(t + 1) * kstep;
            const char* a2 = last ? nA : cA + (size_t)(t + 2) * kstep; const char* b2 = last ? nB : cB + (size_t)(t + 2) * kstep;
            const char* a3 = a2 + kstep; const char* b3 = b2 + kstep;
            unsigned sA0[2], sA1[2];
#pragma unroll
            for (int i = 0; i < 2; ++i) { sA0[i] = last ? nvA0[i] : cvA0[i]; sA1[i] = last ? nvA1[i] : cvA1[i]; }
            if constexpr (epi_has_pre<Epi>::value) { if (last) E.pre(cur, wr, fr, pre_); }
            PG8_LDB(B0, 0, 0); PG8_LDB(B1, 0, 1); PG8_SCHED; PG8_LDA(At, 0, 0); PG8_STAGE_A(1, 1, a1, cvA0, cvA1);
            PG8_WAIT_V(8); PG8_WAIT_L(0); PG8_BAR; PG8_MMA(0, 0, At, B0); PG8_MMA(0, 1, At, B1); PG8_BAR; PG8_SCHED;
            PG8_LDA(At, 0, 1); PG8_STAGE(PG8_SB(0, 0), b2, voffB); PG8_STAGE(PG8_SB(0, 1), b2 + hstep, voffB); PG8_STAGE_A(0, 0, a2, sA0, sA1);
            PG8_WAIT_V(8); PG8_WAIT_L(0); PG8_BAR; PG8_MMA(1, 0, At, B0); PG8_MMA(1, 1, At, B1); PG8_BAR; PG8_SCHED;
            PG8_LDB(B0, 1, 0); PG8_LDB(B1, 1, 1); PG8_SCHED; PG8_LDA(At, 1, 0); PG8_STAGE_A(0, 1, a2, sA0, sA1);
            PG8_WAIT_V(8); PG8_WAIT_L(0); PG8_BAR; PG8_MMA(0, 0, At, B0); PG8_MMA(0, 1, At, B1); PG8_BAR; PG8_SCHED;
            PG8_LDA(At, 1, 1); PG8_STAGE(PG8_SB(1, 0), b3, voffB); PG8_STAGE(PG8_SB(1, 1), b3 + hstep, voffB); PG8_STAGE_A(1, 0, a3, sA0, sA1);
            PG8_WAIT_V(8); PG8_WAIT_L(0); PG8_BAR; PG8_MMA(1, 0, At, B0); PG8_MMA(1, 1, At, B1); PG8_BAR; PG8_SCHED;
        }
        if constexpr (ALIGN_EPI) { if (wr == 0) PG8_BAR; }
        if constexpr (epi_has_pre<Epi>::value) E(acc, cur, wr, wc, fr, fq, pre_); else E(acc, cur, wr, wc, fr, fq);
        if (!has_next) break;
#pragma unroll
        for (int a = 0; a < 2; ++a)
#pragma unroll
            for (int b = 0; b < 2; ++b)
#pragma unroll
                for (int m = 0; m < 4; ++m)
#pragma unroll
                    for (int n = 0; n < 2; ++n) acc[a][b][m][n] = (f32x4){0.f, 0.f, 0.f, 0.f};
        cur = nxt; cA = nA; cB = nB; ++ui;
        if constexpr (GATHER) {
#pragma unroll
            for (int i = 0; i < 2; ++i) { cvA0[i] = nvA0[i]; cvA1[i] = nvA1[i]; } }
        if constexpr (ALIGN_EPI) { if (wr == 1) PG8_BAR; }
    }
    PG8_WAIT_V(0);
    if constexpr (!ALIGN_EPI) { if (wr == 0) PG8_BAR; }
    PG8_BAR;
#undef PG8_SA
#undef PG8_SB
#undef PG8_STAGE
#undef PG8_STAGE_A
#undef PG8_ROWS
#undef PG8_LDA
#undef PG8_LDB
#undef PG8_MMA
#undef PG8_WAIT_V
#undef PG8_WAIT_L
#undef PG8_BAR
#undef PG8_SCHED
}

struct SchedRect {
    const char* A; const char* B; size_t tA, tB; int nM, nN, nwg, G, c;
    __device__ __forceinline__ void init(const void* A_, const void* B_, int M, int N, int K, int G_, int c_) { A = (const char*)A_; B = (const char*)B_; tA = tB = (size_t)BM * K * 2; nM = M / BM; nN = N / BM; nwg = nM * nN; G = G_; c = c_; }
    __device__ __forceinline__ bool next(int i, Unit& u) const {
        const long L = (long)i * G + c; if (L >= nwg) return false;
        int wgid = (int)L; { const int q = nwg / NXCD, r = nwg % NXCD, xcd = wgid % NXCD, off = wgid / NXCD; wgid = (xcd < r ? xcd * (q + 1) : r * (q + 1) + (xcd - r) * q) + off; }
        const int nig = WGM * nN, gid = wgid / nig, fm = gid * WGM, gsz = (nM - fm) < WGM ? (nM - fm) : WGM;
        u.pm = fm + ((wgid % nig) % gsz); u.pn = (wgid % nig) / gsz; u.aux = 0; u.A = A + (size_t)u.pm * tA; u.B = B + (size_t)u.pn * tB; return true;
    }
    __device__ __forceinline__ int arow(const Unit&, int) const { return 0; }
};
struct SchedOne {
    bool has; Unit u0;
    __device__ __forceinline__ bool next(int i, Unit& u) const { if (i > 0 || !has) return false; u = u0; return true; }
    __device__ __forceinline__ int arow(const Unit&, int) const { return 0; }
};
struct SchedMoe {
    const LAS int* texp; const LAS int* idx; const char* A; const char* B; size_t tA, eB, tB; int G, c, ntiles; bool gather;
    __device__ __forceinline__ bool next(int i, Unit& u) const {
        const int L = i * G + c, T = L >> 2; if (T >= ntiles) return false;
        const int e = __builtin_amdgcn_readfirstlane(texp[T]);
        u.pm = T; u.pn = L & 3; u.aux = e | (i << 8); u.A = gather ? A : A + (size_t)T * tA; u.B = B + (size_t)e * eB + (size_t)(L & 3) * tB; return true;
    }
    __device__ __forceinline__ int arow(const Unit& u, int r) const { return idx[(u.aux >> 8) * 256 + r]; }
};

struct EpiBf16 {
    static constexpr bool PERM = true;
    bf16_t* O; int ldc;
    __device__ __forceinline__ void operator()(const f32x4 (&acc)[2][2][4][2], const Unit& u, int wr, int wc, int fr, int fq) const {
        const int row0 = u.pm * BM + wr * 64 + fr, col0 = u.pn * BM + wc * 32 + 8 * fq;
#pragma unroll
        for (int ai = 0; ai < 2; ++ai)
#pragma unroll
            for (int m = 0; m < 4; ++m) { bf16_t* rowp = O + (size_t)(row0 + ai * HALF + m * 16) * ldc + col0;
#pragma unroll
                for (int bj = 0; bj < 2; ++bj) { const f32x4 v0 = acc[ai][bj][m][0], v1 = acc[ai][bj][m][1];
                    u32x4 w; w.x = cvtpk(v0[0], v0[1]); w.y = cvtpk(v0[2], v0[3]); w.z = cvtpk(v1[0], v1[1]); w.w = cvtpk(v1[2], v1[3]);
                    *(u32x4*)(rowp + bj * HALF) = w; } }
    }
};
struct EpiT {
    static constexpr bool PERM = true;
    bf16_t *ftx, *ftc, *vtx, *vtc;
    __device__ __forceinline__ void operator()(const f32x4 (&acc)[2][2][4][2], const Unit& u, int wr, int wc, int fr, int fq) const {
        bf16_t* base; int pitch;
        const int b = (u.pn < 64) ? (u.pn >> 3) : (u.pn - 64);
        if (u.pm == 0) { if (u.pn < 64) { base = ftx + (size_t)b * 256 * 2048 + (u.pn & 7) * 256; pitch = 2048; } else { base = ftc + (size_t)b * 256 * 256; pitch = 256; } }
        else { const int v0 = (u.pm - 1) * 256; if (u.pn < 64) { base = vtx + ((size_t)b * 512 + v0) * 2048 + (u.pn & 7) * 256; pitch = 2048; } else { base = vtc + ((size_t)b * 512 + v0) * 256; pitch = 256; } }
        const int row0 = wr * 64 + fr, col0 = wc * 32 + 8 * fq;
#pragma unroll
        for (int ai = 0; ai < 2; ++ai)
#pragma unroll
            for (int m = 0; m < 4; ++m) { bf16_t* rowp = base + (size_t)(row0 + ai * HALF + m * 16) * pitch + col0;
#pragma unroll
                for (int bj = 0; bj < 2; ++bj) { const f32x4 v0 = acc[ai][bj][m][0], v1 = acc[ai][bj][m][1];
                    u32x4 w; w.x = cvtpk(v0[0], v0[1]); w.y = cvtpk(v0[2], v0[3]); w.z = cvtpk(v1[0], v1[1]); w.w = cvtpk(v1[2], v1[3]);
                    *(u32x4*)(rowp + bj * HALF) = w; } }
    }
};
struct EpiDft {
    static constexpr bool PERM = true;
    bf16_t* conc; int ctxmode;
    __device__ __forceinline__ void operator()(const f32x4 (&acc)[2][2][4][2], const Unit& u, int wr, int wc, int fr, int fq) const {
        const int N = ctxmode ? 256 : 2048; bf16_t* base = conc + (size_t)u.pn * N * KO + wc * 32 + 8 * fq;
#pragma unroll
        for (int ai = 0; ai < 2; ++ai)
#pragma unroll
            for (int m = 0; m < 4; ++m) { const int r = ai * HALF + wr * 64 + m * 16 + fr;
                const int cs = ctxmode ? ai : (u.pm >> 2), k = ctxmode ? (r - ai * HALF) : ((u.pm & 3) * 256 + r);
                bf16_t* rowp = base + (size_t)k * KO + cs * 256; bf16_t* mirp = base + (size_t)(N - k) * KO + cs * 256; const float sg = cs ? -1.f : 1.f;
#pragma unroll
                for (int bj = 0; bj < 2; ++bj) { const f32x4 v0 = acc[ai][bj][m][0], v1 = acc[ai][bj][m][1];
                    u32x4 w; w.x = cvtpk(v0[0], v0[1]); w.y = cvtpk(v0[2], v0[3]); w.z = cvtpk(v1[0], v1[1]); w.w = cvtpk(v1[2], v1[3]);
                    *(u32x4*)(rowp + bj * HALF) = w;
                    if (k > 0) { u32x4 x; x.x = cvtpk(v0[0] * sg, v0[1] * sg); x.y = cvtpk(v0[2] * sg, v0[3] * sg); x.z = cvtpk(v1[0] * sg, v1[1] * sg); x.w = cvtpk(v1[2] * sg, v1[3] * sg);
                        *(u32x4*)(mirp + bj * HALF) = x; } } }
    }
};
struct EpiOut {
    static constexpr bool PERM = true;
    bf16_t* x1; const float* xin; const float* cin; const float* mod;
    __device__ __forceinline__ void operator()(const f32x4 (&acc)[2][2][4][2], const Unit& u, int wr, int wc, int fr, int fq) const {
        const int rr = (u.pm < 64) ? (u.pm >> 3) : 8;
        const int row0 = u.pm * BM + wr * 64 + fr, col0 = u.pn * BM + wc * 32 + 8 * fq;
        const float* res = xin ? ((u.pm < 64) ? xin + (size_t)row0 * D : cin + (size_t)(row0 - NX) * D) : nullptr;
        const float* g1 = mod + rr * 6144 + 2 * D + col0;
        f32x4 gv[2][2];
#pragma unroll
        for (int bj = 0; bj < 2; ++bj)
#pragma unroll
            for (int n = 0; n < 2; ++n) gv[bj][n] = *(const f32x4*)(g1 + bj * HALF + 4 * n);
        if (res) {
#pragma unroll
            for (int ai = 0; ai < 2; ++ai) { f32x4 r[4][2][2];
#pragma unroll
                for (int m = 0; m < 4; ++m)
#pragma unroll
                    for (int bj = 0; bj < 2; ++bj) { const float* rp = res + (size_t)(ai * HALF + m * 16) * D + col0 + bj * HALF; r[m][bj][0] = *(const f32x4*)rp; r[m][bj][1] = *(const f32x4*)(rp + 4); }
#pragma unroll
                for (int m = 0; m < 4; ++m) { bf16_t* op = x1 + (size_t)row0 * D + (size_t)(ai * HALF + m * 16) * D + col0;
#pragma unroll
                    for (int bj = 0; bj < 2; ++bj) { const f32x4 v0 = r[m][bj][0] + gv[bj][0] * acc[ai][bj][m][0], v1 = r[m][bj][1] + gv[bj][1] * acc[ai][bj][m][1];
                        u32x4 w; w.x = cvtpk(v0[0], v0[1]); w.y = cvtpk(v0[2], v0[3]); w.z = cvtpk(v1[0], v1[1]); w.w = cvtpk(v1[2], v1[3]);
                        *(u32x4*)(op + bj * HALF) = w; } } }
        } else {
#pragma unroll
            for (int ai = 0; ai < 2; ++ai) { u32x4 q[4][2];
#pragma unroll
                for (int m = 0; m < 4; ++m)
#pragma unroll
                    for (int bj = 0; bj < 2; ++bj) q[m][bj] = *(const u32x4*)(x1 + (size_t)row0 * D + (size_t)(ai * HALF + m * 16) * D + col0 + bj * HALF);
#pragma unroll
                for (int m = 0; m < 4; ++m) { bf16_t* op = x1 + (size_t)row0 * D + (size_t)(ai * HALF + m * 16) * D + col0;
#pragma unroll
                    for (int bj = 0; bj < 2; ++bj) { const u32x4 qq = q[m][bj];
                        const f32x4 r0 = (f32x4){bflo(qq.x), bfhi(qq.x), bflo(qq.y), bfhi(qq.y)}, r1 = (f32x4){bflo(qq.z), bfhi(qq.z), bflo(qq.w), bfhi(qq.w)};
                        const f32x4 v0 = r0 + gv[bj][0] * acc[ai][bj][m][0], v1 = r1 + gv[bj][1] * acc[ai][bj][m][1];
                        u32x4 w; w.x = cvtpk(v0[0], v0[1]); w.y = cvtpk(v0[2], v0[3]); w.z = cvtpk(v1[0], v1[1]); w.w = cvtpk(v1[2], v1[3]);
                        *(u32x4*)(op + bj * HALF) = w; } } }
        }
    }
};
struct EpiUp {
    static constexpr bool PERM = false;
    bf16_t* H;
    __device__ __forceinline__ void operator()(const f32x4 (&acc)[2][2][4][2], const Unit& u, int wr, int wc, int fr, int fq) const {
        const int row0 = u.pm * BM + wr * 64 + fr;
#pragma unroll
        for (int ai = 0; ai < 2; ++ai)
#pragma unroll
            for (int m = 0; m < 4; ++m) { bf16_t* rowp = H + (size_t)(row0 + ai * HALF + m * 16) * DE;
#pragma unroll
                for (int bj = 0; bj < 2; ++bj) { const int hid = 16 * (8 * u.pn + 4 * bj + wc) + 4 * fq;
                    const f32x4 g = acc[ai][bj][m][0], up = acc[ai][bj][m][1]; float h[4];
#pragma unroll
                    for (int j = 0; j < 4; ++j) h[j] = g[j] * __builtin_amdgcn_rcpf(1.f + __builtin_amdgcn_exp2f(-LOG2E * g[j])) * up[j];
                    u32x2 w; w.x = cvtpk(h[0], h[1]); w.y = cvtpk(h[2], h[3]);
                    *(u32x2*)(rowp + hid) = w; } }
    }
};
struct EpiDown {
    static constexpr bool PERM = true, PRE = true;
    bf16_t* y2; const unsigned long long* rowlist; const LAS int* tcnt; const LAS int* tbase;
    __device__ __forceinline__ void pre(const Unit& u, int wr, int fr, unsigned long long (&pr)[8]) const {
        const int e = u.aux & 255, cnt = tcnt[e], j0 = (u.pm - tbase[e]) * 256 + wr * 64 + fr;
#pragma unroll
        for (int ai = 0; ai < 2; ++ai)
#pragma unroll
            for (int m = 0; m < 4; ++m) { const int j = j0 + ai * HALF + m * 16; pr[ai * 4 + m] = rowlist[(size_t)e * MT + (j < cnt ? j : 0)]; }
    }
    __device__ __forceinline__ void operator()(const f32x4 (&acc)[2][2][4][2], const Unit& u, int wr, int wc, int fr, int fq, const unsigned long long (&pr)[8]) const {
        const int e = u.aux & 255, cnt = tcnt[e], j0 = (u.pm - tbase[e]) * 256 + wr * 64 + fr;
        const int col0 = u.pn * BM + wc * 32 + 8 * fq;
#pragma unroll
        for (int ai = 0; ai < 2; ++ai)
#pragma unroll
            for (int m = 0; m < 4; ++m) { const int j = j0 + ai * HALF + m * 16;
                if (j < cnt) { const unsigned long long d = pr[ai * 4 + m]; const unsigned ts = (unsigned)d; const float w_ = __uint_as_float((unsigned)(d >> 32)); bf16_t* rowp = y2 + (size_t)ts * D + col0;
#pragma unroll
                    for (int bj = 0; bj < 2; ++bj) { const f32x4 v0 = acc[ai][bj][m][0] * w_, v1 = acc[ai][bj][m][1] * w_;
                        u32x4 w; w.x = cvtpk(v0[0], v0[1]); w.y = cvtpk(v0[2], v0[3]); w.z = cvtpk(v1[0], v1[1]); w.w = cvtpk(v1[2], v1[3]);
                        *(u32x4*)(rowp + bj * HALF) = w; } } }
    }
};
struct SchedInproj {
    SchedRect R; const char *A1, *B1; int G, c;
    __device__ __forceinline__ bool next(int i, Unit& u) const {
        const int L = i * G + c; if (L < R.nwg) return R.next(i, u);
        const int j = L - R.nwg; if (j >= 216) return false;
        { const int xq = j & 7, yq = j >> 3; u.pm = yq % 3; u.pn = (yq / 3) * 8 + xq; } u.aux = 1;     u.A = A1 + (size_t)u.pm * ((size_t)BM * D * 2); u.B = B1 + (size_t)u.pn * ((size_t)BM * D * 2); return true;
    }
    __device__ __forceinline__ int arow(const Unit&, int) const { return 0; }
};
struct EpiInproj {
    static constexpr bool PERM = true;
    bf16_t *U, *ftx, *ftc, *vtx, *vtc;
    __device__ __forceinline__ void operator()(const f32x4 (&acc)[2][2][4][2], const Unit& u, int wr, int wc, int fr, int fq) const {
        bf16_t* base; size_t pitch;
        if (u.aux == 0) { base = U + (size_t)u.pm * BM * NU + (size_t)u.pn * BM; pitch = NU; }
        else { const int b = (u.pn < 64) ? (u.pn >> 3) : (u.pn - 64);
            if (u.pm == 0) { if (u.pn < 64) { base = ftx + (size_t)b * 256 * 2048 + (u.pn & 7) * 256; pitch = 2048; } else { base = ftc + (size_t)b * 256 * 256; pitch = 256; } }
            else { const int v0 = (u.pm - 1) * 256; if (u.pn < 64) { base = vtx + ((size_t)b * 512 + v0) * 2048 + (u.pn & 7) * 256; pitch = 2048; } else { base = vtc + ((size_t)b * 512 + v0) * 256; pitch = 256; } } }
        const int row0 = wr * 64 + fr, col0 = wc * 32 + 8 * fq;
#pragma unroll
        for (int ai = 0; ai < 2; ++ai)
#pragma unroll
            for (int m = 0; m < 4; ++m) { bf16_t* rowp = base + (size_t)(row0 + ai * HALF + m * 16) * pitch + col0;
#pragma unroll
                for (int bj = 0; bj < 2; ++bj) { const f32x4 v0 = acc[ai][bj][m][0], v1 = acc[ai][bj][m][1];
                    u32x4 w; w.x = cvtpk(v0[0], v0[1]); w.y = cvtpk(v0[2], v0[3]); w.z = cvtpk(v1[0], v1[1]); w.w = cvtpk(v1[2], v1[3]);
                    *(u32x4*)(rowp + bj * HALF) = w; } }
    }
};
}

struct Params {
    const float *x, *c, *ctx, *c_ctx, *w_ada, *b_ada, *norm1, *norm2, *w_in, *w_fourier, *w_conv, *rpb, *w_out, *w_rg, *b_rg, *w_re, *b_re, *w_gate, *w_up, *w_down, *norm_final;
    float* out; unsigned char* ws; int ph_lo, ph_hi, rep0, pad;
};
typedef const __attribute__((address_space(4))) Params CP;
__device__ __forceinline__ CP* opaque_args(CP* p) { asm volatile("" : "+s"(p)); return p; }
struct Ctx { LAS unsigned char* lds; int tid, lane, wave, G, vcu, gw, ngw; };
__device__ __forceinline__ Ctx reopaque(const Ctx& c) { Ctx r = c; int t = threadIdx.x; asm volatile("" : "+v"(t)); r.tid = t; r.lane = t & 63; return r; }

__device__ __forceinline__ void tr_item(const float* src, int ldn, int k0, int n0, bf16_t* dst, int ldk, int kd0, int rtype, LAS float* scr, int lane) {
    float tv[32];
#pragma unroll
    for (int i = 0; i < 32; ++i) tv[i] = __builtin_nontemporal_load(src + (size_t)(k0 + 2 * i + (lane >> 5)) * ldn + n0 + (lane & 31));
#pragma unroll
    for (int i = 0; i < 32; ++i) scr[(2 * i + (lane >> 5)) * 33 + (lane & 31)] = tv[i];
    LDS_WAIT(); asm volatile("" ::: "memory");
    const int c = lane & 7;
#pragma unroll
    for (int j = 0; j < 4; ++j) { const int n = (lane >> 3) + 8 * j; const LAS float* s = scr + (8 * c) * 33 + n;
        const int sn = n0 + n; int dr; float sc = 1.f;
        if (rtype == 0) { dr = (sn < 256) ? sn : (sn < 1280 ? sn + 512 : (sn < 1792 ? sn - 1024 : sn)); if (sn >= 256 && sn < 768) sc = QSCALE; }
        else if (rtype == 2) dr = 32 * (sn >> 4) + (sn & 15);
        else if (rtype == 3) dr = 32 * (sn >> 4) + 16 + (sn & 15);
        else dr = sn;
        u32x4 o; o.x = cvtpk(s[0 * 33] * sc, s[1 * 33] * sc); o.y = cvtpk(s[2 * 33] * sc, s[3 * 33] * sc); o.z = cvtpk(s[4 * 33] * sc, s[5 * 33] * sc); o.w = cvtpk(s[6 * 33] * sc, s[7 * 33] * sc);
        *(u32x4*)(dst + (size_t)dr * ldk + kd0 + 8 * c) = o; }
    LDS_WAIT(); asm volatile("" ::: "memory");
}
__device__ __forceinline__ void phase_p0a(CP* p0, const Ctx& cx0) {
    const Ctx cx = reopaque(cx0); CP* p = opaque_args(p0);
    LAS float* T = (LAS float*)(cx.lds + 147456);
    LAS float* scr = (LAS float*)(cx.lds + cx.wave * 8448);
    unsigned char* ws = p->ws;
    for (int j = cx.tid; j < 2048; j += 512) T[j] = cospif((float)j * (1.0f / 1024.0f));
    __syncthreads();
    const int gt = cx.vcu * 512 + cx.tid, ngt = cx.G * 512;
    f32x4 fv[8], fo[4]; const bool pre_fold = (cx.G >= 256) && (cx.vcu < 256);
    if (pre_fold) { const int task = cx.vcu, li = task >> 7, g = (task >> 5) & 3, n0 = (task & 31) * 32;
        const float* wf = p->w_fourier + (size_t)li * 65536 + (size_t)(64 * g) * 256; const float* wo = p->w_out + (size_t)li * 1024 * 1024 + n0; const int l = cx.tid & 63, jb = cx.tid >> 6;
#pragma unroll
        for (int r = 0; r < 8; ++r) fv[r] = *(const f32x4*)(wf + (size_t)l * 256 + jb * 32 + 4 * r);
#pragma unroll
        for (int r = 0; r < 4; ++r) { const int pc = cx.tid + 512 * r, j = pc >> 3, q = pc & 7; fo[r] = *(const f32x4*)(wo + (size_t)j * 1024 + q * 4); } }
    f32x4 wmod[16], wmod2[16]; const bool has_mod = (cx.vcu < 192);
    { const int u = has_mod ? cx.vcu : 0, li = u / 96, j0 = (u % 96) * 64, c4 = (cx.tid & 15) * 4, ksl = cx.tid >> 4; const float* wp = p->w_ada + ((size_t)li * 1024 + ksl * 32) * 6144 + j0 + c4;
      if (has_mod) {
#pragma unroll
          for (int kk = 0; kk < 16; ++kk) wmod[kk] = __builtin_nontemporal_load((const f32x4*)(wp + (size_t)kk * 6144)); } }
    for (int rp_ = 0; rp_ < ((MK_P0REP & 1) ? 3 : 1); ++rp_) { bf16_t* AX = (bf16_t*)(ws + WS_ADFTX); const float SX = 0.0027621358640099513f;
      for (int it = gt; it < 2048 * 256; it += ngt) { const int R = it >> 8, n0 = (it & 255) * 8, cs = R >> 10, k = R & 1023; float v[8];
#pragma unroll
          for (int j = 0; j < 8; ++j) { const int idx = (k * (n0 + j)) & 2047; v[j] = T[cs ? ((idx - 512) & 2047) : idx] * SX; }
          u32x4 o; o.x = cvtpk(v[0], v[1]); o.y = cvtpk(v[2], v[3]); o.z = cvtpk(v[4], v[5]); o.w = cvtpk(v[6], v[7]);
          *(u32x4*)(AX + (size_t)R * 2048 + n0) = o; }
      bf16_t* AC = (bf16_t*)(ws + WS_ADFTC); const float SC = 1.0f / 128.0f;
      for (int it = gt; it < 256 * 32; it += ngt) { const int R = it >> 5, n0 = (it & 31) * 8, cs = R >> 7, k = R & 127; float v[8];
#pragma unroll
          for (int j = 0; j < 8; ++j) { const int idx = (8 * k * (n0 + j)) & 2047; v[j] = T[cs ? ((idx - 512) & 2047) : idx] * SC; }
          u32x4 o; o.x = cvtpk(v[0], v[1]); o.y = cvtpk(v[2], v[3]); o.z = cvtpk(v[4], v[5]); o.w = cvtpk(v[6], v[7]);
          *(u32x4*)(AC + (size_t)R * 256 + n0) = o; } }
    { bf16_t* WH = (bf16_t*)(ws + WS_WRT); bf16_t* WL = WH + 2 * 48 * 1024;
      for (int it = gt; it < 2 * 48 * 1024; it += ngt) { const int k = it & 1023, c = (it >> 10) % 48, li = it / 49152;
          const float w = (c < 4) ? p->w_rg[(size_t)li * 4096 + k * 4 + c] : ((c < 36) ? p->w_re[(size_t)li * 32768 + k * 32 + (c - 4)] : 0.f);
          const unsigned hb = cvtpk(w, 0.f) & 0xffffu; const float lo = w - bf2f((unsigned short)hb);
          WH[it] = (bf16_t)hb; WL[it] = (bf16_t)(cvtpk(lo, 0.f) & 0xffffu); } }
    for (int rp_ = 0; rp_ < ((MK_P0REP & 2) ? 3 : 1); ++rp_) for (int task = cx.vcu; task < 256; task += cx.G) { const int li = task >> 7, g = (task >> 5) & 3, n0 = (task & 31) * 32;
        LAS float* WfT = (LAS float*)cx.lds; LAS float* Wo = (LAS float*)(cx.lds + 65536); LAS float* Gs = (LAS float*)(cx.lds + 98304); LAS float* Pp = (LAS float*)(cx.lds + 106496);
        LDS_BARRIER();
        { const float* wf = p->w_fourier + (size_t)li * 65536 + (size_t)(64 * g) * 256; const float* wo = p->w_out + (size_t)li * 1024 * 1024 + n0;
          const int l = cx.tid & 63, jb = cx.tid >> 6;
          if (!pre_fold) {
#pragma unroll
              for (int r = 0; r < 8; ++r) fv[r] = *(const f32x4*)(wf + (size_t)l * 256 + jb * 32 + 4 * r);
#pragma unroll
              for (int r = 0; r < 4; ++r) { const int pc = cx.tid + 512 * r, j = pc >> 3, q = pc & 7; fo[r] = *(const f32x4*)(wo + (size_t)j * 1024 + q * 4); } }
#pragma unroll
          for (int r = 0; r < 8; ++r)
#pragma unroll
              for (int e = 0; e < 4; ++e) WfT[(jb * 32 + 4 * r + e) * 64 + l] = fv[r][e];
#pragma unroll
          for (int r = 0; r < 4; ++r) { const int pc = cx.tid + 512 * r, j = pc >> 3, q = pc & 7; *(LAS f32x4*)(Wo + j * 32 + q * 4) = fo[r]; } }
        __syncthreads();
        { const int n4 = cx.tid & 7, l4 = (cx.tid >> 3) & 15, kq = cx.tid >> 7; f32x4 acc4[4];
#pragma unroll
          for (int x = 0; x < 4; ++x) acc4[x] = (f32x4){0.f, 0.f, 0.f, 0.f};
#pragma unroll 4
          for (int j = kq * 64; j < kq * 64 + 64; ++j) { const f32x4 av = *(const LAS f32x4*)(WfT + j * 64 + l4 * 4), bv = *(const LAS f32x4*)(Wo + j * 32 + n4 * 4);
#pragma unroll
              for (int x = 0; x < 4; ++x) acc4[x] += bv * av[x]; }
#pragma unroll
          for (int x = 0; x < 4; ++x) *(LAS f32x4*)(Pp + (kq * 64 + l4 * 4 + x) * 32 + n4 * 4) = acc4[x]; }
        __syncthreads();
        { const int o4 = cx.tid * 4; const f32x4 s4 = *(const LAS f32x4*)(Pp + o4) + *(const LAS f32x4*)(Pp + 2048 + o4) + *(const LAS f32x4*)(Pp + 4096 + o4) + *(const LAS f32x4*)(Pp + 6144 + o4);
          *(LAS f32x4*)(Gs + o4) = s4;
          LAS float* Mx = WfT;
#pragma unroll
          for (int r = 0; r < 16; ++r) { const int e = cx.tid + 512 * r, cs2 = e >> 12, l2 = (e >> 6) & 63, c2 = e & 63; const int idx = (32 * l2 * c2) & 2047; Mx[e] = cs2 ? -T[(idx - 512) & 2047] : T[idx]; } }
        __syncthreads();
        { bf16_t* WOUT = (bf16_t*)(ws + WS_WOUT) + (size_t)li * 1024 * 1280; const int n = cx.tid & 31, combo = cx.tid >> 5, cs = combo >> 3, c8 = combo & 7; float a8[8];
          const LAS float* Mx = WfT + cs * 4096 + c8 * 8;
#pragma unroll
          for (int i = 0; i < 8; ++i) a8[i] = 0.f;
#pragma unroll 4
          for (int l = 0; l < 64; ++l) { const float gv = Gs[l * 32 + n]; const f32x4 m0 = *(const LAS f32x4*)(Mx + l * 64), m1 = *(const LAS f32x4*)(Mx + l * 64 + 4);
              a8[0] += m0[0] * gv; a8[1] += m0[1] * gv; a8[2] += m0[2] * gv; a8[3] += m0[3] * gv; a8[4] += m1[0] * gv; a8[5] += m1[1] * gv; a8[6] += m1[2] * gv; a8[7] += m1[3] * gv; }
          u32x4 o; o.x = cvtpk(a8[0], a8[1]); o.y = cvtpk(a8[2], a8[3]); o.z = cvtpk(a8[4], a8[5]); o.w = cvtpk(a8[6], a8[7]);
          *(u32x4*)(WOUT + (size_t)(n0 + n) * 1280 + cs * 256 + 64 * g + c8 * 8) = o; } }
    LDS_BARRIER();
    { float* MOD = (float*)(ws + WS_MOD); LAS float* sl = (LAS float*)cx.lds; LAS float* red = (LAS float*)(cx.lds + 36864);
      if (has_mod) { const int u = cx.vcu, li = u / 96, j0 = (u % 96) * 64, c4 = (cx.tid & 15) * 4, ksl = cx.tid >> 4; const float* wp = p->w_ada + ((size_t)li * 1024 + ksl * 32 + 16) * 6144 + j0 + c4;
#pragma unroll
          for (int kk = 0; kk < 16; ++kk) wmod2[kk] = __builtin_nontemporal_load((const f32x4*)(wp + (size_t)kk * 6144)); }
      LDS_BARRIER();
      for (int i = cx.tid; i < 9 * 1024; i += 512) { const int r = i >> 10, k = i & 1023; const float v = (r < 8) ? p->c[r * 1024 + k] : p->c_ctx[k]; sl[i] = v / (1.f + __expf(-v)); }
      LDS_BARRIER();
      if (has_mod) { const int u = cx.vcu, li = u / 96, j0 = (u % 96) * 64, c4 = (cx.tid & 15) * 4, ksl = cx.tid >> 4; f32x4 a[9];
#pragma unroll
          for (int r = 0; r < 9; ++r) a[r] = (f32x4){0.f, 0.f, 0.f, 0.f};
#pragma unroll
          for (int kk = 0; kk < 16; ++kk)
#pragma unroll
              for (int r = 0; r < 9; ++r) a[r] += wmod[kk] * sl[r * 1024 + ksl * 32 + kk];
#pragma unroll
          for (int kk = 0; kk < 16; ++kk)
#pragma unroll
              for (int r = 0; r < 9; ++r) a[r] += wmod2[kk] * sl[r * 1024 + ksl * 32 + 16 + kk];
#pragma unroll
          for (int r = 0; r < 9; ++r) *(LAS f32x4*)(red + (ksl * 9 + r) * 64 + c4) = a[r];
          LDS_BARRIER();
          for (int o = cx.tid; o < 576; o += 512) { const int r = o >> 6, cj = o & 63; float t2 = p->b_ada[li * 6144 + j0 + cj];
#pragma unroll
              for (int q = 0; q < 32; ++q) t2 += red[(q * 9 + r) * 64 + cj];
              MOD[((size_t)li * 9 + r) * 6144 + j0 + cj] = t2; } }
      LDS_BARRIER(); }
    for (int rp_ = 0; rp_ < ((MK_P0REP & 8) ? 3 : 1); ++rp_) { bf16_t* WIN = (bf16_t*)(ws + WS_WIN); bf16_t* WOUT = (bf16_t*)(ws + WS_WOUT);
      constexpr int I0 = 2 * 1280, I1 = 2 * 384;
      const bool deal = (cx.G == 256); const int ew = (cx.vcu - 192) * 8 + cx.wave, lw = cx.vcu * 8 + cx.wave;
      const int it0 = !deal ? cx.gw : (cx.vcu >= 192 ? ew : ((lw < I0 + I1 - 2048) ? 2048 + lw : I0 + I1)), its = !deal ? cx.ngw : 512, itn = !deal ? I0 + I1 : (cx.vcu >= 192 ? 2048 : ((lw < I0 + I1 - 2048) ? it0 + 1 : it0));
      for (int it = it0; it < itn; it += its) { int r = it;
          if (r < I0) { const int li = r / 1280, q = r % 1280, kb = q / 80, nb = q % 80;
              tr_item(p->w_in + (size_t)li * 1024 * 2560, 2560, kb * 64, nb * 32, WIN + (size_t)li * 2560 * 1024, 1024, kb * 64, 0, scr, cx.lane); continue; } r -= I0;
          { const int li = r / 384, q = r % 384, kb = q / 32, nb = q % 32;
              tr_item(p->w_out + (size_t)li * 1024 * 1024, 1024, 256 + kb * 64, nb * 32, WOUT + (size_t)li * 1024 * 1280, 1280, 512 + kb * 64, 1, scr, cx.lane); } } }
}
constexpr int BG_PER_LAYER = 24576, BG_ALL = 2 * BG_PER_LAYER, BG_STEP = 32;
__device__ __forceinline__ void bg_item(CP* p, int x, LAS float* scr, int lane) {
    unsigned char* ws = p->ws; bf16_t* WGU = (bf16_t*)(ws + WS_WGU); bf16_t* WDN = (bf16_t*)(ws + WS_WD);
    const int li = x / BG_PER_LAYER, y = x % BG_PER_LAYER, type = y >> 13, r = y & 8191, le = li * 32 + (r >> 8), q = r & 255;
    if (type == 0) { const int kb = q >> 4, nb = q & 15; tr_item(p->w_gate + (size_t)le * 1024 * 512, 512, kb * 64, nb * 32, WGU + (size_t)le * 1024 * 1024, 1024, kb * 64, 2, scr, lane); }
    else if (type == 1) { const int kb = q >> 4, nb = q & 15; tr_item(p->w_up + (size_t)le * 1024 * 512, 512, kb * 64, nb * 32, WGU + (size_t)le * 1024 * 1024, 1024, kb * 64, 3, scr, lane); }
    else { const int kb = q >> 5, nb = q & 31; tr_item(p->w_down + (size_t)le * 512 * 1024, 1024, kb * 64, nb * 32, WDN + (size_t)le * 1024 * 512, 512, kb * 64, 4, scr, lane); }
}
__device__ __forceinline__ bool bg_step(CP* p, const Ctx& cx, int limit, int nclaim) {
    volatile LAS int* sel = (volatile LAS int*)(cx.lds + MISC_OFF + 40);
    __syncthreads();
    if (cx.tid == 0) { unsigned* hq = (unsigned*)(p->ws + WS_CTL) + CW_BGQ; int h = BG_ALL; if ((int)xb_ld(hq) < limit) h = (int)xb_add(hq, (unsigned)nclaim); sel[0] = h; }
    __syncthreads();
    const int h = __builtin_amdgcn_readfirstlane(sel[0]);
    if (h >= BG_ALL) return false;
    LAS float* scr = (LAS float*)(cx.lds + cx.wave * 8448);
#pragma unroll 1
    for (int k = 0; k < nclaim / 8; ++k) { const int x = h + cx.wave + 8 * k; if (x < BG_ALL) bg_item(p, x, scr, cx.lane); }
    return h < limit;
}
__device__ __forceinline__ void bg_idle(CP* p, const Ctx& cx, int ph) {
    unsigned* dn = (unsigned*)(p->ws + WS_CTL) + CW_DONE + 64 * ph; volatile LAS int* sel = (volatile LAS int*)(cx.lds + MISC_OFF + 40);
    __syncthreads();
    if (cx.tid == 0) (void)xb_add(dn, 1u);
    for (;;) {
        __syncthreads();
        if (cx.tid == 0) sel[1] = ((int)xb_ld(dn) < cx.G) ? 1 : 0;
        __syncthreads();
        if (!__builtin_amdgcn_readfirstlane(sel[1])) break;
        if (!bg_step(p, cx, BG_ALL, BG_STEP)) break;
    }
}
__device__ __forceinline__ void bg_drain(CP* p, const Ctx& cx, int limit) {
    unsigned* hq = (unsigned*)(p->ws + WS_CTL) + CW_BGQ; volatile LAS int* sel = (volatile LAS int*)(cx.lds + MISC_OFF + 40);
    LAS float* scr = (LAS float*)(cx.lds + cx.wave * 8448);
    for (;;) {
        __syncthreads();
        if (cx.tid == 0) { const int hd = (int)xb_ld(hq); int h = BG_ALL, n = 0;
            if (hd < limit) { n = (((limit - hd + cx.G - 1) / cx.G) + 7) & ~7; n = n < 8 ? 8 : (n > 256 ? 256 : n); h = (int)xb_add(hq, (unsigned)n); }
            sel[0] = h; sel[1] = n; }
        __syncthreads();
        const int h = __builtin_amdgcn_readfirstlane(sel[0]), n = __builtin_amdgcn_readfirstlane(sel[1]);
        if (h >= BG_ALL) break;
#pragma unroll 1
        for (int k = 0; k < n / 8; ++k) { const int x = h + cx.wave + 8 * k; if (x < BG_ALL) bg_item(p, x, scr, cx.lane); }
        if (h >= limit) break;
    }
}
template <int LI0>
__device__ __forceinline__ void phase_norm1_t(CP* p0, const Ctx& cx0) {
    constexpr int li = LI0 ? 0 : 1;
    const Ctx cx = reopaque(cx0); CP* p = opaque_args(p0);
    unsigned char* ws = p->ws; bf16_t* X1 = (bf16_t*)(ws + WS_X1); const bf16_t* Y2 = (const bf16_t*)(ws + WS_Y2); bf16_t* H1 = (bf16_t*)(ws + WS_H1);
    const float* MOD = (const float*)(ws + WS_MOD) + (size_t)li * 9 * 6144; const float* n1 = p->norm1 + li * 1024;
    const int rpw = (MT + cx.ngw - 1) / cx.ngw, mlo = cx.gw * rpw, mhi = (mlo + rpw < MT) ? mlo + rpw : MT;
    if (mlo >= mhi) return;
    const int r0 = (mlo < NX) ? (mlo >> 11) : 8, r1 = ((mhi - 1) < NX) ? ((mhi - 1) >> 11) : 8;
    f32x4 gs0[4], sh0[4], g20[4], gs1[4], sh1[4], g21[4];
    { const float* shp0 = MOD + r0 * 6144; const float* shp1 = MOD + r1 * 6144; const float* g2p0 = MOD - 9 * 6144 + r0 * 6144 + 5 * D; const float* g2p1 = MOD - 9 * 6144 + r1 * 6144 + 5 * D;
#pragma unroll
      for (int j = 0; j < 4; ++j) { const int k = 256 * j + 4 * cx.lane; const f32x4 nw = *(const f32x4*)(n1 + k);
          gs0[j] = nw * (*(const f32x4*)(shp0 + D + k) + 1.0f); sh0[j] = *(const f32x4*)(shp0 + k); gs1[j] = nw * (*(const f32x4*)(shp1 + D + k) + 1.0f); sh1[j] = *(const f32x4*)(shp1 + k);
          g20[j] = (li == 0) ? (f32x4){0.f, 0.f, 0.f, 0.f} : *(const f32x4*)(g2p0 + k); g21[j] = (li == 0) ? (f32x4){0.f, 0.f, 0.f, 0.f} : *(const f32x4*)(g2p1 + k); } }
    f32x4 vaA[4], vaB[4]; u32x2 xaA[4], yaA[4], ybA[4], xaB[4], yaB[4], ybB[4];
#define N1_LOAD(m_, S_) do { if (li == 0) { const float* src_ = ((m_) < NX) ? p->x + (size_t)(m_) * D : p->ctx + (size_t)((m_) - NX) * D; \
            _Pragma("unroll") for (int j_ = 0; j_ < 4; ++j_) va##S_[j_] = __builtin_nontemporal_load((const f32x4*)(src_ + 256 * j_ + 4 * cx.lane)); } \
        else { const bf16_t* xr_ = X1 + (size_t)(m_) * D; const bf16_t* yr_ = Y2 + (size_t)(m_) * 2 * D; \
            _Pragma("unroll") for (int j_ = 0; j_ < 4; ++j_) { const int k_ = 256 * j_ + 4 * cx.lane; xa##S_[j_] = *(const u32x2*)(xr_ + k_); ya##S_[j_] = *(const u32x2*)(yr_ + k_); yb##S_[j_] = *(const u32x2*)(yr_ + D + k_); } } } while (0)
#define N1_ROW(m_, S_) do { const int m = (m_); \
        const bool hi = (((m < NX) ? (m >> 11) : 8) != r0); \
        f32x4 v[4]; \
        _Pragma("unroll") for (int j = 0; j < 4; ++j) { if (li == 0) v[j] = va##S_[j]; \
            else v[j] = (f32x4){bflo(xa##S_[j].x), bfhi(xa##S_[j].x), bflo(xa##S_[j].y), bfhi(xa##S_[j].y)} + (hi ? g21[j] : g20[j]) * (f32x4){bflo(ya##S_[j].x) + bflo(yb##S_[j].x), bfhi(ya##S_[j].x) + bfhi(yb##S_[j].x), bflo(ya##S_[j].y) + bflo(yb##S_[j].y), bfhi(ya##S_[j].y) + bfhi(yb##S_[j].y)}; } \
        if (m + 2 < mhi) N1_LOAD(m + 2, S_); \
        if (li != 0) { \
            _Pragma("unroll") for (int j = 0; j < 4; ++j) { u32x2 w; w.x = cvtpk(v[j][0], v[j][1]); w.y = cvtpk(v[j][2], v[j][3]); *(u32x2*)(X1 + (size_t)m * D + 256 * j + 4 * cx.lane) = w; } } \
        float ss = 0.f; \
        _Pragma("unroll") for (int j = 0; j < 4; ++j) ss += v[j][0] * v[j][0] + v[j][1] * v[j][1] + v[j][2] * v[j][2] + v[j][3] * v[j][3]; \
        const float r = 1.0f / sqrtf(wave_sum(ss) * (1.0f / D) + 1e-6f); \
        _Pragma("unroll") for (int j = 0; j < 4; ++j) { const f32x4 o = v[j] * r * (hi ? gs1[j] : gs0[j]) + (hi ? sh1[j] : sh0[j]); u32x2 w; w.x = cvtpk(o[0], o[1]); w.y = cvtpk(o[2], o[3]); \
            *(u32x2*)(H1 + (size_t)m * D + 256 * j + 4 * cx.lane) = w; } } while (0)
    N1_LOAD(mlo, A);
    if (mlo + 1 < mhi) N1_LOAD(mlo + 1, B);
#pragma unroll 1
    for (int mm = mlo; mm < mhi; mm += 2) {
        N1_ROW(mm, A);
        if (mm + 1 < mhi) N1_ROW(mm + 1, B);
    }
#undef N1_ROW
#undef N1_LOAD
}
__device__ __forceinline__ void phase_norm1(CP* p0, const Ctx& cx0, int li) { if (li == 0) phase_norm1_t<1>(p0, cx0); else phase_norm1_t<0>(p0, cx0); }
__device__ __forceinline__ void phase_inproj(CP* p0, const Ctx& cx0, int li, int ph) {
    const Ctx cx = reopaque(cx0); CP* p = opaque_args(p0);
    unsigned char* ws = p->ws; const bf16_t* H1 = (const bf16_t*)(ws + WS_H1); const bf16_t* WIN = (const bf16_t*)(ws + WS_WIN) + (size_t)li * 2560 * 1024;
    pg8::SchedInproj S; S.R.init(H1, WIN + (size_t)768 * 1024, MT, NU, D, cx.G, (int)blockIdx.x); S.G = cx.G; S.c = (int)blockIdx.x; S.A1 = (const char*)WIN; S.B1 = (const char*)H1;
    pg8::EpiInproj E{(bf16_t*)(ws + WS_U), (bf16_t*)(ws + WS_FTX), (bf16_t*)(ws + WS_FTC), (bf16_t*)(ws + WS_VTX), (bf16_t*)(ws + WS_VTC)};
    pg8::gemm_phase<pg8::EpiInproj, pg8::SchedInproj, false, true, D>(cx.lds, S, E);
    (void)ph;
}
struct AttnPtrs { const bf16_t* U; const bf16_t* vtx; const bf16_t* vtc; bf16_t* conc; };
__device__ __forceinline__ void attn_dma_step(const AttnPtrs& a, int t, int b, int h, int krlo, int wave, int lane, LAS unsigned char* slot) {
    const bf16_t* kp; const bf16_t* vp; size_t vpitch;
    if (t < 4) { kp = a.U + (size_t)(NX + b * 256 + 64 * t) * NU + 512 + h * 64; vp = a.vtc + ((size_t)b * 512 + h * 64) * 256 + 64 * t; vpitch = 256; }
    else { const int t0 = 64 * (krlo + t - 4); kp = a.U + (size_t)(b * 2048 + t0) * NU + 512 + h * 64; vp = a.vtx + ((size_t)b * 512 + h * 64) * 2048 + t0; vpitch = 2048; }
    const int r = 8 * wave + (lane >> 3);
    __builtin_amdgcn_global_load_lds((const unsigned*)(kp + (size_t)r * NU + 8 * ((lane & 7) ^ (r & 7))), (LAS unsigned*)(slot + wave * 1024), 16, 0, 0);
    __builtin_amdgcn_global_load_lds((const unsigned*)(vp + (size_t)r * vpitch + 8 * ((lane & 7) ^ ((r >> 1) & 7))), (LAS unsigned*)(slot + 8192 + wave * 1024), 16, 0, 0);
}
__device__ __forceinline__ void attn_frags(const LAS unsigned char* sl, int kb0, int lane, bf16x8 (&kf)[4], bf16x8 (&vf)[4]) {
    const int q = lane & 31, hh = lane >> 5, key = kb0 + q;
#pragma unroll
    for (int s = 0; s < 4; ++s) kf[s] = *(const LAS bf16x8*)(sl + key * 128 + (((2 * s + hh) ^ (key & 7)) << 4));
#pragma unroll
    for (int s2 = 0; s2 < 2; ++s2)
#pragma unroll
        for (int dh = 0; dh < 2; ++dh) { const int d = 32 * dh + q, fd = (d >> 1) & 7, ch = (kb0 >> 3) + 2 * s2;
            const bf16x4 lo = *(const LAS bf16x4*)(sl + 8192 + d * 128 + ((ch ^ fd) << 4) + (hh << 3)), hi = *(const LAS bf16x4*)(sl + 8192 + d * 128 + (((ch + 1) ^ fd) << 4) + (hh << 3));
            vf[s2 * 2 + dh] = (bf16x8){lo[0], lo[1], lo[2], lo[3], hi[0], hi[1], hi[2], hi[3]}; }
}
#define ATT_COMPUTE(loc_, kr_, kf_, vf_) do { \
    f32x16 s_; \
    if (loc_) { const bool rok_ = ((kr_) >= rsq) && ((kr_) < rsq + 8); int ro_ = (kr_) - rq + 7; ro_ = ro_ < 0 ? 0 : (ro_ > 14 ? 14 : ro_); \
        const LAS float* bp_ = tblh + ro_ * 64 + cbase; const float rp_ = rok_ ? 0.f : -1e30f; \
        _Pragma("unroll") for (int i_ = 0; i_ < 16; ++i_) s_[i_] = bp_[(i_ & 3) + 8 * (i_ >> 2)] + colpen[i_] + rp_; } \
    else { _Pragma("unroll") for (int i_ = 0; i_ < 16; ++i_) s_[i_] = 0.f; } \
    _Pragma("unroll") for (int k_ = 0; k_ < 4; ++k_) s_ = __builtin_amdgcn_mfma_f32_32x32x16_bf16(kf_[k_], qf[k_], s_, 0, 0, 0); \
    float cm_ = s_[0]; \
    _Pragma("unroll") for (int i_ = 1; i_ < 16; ++i_) cm_ = fmaxf(cm_, s_[i_]); \
    if (__any(cm_ > mrun + 8.0f)) {     \
        cm_ = fmaxf(cm_, __shfl_xor(cm_, 32)); \
        const float mn_ = fmaxf(mrun, cm_); const float al_ = __builtin_amdgcn_exp2f(mrun - mn_); mrun = mn_; lsum *= al_; \
        _Pragma("unroll") for (int i_ = 0; i_ < 16; ++i_) { o0[i_] *= al_; o1[i_] *= al_; } } \
    float ps_ = 0.f; \
    _Pragma("unroll") for (int i_ = 0; i_ < 16; ++i_) { s_[i_] = __builtin_amdgcn_exp2f(s_[i_] - mrun); ps_ += s_[i_]; } \
    lsum += ps_; \
    bf16x8 p0_, p1_; { u32x4 w_; w_.x = cvtpk(s_[0], s_[1]); w_.y = cvtpk(s_[2], s_[3]); w_.z = cvtpk(s_[4], s_[5]); w_.w = cvtpk(s_[6], s_[7]); p0_ = __builtin_bit_cast(bf16x8, w_); \
        w_.x = cvtpk(s_[8], s_[9]); w_.y = cvtpk(s_[10], s_[11]); w_.z = cvtpk(s_[12], s_[13]); w_.w = cvtpk(s_[14], s_[15]); p1_ = __builtin_bit_cast(bf16x8, w_); } \
    o0 = __builtin_amdgcn_mfma_f32_32x32x16_bf16(vf_[0], p0_, o0, 0, 0, 0); o1 = __builtin_amdgcn_mfma_f32_32x32x16_bf16(vf_[1], p0_, o1, 0, 0, 0); \
    o0 = __builtin_amdgcn_mfma_f32_32x32x16_bf16(vf_[2], p1_, o0, 0, 0, 0); o1 = __builtin_amdgcn_mfma_f32_32x32x16_bf16(vf_[3], p1_, o1, 0, 0, 0); \
} while (0)

__device__ __forceinline__ void attn_group(const AttnPtrs& a, const LAS float* tbl, LAS unsigned char* ring, int qi, int gid, int wave, int lane) {
    const int q = lane & 31, hh = lane >> 5;
    int b, h, nsteps, krlo = 0, kr0 = 0, nl = 0, bs = 0, rq = 0, rsq = 0, cq = 0, csq = 0; size_t qrow;
    if (gid < 64) {
        const int pair = qi * 8 + ((gid < 48) ? gid / 6 : ((gid - 48) >> 1)), g4 = (gid < 48) ? 1 + gid % 6 : (((gid - 48) & 1) ? 7 : 0), rp = 2 * g4 + (wave >> 2), cb = wave & 3; b = pair >> 3; h = pair & 7;
        rq = 2 * rp + (q >> 4); cq = 16 * cb + (q & 15);
        rsq = rq - 4; rsq = rsq < 0 ? 0 : (rsq > 24 ? 24 : rsq); csq = cq - 8; csq = csq < 0 ? 0 : (csq > 48 ? 48 : csq);
        kr0 = 2 * rp - 4; kr0 = kr0 < 0 ? 0 : (kr0 > 24 ? 24 : kr0); int kr1 = 2 * rp + 1 - 4; kr1 = kr1 < 0 ? 0 : (kr1 > 24 ? 24 : kr1); nl = kr1 + 8 - kr0;
        krlo = 4 * g4 - 4; krlo = krlo < 0 ? 0 : (krlo > 24 ? 24 : krlo); int krhi = 4 * g4 + 3 - 4; krhi = krhi < 0 ? 0 : (krhi > 24 ? 24 : krhi); nsteps = 4 + (krhi + 8 - krlo);
        bs = (cb == 0) ? 0 : (cb == 1 ? 8 : (cb == 2 ? 24 : 32));
        qrow = (size_t)b * 2048 + 64 * rq + cq; }
    else { const int pair = qi * 8 + (gid - 64); b = pair >> 3; h = pair & 7; nsteps = 4; qrow = (size_t)NX + b * 256 + 32 * wave + q; }
    bf16x8 qf[4];
#pragma unroll
    for (int s = 0; s < 4; ++s) qf[s] = *(const bf16x8*)(a.U + qrow * NU + h * 64 + 16 * s + 8 * hh);
    attn_dma_step(a, 0, b, h, krlo, wave, lane, ring);
    attn_dma_step(a, 1, b, h, krlo, wave, lane, ring + 16384);
    asm volatile("s_waitcnt vmcnt(4)" : "+v"(qf[0]), "+v"(qf[1]), "+v"(qf[2]), "+v"(qf[3]) :: "memory");
    float colpen[16];
#pragma unroll
    for (int i = 0; i < 16; ++i) { const int kc = bs + (i & 3) + 8 * (i >> 2) + 4 * hh; colpen[i] = (kc >= csq && kc < csq + 16) ? 0.f : -1e30f; }
    const LAS float* tblh = tbl + h * (15 * 64); const int cbase = bs - cq + 15 + 16 + 4 * hh;
    f32x16 o0, o1;
#pragma unroll
    for (int i = 0; i < 16; ++i) { o0[i] = 0.f; o1[i] = 0.f; }
    float mrun = -1e30f, lsum = 0.f;
    bf16x8 kf[4], vf[4];
    int slot_t = 0, slot_n = 2;
#pragma unroll 1
    for (int t = 0; t < nsteps; ++t) {
        if (t + 1 < nsteps) asm volatile("s_waitcnt vmcnt(2)" ::: "memory"); else asm volatile("s_waitcnt vmcnt(0)" ::: "memory");
        __builtin_amdgcn_s_barrier();
        if (t + 2 < nsteps) attn_dma_step(a, t + 2, b, h, krlo, wave, lane, ring + slot_n * 16384);
        const LAS unsigned char* sl = ring + slot_t * 16384;
        const bool loc = (t >= 4); const int kr = krlo + t - 4;
        const int nsub = loc ? ((kr >= kr0 && kr < kr0 + nl) ? 1 : 0) : 2;
#pragma unroll 1
        for (int sub = 0; sub < nsub; ++sub) {
            attn_frags(sl, loc ? bs : 32 * sub, lane, kf, vf); asm volatile("s_waitcnt lgkmcnt(0)" ::: "memory"); __builtin_amdgcn_sched_barrier(0);
            ATT_COMPUTE(loc, kr, kf, vf); }
        slot_t = (slot_t == 2) ? 0 : slot_t + 1; slot_n = (slot_n == 2) ? 0 : slot_n + 1;
    }
    const float inv = 1.0f / (lsum + __shfl_xor(lsum, 32));
    bf16_t* op = a.conc + qrow * KO + 512 + h * 64 + 4 * hh;
#pragma unroll
    for (int g = 0; g < 4; ++g) { u32x2 w; w.x = cvtpk(o0[4 * g] * inv, o0[4 * g + 1] * inv); w.y = cvtpk(o0[4 * g + 2] * inv, o0[4 * g + 3] * inv); *(u32x2*)(op + 8 * g) = w;
        w.x = cvtpk(o1[4 * g] * inv, o1[4 * g + 1] * inv); w.y = cvtpk(o1[4 * g + 2] * inv, o1[4 * g + 3] * inv); *(u32x2*)(op + 32 + 8 * g) = w; }
}
__device__ __forceinline__ void phase_mix(CP* p0, const Ctx& cx0, int li, int rep, int ph) {
    const Ctx cx = reopaque(cx0); CP* p = opaque_args(p0);
    unsigned char* ws = p->ws; const bf16_t* U = (const bf16_t*)(ws + WS_U); bf16_t* CONC = (bf16_t*)(ws + WS_CONC);
    const int nrows = (li == 0) ? MT : NX;
    const int nd = (li == 0) ? 72 : 64; const bool isd = ((int)blockIdx.x < nd) && (cx.G == 256);
    const int Iall = nrows * 32, Ia = (cx.G == 256) ? ((Iall >> 2) & ~511) : Iall;
    const float* wc = p->w_conv + li * 768;
    auto conv_items = [&](int first, int last, int stride) { for (int it = first; it < last; it += stride) { const int m = it >> 5, c0 = (it & 31) * 8;
          const int pos = (m < NX) ? (m & 2047) : ((m - NX) & 255), len = (m < NX) ? 2048 : 256;
          const bf16_t* up = U + (size_t)m * NU; float z[3][8];
#pragma unroll
          for (int d = 0; d < 3; ++d) { const bool ok = (pos + d - 1 >= 0) && (pos + d - 1 < len);
              const ptrdiff_t ro = ok ? (ptrdiff_t)(d - 1) * NU : (ptrdiff_t)0; const float zf = ok ? 1.f : 0.f;
              const u32x4 a = *(const u32x4*)(up + ro + 1280 + c0), b = *(const u32x4*)(up + ro + 1536 + c0);
              z[d][0] = zf * bflo(a.x) * bflo(b.x); z[d][1] = zf * bfhi(a.x) * bfhi(b.x); z[d][2] = zf * bflo(a.y) * bflo(b.y); z[d][3] = zf * bfhi(a.y) * bfhi(b.y);
              z[d][4] = zf * bflo(a.z) * bflo(b.z); z[d][5] = zf * bfhi(a.z) * bfhi(b.z); z[d][6] = zf * bflo(a.w) * bflo(b.w); z[d][7] = zf * bfhi(a.w) * bfhi(b.w); }
          const u32x4 g = *(const u32x4*)(up + 1024 + c0); float gb[8] = {bflo(g.x), bfhi(g.x), bflo(g.y), bfhi(g.y), bflo(g.z), bfhi(g.z), bflo(g.w), bfhi(g.w)}; float o[8];
#pragma unroll
          for (int j = 0; j < 8; ++j) o[j] = gb[j] * (wc[c0 + j] * z[0][j] + wc[256 + c0 + j] * z[1][j] + wc[512 + c0 + j] * z[2][j]);
          u32x4 w; w.x = cvtpk(o[0], o[1]); w.y = cvtpk(o[2], o[3]); w.z = cvtpk(o[4], o[5]); w.w = cvtpk(o[6], o[7]);
          *(u32x4*)(CONC + (size_t)m * KO + 1024 + c0) = w; } };
    if (cx.G != 256) conv_items(cx.vcu * 512 + cx.tid, Iall, cx.G * 512);
    else if (!isd) conv_items(((int)blockIdx.x - nd) * 512 + cx.tid, Ia, (cx.G - nd) * 512);
    const bf16_t* FTX = (const bf16_t*)(ws + WS_FTX); const bf16_t* FTC = (const bf16_t*)(ws + WS_FTC); const int ntask = (li == 0) ? 512 : 256;
      auto nyq_tasks = [&](int first, int step) { for (int tk = first; tk < ntask; tk += step) { const bool cxm = tk >= 256; const int b = (tk & 255) >> 5, ch0 = (tk & 31) * 8; float sm[8];
          if (!cxm) { u32x4 v[8][4];
#pragma unroll
              for (int c = 0; c < 8; ++c) { const bf16_t* fp = FTX + ((size_t)(b * 256 + ch0 + c)) * 2048 + 8 * cx.lane;
#pragma unroll
                  for (int q = 0; q < 4; ++q) v[c][q] = *(const u32x4*)(fp + 512 * q); }
#pragma unroll
              for (int c = 0; c < 8; ++c) { float a = 0.f;
#pragma unroll
                  for (int q = 0; q < 4; ++q) a += (bflo(v[c][q].x) - bfhi(v[c][q].x)) + (bflo(v[c][q].y) - bfhi(v[c][q].y)) + (bflo(v[c][q].z) - bfhi(v[c][q].z)) + (bflo(v[c][q].w) - bfhi(v[c][q].w));
                  sm[c] = wave_sum(a) * 0.0027621358640099513f; } }
          else { u32x2 v[8];
#pragma unroll
              for (int c = 0; c < 8; ++c) v[c] = *(const u32x2*)(FTC + ((size_t)(b * 256 + ch0 + c)) * 256 + 4 * cx.lane);
#pragma unroll
              for (int c = 0; c < 8; ++c) sm[c] = wave_sum((bflo(v[c].x) - bfhi(v[c].x)) + (bflo(v[c].y) - bfhi(v[c].y))) * (1.0f / 128.0f); }
          if (cx.lane == 0) { bf16_t* dst = CONC + (cxm ? ((size_t)NX + b * 256 + 128) : ((size_t)b * 2048 + 1024)) * KO + ch0;
              u32x4 w; w.x = cvtpk(sm[0], sm[1]); w.y = cvtpk(sm[2], sm[3]); w.z = cvtpk(sm[4], sm[5]); w.w = cvtpk(sm[6], sm[7]);
              unsigned z0 = 0u; asm volatile("" : "+v"(z0));
              *(u32x4*)dst = w; *(u32x4*)(dst + 256) = (u32x4){z0, z0, z0, z0}; } } };
      if (cx.G != 256) nyq_tasks(((cx.gw & 3) == 0) ? (cx.gw >> 2) : ntask, cx.ngw >> 2);
    for (int rp_ = 0; rp_ < ((MK_MIXREP & 1) ? 3 : 1); ++rp_) if (!(MK_SUB & 4)) { const int c = (int)blockIdx.x;
      pg8::SchedOne S; int Kd = 2048; pg8::EpiDft E{CONC, 0};
      if (c < 64) { S.has = true; S.u0.pm = c >> 3; S.u0.pn = c & 7; S.u0.aux = 0;
          S.u0.A = (const char*)(ws + WS_ADFTX) + (size_t)(c >> 3) * 256 * 2048 * 2; S.u0.B = (const char*)(ws + WS_FTX) + (size_t)(c & 7) * 256 * 2048 * 2; }
      else { const int c2 = c - 64; S.has = (li == 0 && c2 < 8); S.u0.pm = 0; S.u0.pn = c2 & 7; S.u0.aux = 0; Kd = 256; E.conc = CONC + (size_t)NX * KO; E.ctxmode = 1;
          S.u0.A = (const char*)(ws + WS_ADFTC); S.u0.B = (const char*)(ws + WS_FTC) + (size_t)(c2 & 7) * 256 * 256 * 2; }
      pg8::gemm_phase<pg8::EpiDft, pg8::SchedOne, false, false, 0>(cx.lds, S, E, Kd); }
    if (isd) conv_items(Ia + (int)blockIdx.x * 512 + cx.tid, Iall, nd * 512);
    if (cx.G == 256 && (int)blockIdx.x < 64) nyq_tasks((int)blockIdx.x * 8 + cx.wave, 512);
    for (int rp_ = 0; rp_ < ((MK_MIXREP & 2) ? 3 : 1); ++rp_) if (!(MK_SUB & 8)) { LAS float* tbl = (LAS float*)(cx.lds + MISC_OFF + 64);
      __syncthreads();
#pragma unroll
      for (int it = 0; it < 15; ++it) { const int i = cx.tid + 512 * it, col = (i & 63) - 16, ro = (i >> 6) % 15, h = i / 960, cc = col < 0 ? 0 : (col > 30 ? 30 : col);
          const float v = p->rpb[(size_t)li * 3720 + h * 465 + ro * 31 + cc];
          tbl[i] = (col >= 0 && col <= 30) ? v * LOG2E : 0.f; }
      __syncthreads();
      AttnPtrs a{U, (const bf16_t*)(ws + WS_VTX), (const bf16_t*)(ws + WS_VTC), CONC};
      unsigned* qw = (unsigned*)(ws + WS_CTL) + CW_ATTQ + li * 512 + rep * 1024 + rp_ * 1024;
      volatile LAS int* gsel = (volatile LAS int*)(cx.lds + MISC_OFF + 32);
      const int nper = (li == 0) ? 72 : 64; const int q0 = (int)(xb_xcc_id() & 7u);
      bool own = true;
      for (;;) {
          __syncthreads();
          if (cx.wave == 0) {
              int g = -2, qi = q0;
              if (own) { if (cx.lane == 0) g = (int)xb_add(qw + q0 * 64, 1u); g = __builtin_amdgcn_readfirstlane(g); if (g >= nper) g = -2; }
              if (g == -2) {
                  int head = nper; if (cx.lane < 8) head = (int)xb_ld(qw + ((q0 + cx.lane) & 7) * 64);
                  const unsigned long long m = __ballot(head < nper);
                  if (m) { qi = (q0 + (int)__builtin_ctzll(m)) & 7; if (cx.lane == 0) g = (int)xb_add(qw + qi * 64, 1u); g = __builtin_amdgcn_readfirstlane(g); if (g >= nper) g = -2; } else g = -1; }
              if (cx.lane == 0) { gsel[0] = g; gsel[1] = qi; } }
          __syncthreads();
          const int gid = __builtin_amdgcn_readfirstlane(gsel[0]), qi = __builtin_amdgcn_readfirstlane(gsel[1]);
          if (gid == -1) break;
          if (qi != q0 || gid == -2) own = false;
          if (gid == -2) continue;
          attn_group(a, tbl, cx.lds, qi, gid, cx.wave, cx.lane); } }
    (void)ph;
}
__device__ __forceinline__ void phase_outproj(CP* p0, const Ctx& cx0, int li, int ph) {
    const Ctx cx = reopaque(cx0); CP* p = opaque_args(p0);
    unsigned char* ws = p->ws;
    pg8::SchedRect S; S.init(ws + WS_CONC, (const bf16_t*)(ws + WS_WOUT) + (size_t)li * 1024 * 1280, (li == 0) ? MT : NX, D, KO, cx.G, (int)blockIdx.x);
    pg8::EpiOut E{(bf16_t*)(ws + WS_X1), (li == 0) ? p->x : nullptr, (li == 0) ? p->ctx : nullptr, (const float*)(ws + WS_MOD) + (size_t)li * 9 * 6144};
    pg8::gemm_phase<pg8::EpiOut, pg8::SchedRect, false, true, KO>(cx.lds, S, E);
    if (li == 0) bg_idle(p, cx, ph);
}
__device__ __forceinline__ void phase_router(CP* p0, const Ctx& cx0, int li, int dummy) {
    const Ctx cx = reopaque(cx0); CP* p = opaque_args(p0);
    unsigned char* ws = p->ws; const bf16_t* X1 = (const bf16_t*)(ws + WS_X1); bf16_t* TT = (bf16_t*)(ws + WS_H1);
    const float* MOD = (const float*)(ws + WS_MOD) + (size_t)li * 9 * 6144; const float* n2 = p->norm2 + li * 1024;
    const bf16_t* WH = (const bf16_t*)(ws + WS_WRT) + (size_t)li * 48 * 1024; const bf16_t* WL = WH + 2 * 48 * 1024;
    const int M = (li == 0) ? MT : NX; const int RB = (M + cx.G - 1) / cx.G;
    const int RPW = (RB + 7) >> 3;
    const int row0 = cx.vcu * RB;
    LAS float* lg = (LAS float*)cx.lds;
    LAS int* lcnt = (LAS int*)(cx.lds + 12288); LAS int* lbase = (LAS int*)(cx.lds + 12544);
    LAS unsigned char* wb = cx.lds + 16384;
    LAS unsigned char* wa = cx.lds + 16384 + 2 * 48 * 528 + cx.wave * (2 * 9 * 528);
    __syncthreads();
    if (cx.tid < 32) lcnt[cx.tid] = 0;
    u32x4 wreg[6];
#define RT_WLOAD(ii) do { _Pragma("unroll") for (int r_ = 0; r_ < 6; ++r_) { const int p_ = cx.tid + 512 * r_, hl_ = p_ / 1536, q_ = p_ % 1536, c_ = q_ >> 5, k16_ = q_ & 31; \
        wreg[r_] = *(const u32x4*)((hl_ ? WL : WH) + (size_t)c_ * 1024 + 256 * (ii) + 8 * k16_); } } while (0)
#define RT_WSTORE() do { _Pragma("unroll") for (int r_ = 0; r_ < 6; ++r_) { const int p_ = cx.tid + 512 * r_, hl_ = p_ / 1536, q_ = p_ % 1536, c_ = q_ >> 5, k16_ = q_ & 31; \
        *(LAS u32x4*)(wb + hl_ * (48 * 528) + c_ * 528 + 16 * k16_) = wreg[r_]; } } while (0)
    RT_WLOAD(0);
    u32x2 xr[9][4]; float rinv[9];
#pragma unroll
    for (int j = 0; j < 9; ++j) { const int rl = cx.wave * RPW + j; int m = row0 + rl; const bool ok = (j < RPW) && (rl < RB) && (m < M); if (!ok) m = row0 < M ? row0 : 0;
#pragma unroll
        for (int i = 0; i < 4; ++i) xr[j][i] = *(const u32x2*)(X1 + (size_t)m * D + 256 * i + 4 * cx.lane); }
#pragma unroll
    for (int j = 0; j < 9; ++j) { float ss = 0.f;
#pragma unroll
        for (int i = 0; i < 4; ++i) { const float a0 = bflo(xr[j][i].x), a1 = bfhi(xr[j][i].x), a2 = bflo(xr[j][i].y), a3 = bfhi(xr[j][i].y); ss += a0 * a0 + a1 * a1 + a2 * a2 + a3 * a3; }
        rinv[j] = __uint_as_float((unsigned)__builtin_amdgcn_readfirstlane((int)__float_as_uint(1.0f / sqrtf(wave_sum(ss) * (1.0f / D) + 1e-6f)))); }
    int r0, r1; { const int rl0 = cx.wave * RPW; int mf = row0 + rl0, ml = row0 + rl0 + RPW - 1; const int mend = (row0 + RB < M ? row0 + RB : M) - 1;
        if (ml > mend) ml = mend; if (rl0 >= RB || mf > mend) { mf = row0 < M ? row0 : 0; ml = mf; }
        r0 = (mf < NX) ? (mf >> 11) : 8; r1 = (ml < NX) ? (ml >> 11) : 8; }
    f32x4 acc[3];
#pragma unroll
    for (int nt = 0; nt < 3; ++nt) acc[nt] = (f32x4){0.f, 0.f, 0.f, 0.f};
    const int col = cx.lane & 15, kq = cx.lane >> 4, rA = (col < 9) ? col : 8;
#pragma unroll
    for (int i = 0; i < 4; ++i) {
        const int k = 256 * i + 4 * cx.lane; const f32x4 g = *(const f32x4*)(n2 + k);
        const float* sh0 = MOD + r0 * 6144 + 3 * D; const float* sh1 = MOD + r1 * 6144 + 3 * D;
        const f32x4 sa0 = *(const f32x4*)(sh0 + D + k), hs0 = *(const f32x4*)(sh0 + k), sa1 = *(const f32x4*)(sh1 + D + k), hs1 = *(const f32x4*)(sh1 + k);
        if (i > 0) LDS_BARRIER();
        RT_WSTORE();
        if (i < 3) RT_WLOAD(i + 1);
        const f32x4 gs0 = g * (sa0 + 1.0f), gs1 = g * (sa1 + 1.0f);
#define RT_ROW(j, ga_, hb_) do { const f32x4 v = (f32x4){bflo(xr[j][i].x), bfhi(xr[j][i].x), bflo(xr[j][i].y), bfhi(xr[j][i].y)}; \
            const f32x4 t = v * rinv[j] * (ga_) + (hb_); \
            u32x2 h, l; h.x = cvtpk(t[0], t[1]); h.y = cvtpk(t[2], t[3]); \
            if (ok) *(u32x2*)(TT + (size_t)m * D + k) = h; \
            l.x = cvtpk(t[0] - bflo(h.x), t[1] - bfhi(h.x)); l.y = cvtpk(t[2] - bflo(h.y), t[3] - bfhi(h.y)); \
            *(LAS u32x2*)(wa + j * 528 + 8 * cx.lane) = h; *(LAS u32x2*)(wa + (9 + j) * 528 + 8 * cx.lane) = l; } while (0)
#pragma unroll
        for (int j = 0; j < 9; ++j) { const int rl = cx.wave * RPW + j; int m = row0 + rl; const bool ok = (j < RPW) && (rl < RB) && (m < M); if (!ok) m = row0 < M ? row0 : 0;
            const bool hi = (((m < NX) ? (m >> 11) : 8) != r0);
            const f32x4 ga = hi ? gs1 : gs0, hb = hi ? hs1 : hs0;
            RT_ROW(j, ga, hb); }
#undef RT_ROW
        LDS_BARRIER();
#pragma unroll
        for (int ks = 0; ks < 8; ++ks) {
            const bf16x8 ah = *(const LAS bf16x8*)(wa + rA * 528 + (32 * ks + 8 * kq) * 2), al = *(const LAS bf16x8*)(wa + (9 + rA) * 528 + (32 * ks + 8 * kq) * 2); bf16x8 bh[3], bl[3];
#pragma unroll
            for (int nt = 0; nt < 3; ++nt) { const int wo = (16 * nt + col) * 528 + (32 * ks + 8 * kq) * 2; bh[nt] = *(const LAS bf16x8*)(wb + wo); bl[nt] = *(const LAS bf16x8*)(wb + 48 * 528 + wo); }
            asm volatile("s_waitcnt lgkmcnt(0)" ::: "memory"); __builtin_amdgcn_sched_barrier(0);
#pragma unroll
            for (int nt = 0; nt < 3; ++nt) acc[nt] = __builtin_amdgcn_mfma_f32_16x16x32_bf16(ah, bh[nt], acc[nt], 0, 0, 0);
#pragma unroll
            for (int nt = 0; nt < 3; ++nt) acc[nt] = __builtin_amdgcn_mfma_f32_16x16x32_bf16(ah, bl[nt], acc[nt], 0, 0, 0);
#pragma unroll
            for (int nt = 0; nt < 3; ++nt) acc[nt] = __builtin_amdgcn_mfma_f32_16x16x32_bf16(al, bh[nt], acc[nt], 0, 0, 0);
            __builtin_amdgcn_sched_barrier(0); }
    }
#undef RT_WLOAD
#undef RT_WSTORE
#pragma unroll
    for (int nt = 0; nt < 3; ++nt)
#pragma unroll
        for (int r = 0; r < 4; ++r) { const int row = kq * 4 + r, c = 16 * nt + col; if (row < RPW && c < 36 && cx.wave * RPW + row < 72) lg[(cx.wave * RPW + row) * 36 + c] = acc[nt][r]; }
    __syncthreads();
    int e0 = 0, e1 = 0, lr0 = 0, lr1 = 0; float w0 = 0.f, w1 = 0.f; const bool act = (cx.tid < RB) && (row0 + cx.tid < M) && (cx.tid < 72);
    if (act) { const LAS float* l = lg + cx.tid * 36; float gl[4];
#pragma unroll
        for (int i = 0; i < 4; ++i) gl[i] = l[i] + p->b_rg[li * 4 + i];
        int gi = 0; float gm = gl[0];
#pragma unroll
        for (int i = 1; i < 4; ++i) if (gl[i] > gm) { gm = gl[i]; gi = i; }
        float gs = 0.f;
#pragma unroll
        for (int i = 0; i < 4; ++i) gs += __expf(gl[i] - gm);
        const float gw = 1.0f / gs;
        float ev[8];
#pragma unroll
        for (int i = 0; i < 8; ++i) ev[i] = l[4 + gi * 8 + i] + p->b_re[li * 32 + gi * 8 + i];
        int i0 = 0; float v0 = ev[0];
#pragma unroll
        for (int i = 1; i < 8; ++i) if (ev[i] > v0) { v0 = ev[i]; i0 = i; }
        int i1 = -1; float v1 = 0.f;
#pragma unroll
        for (int i = 0; i < 8; ++i) if (i != i0 && (i1 < 0 || ev[i] > v1)) { v1 = ev[i]; i1 = i; }
        const float ex = __expf(v1 - v0); w0 = gw / (1.f + ex); w1 = gw * ex / (1.f + ex);
        e0 = gi * 8 + i0; e1 = gi * 8 + i1;
        lr0 = __hip_atomic_fetch_add(&lcnt[e0], 1, __ATOMIC_RELAXED, __HIP_MEMORY_SCOPE_WORKGROUP); lr1 = __hip_atomic_fetch_add(&lcnt[e1], 1, __ATOMIC_RELAXED, __HIP_MEMORY_SCOPE_WORKGROUP); }
    __syncthreads();
    if (cx.tid < 32) { const int n = lcnt[cx.tid]; int base = 0; if (n > 0) base = (int)xb_add((unsigned*)(ws + WS_CTL) + CW_CNT + li * 2048 + cx.tid * 64 + dummy * 4096, (unsigned)n); lbase[cx.tid] = base; }
    if (cx.tid == 64) lbase[32] = (int)xb_ld((unsigned*)(ws + WS_CTL) + CW_BGQ);
    __syncthreads();
    const bool drained = __builtin_amdgcn_readfirstlane(lbase[32]) >= ((li == 0) ? BG_PER_LAYER : BG_ALL);
    if (act) { const int tok = row0 + cx.tid; unsigned long long* RL = (unsigned long long*)(ws + (dummy ? WS_END : WS_ROWLIST));
        RL[(size_t)e0 * MT + lbase[e0] + lr0] = ((unsigned long long)__float_as_uint(w0) << 32) | (unsigned)(tok * 2);
        RL[(size_t)e1 * MT + lbase[e1] + lr1] = ((unsigned long long)__float_as_uint(w1) << 32) | (unsigned)(tok * 2 + 1); }
    if (!dummy && !drained) bg_drain(p, cx, (li == 0) ? BG_PER_LAYER : BG_ALL);
}
__device__ __forceinline__ void moe_tables(CP* p, const Ctx& cx, int li, int& ntiles) {
    LAS int* tcnt = (LAS int*)(cx.lds + MISC_OFF + MO_TCNT); LAS int* tbase = (LAS int*)(cx.lds + MISC_OFF + MO_TBASE);
    __syncthreads();
    if (cx.tid < 32) tcnt[cx.tid] = (int)__hip_atomic_load((unsigned*)(p->ws + WS_CTL) + CW_CNT + li * 2048 + cx.tid * 64, __ATOMIC_RELAXED, __HIP_MEMORY_SCOPE_AGENT);
    __syncthreads();
    if (cx.tid == 0) { int a = 0; for (int e = 0; e < 32; ++e) { tbase[e] = a; a += (tcnt[e] + 255) >> 8; } tbase[32] = a; }
    __syncthreads();
    ntiles = __builtin_amdgcn_readfirstlane(tbase[32]);
    if (cx.tid < MAXT) { int e = 0;
#pragma unroll
        for (int j = 1; j < 32; ++j) e += (tbase[j] <= cx.tid) ? 1 : 0;
        ((LAS int*)(cx.lds + MISC_OFF + MO_TEXP))[cx.tid] = e; }
    __syncthreads();
}
__device__ __forceinline__ void phase_moe_up(CP* p0, const Ctx& cx0, int li, int ph) {
    const Ctx cx = reopaque(cx0); CP* p = opaque_args(p0);
    unsigned char* ws = p->ws; int ntiles; moe_tables(p, cx, li, ntiles);
    LAS int* tcnt = (LAS int*)(cx.lds + MISC_OFF + MO_TCNT); LAS int* tbase = (LAS int*)(cx.lds + MISC_OFF + MO_TBASE); LAS int* idx = (LAS int*)(cx.lds + MISC_OFF + MO_IDX);
    const unsigned long long* RL = (const unsigned long long*)(ws + WS_ROWLIST);
    const LAS int* texp = (const LAS int*)(cx.lds + MISC_OFF + MO_TEXP);
    { const int r = cx.tid & 255, i0 = cx.tid >> 8, T0 = (i0 * cx.G + cx.vcu) >> 2, T2 = (2 * cx.G + cx.vcu) >> 2;
      const bool ok0 = T0 < ntiles, ok2 = (i0 == 0) && (T2 < ntiles); const int e0 = texp[ok0 ? T0 : 0], e2 = texp[ok2 ? T2 : 0];
      const int j0 = (T0 - tbase[e0]) * 256 + r, j2 = (T2 - tbase[e2]) * 256 + r;
      const unsigned long long v0 = RL[(size_t)e0 * MT + ((ok0 && j0 < tcnt[e0]) ? j0 : 0)], v2 = RL[(size_t)e2 * MT + ((ok2 && j2 < tcnt[e2]) ? j2 : 0)];
      if (ok0) idx[i0 * 256 + r] = (int)((unsigned)v0 >> 1);
      if (ok2) idx[512 + r] = (int)((unsigned)v2 >> 1); }
    __syncthreads();
    pg8::SchedMoe S; S.texp = texp; S.idx = idx; S.A = (const char*)(ws + WS_H1); S.B = (const char*)(ws + WS_WGU) + (size_t)li * 32 * 1024 * 1024 * 2;
    S.tA = 0; S.eB = (size_t)1024 * 1024 * 2; S.tB = (size_t)256 * 1024 * 2; S.G = cx.G; S.c = cx.vcu; S.ntiles = ntiles; S.gather = true;
    pg8::EpiUp E{(bf16_t*)(ws + WS_H)};
    pg8::gemm_phase<pg8::EpiUp, pg8::SchedMoe, true, true, D>(cx.lds, S, E);
    if (li == 0) bg_idle(p, cx, ph);
}
__device__ __forceinline__ void phase_moe_down(CP* p0, const Ctx& cx0, int li, int ph) {
    const Ctx cx = reopaque(cx0); CP* p = opaque_args(p0);
    unsigned char* ws = p->ws; int ntiles;
#if MK_SPLIT
    moe_tables(p, cx, li, ntiles);
#else
    ntiles = __builtin_amdgcn_readfirstlane(((const LAS int*)(cx.lds + MISC_OFF + MO_TBASE))[32]);
#endif
    LAS int* tcnt = (LAS int*)(cx.lds + MISC_OFF + MO_TCNT); LAS int* tbase = (LAS int*)(cx.lds + MISC_OFF + MO_TBASE); LAS int* idx = (LAS int*)(cx.lds + MISC_OFF + MO_IDX);
    pg8::SchedMoe S; S.texp = (const LAS int*)(cx.lds + MISC_OFF + MO_TEXP); S.idx = idx; S.A = (const char*)(ws + WS_H); S.B = (const char*)(ws + WS_WD) + (size_t)li * 32 * 1024 * 512 * 2;
    S.tA = (size_t)256 * 512 * 2; S.eB = (size_t)1024 * 512 * 2; S.tB = (size_t)256 * 512 * 2; S.G = cx.G; S.c = cx.vcu; S.ntiles = ntiles; S.gather = false;
    pg8::EpiDown E{(bf16_t*)(ws + WS_Y2), (const unsigned long long*)(ws + WS_ROWLIST), tcnt, tbase};
    pg8::gemm_phase<pg8::EpiDown, pg8::SchedMoe, false, true, DE>(cx.lds, S, E);
    if (li == 0) bg_idle(p, cx, ph);
}
__device__ __forceinline__ void phase_final(CP* p0, const Ctx& cx0) {
    const Ctx cx = reopaque(cx0); CP* p = opaque_args(p0);
    unsigned char* ws = p->ws; const bf16_t* X1 = (const bf16_t*)(ws + WS_X1); const bf16_t* Y2 = (const bf16_t*)(ws + WS_Y2);
    const int rpw = (NX + cx.ngw - 1) / cx.ngw, mlo = cx.gw * rpw, mhi = (mlo + rpw < NX) ? mlo + rpw : NX;
    if (mlo >= mhi) return;
    u32x2 xa[4], ya[4], yb[4]; f32x4 g20[4], g21[4], gf[4]; const int r0 = mlo >> 11, r1 = (mhi - 1) >> 11;
#define FN_LOAD(m_) do { const bf16_t* xr_ = X1 + (size_t)(m_) * D; const bf16_t* yr_ = Y2 + (size_t)(m_) * 2 * D; \
        _Pragma("unroll") for (int j_ = 0; j_ < 4; ++j_) { const int k_ = 256 * j_ + 4 * cx.lane; xa[j_] = *(const u32x2*)(xr_ + k_); ya[j_] = *(const u32x2*)(yr_ + k_); yb[j_] = *(const u32x2*)(yr_ + D + k_); } } while (0)
    FN_LOAD(mlo);
#pragma unroll
    for (int j = 0; j < 4; ++j) { gf[j] = *(const f32x4*)(p->norm_final + 256 * j + 4 * cx.lane);
        g20[j] = *(const f32x4*)((const float*)(ws + WS_MOD) + (size_t)(9 + r0) * 6144 + 5 * D + 256 * j + 4 * cx.lane); g21[j] = *(const f32x4*)((const float*)(ws + WS_MOD) + (size_t)(9 + r1) * 6144 + 5 * D + 256 * j + 4 * cx.lane); }
#pragma unroll 1
    for (int m = mlo; m < mhi; ++m) {
        const bool hi = ((m >> 11) != r0);
        f32x4 v[4]; float ss = 0.f;
#pragma unroll
        for (int j = 0; j < 4; ++j) { v[j] = (f32x4){bflo(xa[j].x), bfhi(xa[j].x), bflo(xa[j].y), bfhi(xa[j].y)} + (hi ? g21[j] : g20[j]) * (f32x4){bflo(ya[j].x) + bflo(yb[j].x), bfhi(ya[j].x) + bfhi(yb[j].x), bflo(ya[j].y) + bflo(yb[j].y), bfhi(ya[j].y) + bfhi(yb[j].y)};
            ss += v[j][0] * v[j][0] + v[j][1] * v[j][1] + v[j][2] * v[j][2] + v[j][3] * v[j][3]; }
        if (m + 1 < mhi) FN_LOAD(m + 1);
        const float r = 1.0f / sqrtf(wave_sum(ss) * (1.0f / D) + 1e-6f);
#pragma unroll
        for (int j = 0; j < 4; ++j) *(f32x4*)(p->out + (size_t)m * D + 256 * j + 4 * cx.lane) = v[j] * r * gf[j];
    }
#undef FN_LOAD
}

constexpr int N_PHASES = 16;
__global__ void __launch_bounds__(512, 2) mk_fwd(Params p_unused) {
    CP* p = (CP*)__builtin_amdgcn_kernarg_segment_ptr(); (void)p_unused;
    extern __shared__ __attribute__((aligned(16))) unsigned char lds_raw[];
    Ctx cx; cx.lds = (LAS unsigned char*)lds_raw; cx.tid = threadIdx.x; cx.lane = cx.tid & 63; cx.wave = __builtin_amdgcn_readfirstlane(cx.tid >> 6);
    cx.G = gridDim.x; { const int bx = blockIdx.x; cx.vcu = (cx.G % 8 == 0) ? (bx % 8) * (cx.G / 8) + bx / 8 : bx; }
    cx.gw = cx.vcu * 8 + cx.wave; cx.ngw = cx.G * 8;
    volatile LAS unsigned* misc = (volatile LAS unsigned*)(cx.lds + LDS_BYTES - 16);
    if (cx.tid < 4) misc[cx.tid] = 0u;
    __syncthreads();
#if MK_SPLIT
#define GRID_BAR() do { } while (0)
#else
    XcdBarrier bar = xcd_barrier_post((unsigned*)(p->ws + WS_CTL) + CW_BAR, misc);
#define GRID_BAR() xcd_barrier(bar)
#endif
    const int lo = p->ph_lo, hi = p->ph_hi, rep0 = p->rep0;
    unsigned long long* tsbuf = (unsigned long long*)(p->ws + WS_END + 8 * MiB);
    if (MK_TS && blockIdx.x == 0 && threadIdx.x == 0) tsbuf[0] = __builtin_amdgcn_s_memrealtime();
#define IN(k) (lo <= (k) && (k) < hi)
#define EN(j) (!((MK_SKIP >> (j)) & 1))
#define SEAM(k) do { if (IN(k) && IN((k) + 1)) GRID_BAR(); if (MK_TS && blockIdx.x == 0 && threadIdx.x == 0) tsbuf[(k) + 1] = __builtin_amdgcn_s_memrealtime(); } while (0)
#define NREP(k) (((MK_REP >> (k)) & 1) ? 3 : 1)
#define RUN(kind, ph, cond, call) do { if (EN(kind) && IN(ph)) { const int nr_ = (cond) ? NREP(kind) : 1; for (int rep = nr_ - 1 + rep0; rep >= rep0; --rep) { call; if (rep > rep0) GRID_BAR(); } } } while (0)
    RUN(0, 0, true, phase_p0a(p, cx));
    SEAM(0);
    for (int li = 0; li < 2; ++li) { const int pb = 1 + 7 * li;
        RUN(2, pb + 0, li == 0, phase_norm1(p, cx, li));
        SEAM(pb + 0);
        RUN(3, pb + 1, true, phase_inproj(p, cx, li, pb + 1));
        SEAM(pb + 1);
        RUN(4, pb + 2, true, phase_mix(p, cx, li, rep, pb + 2));
        SEAM(pb + 2);
        RUN(5, pb + 3, li == 0, phase_outproj(p, cx, li, pb + 3));
        SEAM(pb + 3);
        RUN(6, pb + 4, true, phase_router(p, cx, li, rep));
        SEAM(pb + 4);
        RUN(7, pb + 5, true, phase_moe_up(p, cx, li, pb + 5));
        SEAM(pb + 5);
        RUN(8, pb + 6, true, phase_moe_down(p, cx, li, pb + 6));
        SEAM(pb + 6);
    }
    RUN(9, 15, true, phase_final(p, cx));
#if MK_TS
    if (blockIdx.x == 0 && threadIdx.x == 0) { tsbuf[16] = __builtin_amdgcn_s_memrealtime();
        const unsigned long long d = 4ull * (tsbuf[MK_TSB + 1] - tsbuf[MK_TSA]), t0 = __builtin_amdgcn_s_memrealtime();
        while (__builtin_amdgcn_s_memrealtime() - t0 < d) __builtin_amdgcn_s_sleep(8); }
#endif
}

extern "C" void kernel_launch(void* const* d_in, const int* in_sizes, int n_in, void* d_out, int out_size, void* d_ws, size_t ws_size, hipStream_t stream) {
    static int grid = 0;
    if (grid == 0) {
        if (n_in != 21 || out_size != NX * D || ws_size < WS_END) { fprintf(stderr, "kernel_launch: unexpected shapes (n_in %d, out %d, ws %zu)\n", n_in, out_size, ws_size); grid = -1; return; }
        int dev = 0, cus = 0;
        if (hipGetDevice(&dev) != hipSuccess || hipDeviceGetAttribute(&cus, hipDeviceAttributeMultiprocessorCount, dev) != hipSuccess) { grid = -1; return; }
        if (hipFuncSetAttribute((const void*)mk_fwd, hipFuncAttributeMaxDynamicSharedMemorySize, LDS_BYTES) != hipSuccess) { fprintf(stderr, "kernel_launch: hipFuncSetAttribute failed\n"); grid = -1; return; }
        (void)hipGetLastError();
        grid = cus;
        if (grid != 256) { fprintf(stderr, "kernel_launch: %d CUs; this kernel's phase geometry is built for 256: nothing launched\n", grid); grid = -1; return; }
    }
    if (grid < 0) return;
    (void)in_sizes;
    (void)hipMemsetAsync((char*)d_ws + WS_CTL, 0, CTL_ZERO_BYTES, stream);
    Params a{};
    a.x = (const float*)d_in[0]; a.c = (const float*)d_in[1]; a.ctx = (const float*)d_in[2]; a.c_ctx = (const float*)d_in[3]; a.w_ada = (const float*)d_in[4]; a.b_ada = (const float*)d_in[5];
    a.norm1 = (const float*)d_in[6]; a.norm2 = (const float*)d_in[7]; a.w_in = (const float*)d_in[8]; a.w_fourier = (const float*)d_in[9]; a.w_conv = (const float*)d_in[10]; a.rpb = (const float*)d_in[11];
    a.w_out = (const float*)d_in[12]; a.w_rg = (const float*)d_in[13]; a.b_rg = (const float*)d_in[14]; a.w_re = (const float*)d_in[15]; a.b_re = (const float*)d_in[16];
    a.w_gate = (const float*)d_in[17]; a.w_up = (const float*)d_in[18]; a.w_down = (const float*)d_in[19]; a.norm_final = (const float*)d_in[20];
    a.out = (float*)d_out; a.ws = (unsigned char*)d_ws;
#if MK_SPLIT
    for (int ph = 0; ph < N_PHASES; ++ph) { a.ph_lo = ph; a.ph_hi = ph + 1;
        if (ph == MK_XTRA) for (int r = 2; r >= 1; --r) { a.rep0 = r; hipLaunchKernelGGL(mk_fwd, dim3(grid), dim3(512), LDS_BYTES, stream, a); }
        a.rep0 = 0; hipLaunchKernelGGL(mk_fwd, dim3(grid), dim3(512), LDS_BYTES, stream, a); }
#else
    a.ph_lo = 0; a.ph_hi = N_PHASES; hipLaunchKernelGGL(mk_fwd, dim3(grid), dim3(512), LDS_BYTES, stream, a);
#endif
}
```
